# Optimizing an MI355X kernel written in HIP

```python
import jax, jax.numpy as jnp
from jax import lax
import numpy as np

D_MODEL = 1024
BATCH = 8
SEQ = 2048
DEPTH = 1

CHUNK = 64
D_FF = 2816
NORM_EPS = 1e-6

RWKV_HEADS = 8
RWKV_HEAD_DIM = 64
D_RWKV = RWKV_HEADS * RWKV_HEAD_DIM
DECAY_LORA = 64
ICLR_LORA = 64
GATE_LORA = 128
RWKV_GN_EPS = 64e-5

SSM_HEADS = 8
SSM_HEAD_DIM = 64
D_SSM = SSM_HEADS * SSM_HEAD_DIM
SSM_GROUPS = 2
SSM_STATE = 128
CONV_WIDTH = 4
D_CONV = D_SSM + 2 * SSM_GROUPS * SSM_STATE
SSM_NORM_EPS = 1e-5

D_MIX = D_RWKV + D_SSM
D_IN_RWKV = 3 * D_RWKV + DECAY_LORA + ICLR_LORA + GATE_LORA
D_IN_SSM = D_SSM + D_CONV + SSM_HEADS
D_IN = D_IN_RWKV + D_IN_SSM

kernel_name = "hybrid_rwkv7_mamba2_macaron_block"


def rms_norm(x, g, eps=NORM_EPS):
    x32 = x.astype(jnp.float32)
    y = x32 * lax.rsqrt(jnp.mean(x32 * x32, axis=-1, keepdims=True) + eps)
    return y.astype(x.dtype) * g


def swiglu_ffn(h, w_gate, w_up, w_down):
    return (jax.nn.silu(h @ w_gate) * (h @ w_up)) @ w_down


def token_shift(t):
    return jnp.pad(t, ((0, 0), (1, 0), (0, 0)))[:, :-1]


def rwkv7_mix(p, mu, w0, w2, a0, a2, g2, k_k, k_a, r_k, gn_g, gn_b):
    b, L, _ = p.shape
    H, N = RWKV_HEADS, RWKV_HEAD_DIM
    p = p + (token_shift(p) - p) * mu
    r, k, v, wd, ad, gd = jnp.split(
        p, [D_RWKV, 2 * D_RWKV, 3 * D_RWKV, 3 * D_RWKV + DECAY_LORA,
            3 * D_RWKV + DECAY_LORA + ICLR_LORA], axis=-1)
    w_log = -jax.nn.softplus(-(w0 + jnp.tanh(wd) @ w2)) - 0.5
    decay = jnp.exp(-jnp.exp(w_log))
    a = jax.nn.sigmoid(a0 + ad @ a2)
    g = jax.nn.sigmoid(gd) @ g2
    heads = lambda t: t.reshape(b, L, H, N)
    kk = heads(k * k_k)
    kk32 = kk.astype(jnp.float32)
    kk = (kk32 / jnp.maximum(jnp.sqrt(jnp.sum(kk32 * kk32, -1, keepdims=True)), 1e-12)).astype(k.dtype)
    k = k * (1.0 + (a - 1.0) * k_a)
    r_h, w_h, k_h, v_h, a_h = heads(r), heads(decay), heads(k), heads(v), heads(a)

    def step(S, inp):
        rt, wt, kt, vt, kkt, at = inp
        sa = jnp.einsum('bhij,bhj->bhi', S, -kkt)
        S = S * wt[:, :, None, :] + sa[..., None] * (kkt * at)[:, :, None, :] + vt[..., None] * kt[:, :, None, :]
        return S, jnp.einsum('bhij,bhj->bhi', S, rt)

    xs = tuple(jnp.moveaxis(t, 1, 0) for t in (r_h, w_h, k_h, v_h, kk, a_h))
    S0 = jnp.zeros((b, H, N, N), r.dtype)
    _, ys = lax.scan(step, S0, xs)
    y = jnp.moveaxis(ys, 0, 1)
    y32 = y.astype(jnp.float32)
    mean = jnp.mean(y32, -1, keepdims=True)
    var = jnp.mean(jnp.square(y32 - mean), -1, keepdims=True)
    y = ((y32 - mean) * lax.rsqrt(var + RWKV_GN_EPS)).astype(y.dtype).reshape(b, L, D_RWKV) * gn_g + gn_b
    bonus = (jnp.sum(r_h * k_h * r_k, -1, keepdims=True) * v_h).reshape(b, L, D_RWKV)
    return (y + bonus) * g


def causal_depthwise_conv(t, w):
    C = t.shape[-1]
    return lax.conv_general_dilated(
        t, w[:, None, :], window_strides=(1,), padding=[(CONV_WIDTH - 1, 0)],
        dimension_numbers=('NWC', 'WIO', 'NWC'), feature_group_count=C)


def ssd_scan(x, a, Bm, Cm):
    b, L, H, P = x.shape
    G, N = Bm.shape[2], Bm.shape[3]
    R = H // G
    nc = L // CHUNK
    x = x.reshape(b, nc, CHUNK, G, R, P)
    a = a.reshape(b, nc, CHUNK, G, R).transpose(0, 3, 4, 1, 2)
    Bc = Bm.reshape(b, nc, CHUNK, G, N)
    Cc = Cm.reshape(b, nc, CHUNK, G, N)
    a_cs = jnp.cumsum(a, axis=-1)
    causal = jnp.tril(jnp.ones((CHUNK, CHUNK), dtype=bool))
    seg = a_cs[..., :, None] - a_cs[..., None, :]
    L_mat = jnp.exp(jnp.where(causal, seg, -jnp.inf))
    scores = jnp.einsum('bclgn,bcsgn->bgcls', Cc, Bc)
    y_diag = jnp.einsum('bgcls,bgrcls,bcsgrp->bclgrp', scores, L_mat, x)
    decay_to_end = jnp.exp(a_cs[..., -1:] - a_cs)
    chunk_states = jnp.einsum('bclgn,bgrcl,bclgrp->bcgrpn', Bc, decay_to_end, x)
    chunk_decay = jnp.exp(a_cs[..., -1])

    def carry_fn(state, inp):
        st, dec = inp
        return state * dec[..., None, None] + st, state

    init = jnp.zeros((b, G, R, P, N), x.dtype)
    _, prev_states = lax.scan(carry_fn, init,
                              (jnp.moveaxis(chunk_states, 1, 0), jnp.moveaxis(chunk_decay, 3, 0)))
    y_off = jnp.einsum('bclgn,bgrcl,cbgrpn->bclgrp', Cc, jnp.exp(a_cs), prev_states)
    return (y_diag + y_off).reshape(b, L, H, P)


def mamba2_mix(p, conv_w, conv_b, dt_bias, a_log, d_skip, norm_g):
    b, L, _ = p.shape
    z, xbc, dt = jnp.split(p, [D_SSM, D_SSM + D_CONV], axis=-1)
    xbc = jax.nn.silu(causal_depthwise_conv(xbc, conv_w) + conv_b)
    xs, Bm, Cm = jnp.split(xbc, [D_SSM, D_SSM + SSM_GROUPS * SSM_STATE], axis=-1)
    dt = jax.nn.softplus(dt + dt_bias)
    A = -jnp.exp(a_log)
    xh = xs.reshape(b, L, SSM_HEADS, SSM_HEAD_DIM)
    y = ssd_scan(xh * dt[..., None], dt * A,
                 Bm.reshape(b, L, SSM_GROUPS, SSM_STATE), Cm.reshape(b, L, SSM_GROUPS, SSM_STATE))
    y = (y + d_skip[:, None] * xh).reshape(b, L, D_SSM)
    return rms_norm(y * jax.nn.silu(z), norm_g, SSM_NORM_EPS)


def setup_inputs(seed: int = 0) -> dict:
    key = jax.random.key(seed)
    ks = jax.random.split(key, 32)
    f32 = jnp.float32
    nrm = lambda k, shape, s: jax.random.normal(k, shape, f32) * s
    gain = lambda k, shape: 1.0 + 0.02 * jax.random.normal(k, shape, f32)
    Dd = DEPTH
    dt0 = jnp.exp(jax.random.uniform(ks[20], (Dd, SSM_HEADS), f32, np.log(1e-3), np.log(1e-1)))
    return {
        "x": nrm(ks[0], (BATCH, SEQ, D_MODEL), 1.0),
        "norm_ffn1": gain(ks[1], (Dd, D_MODEL)),
        "ffn1_w_gate": nrm(ks[2], (Dd, D_MODEL, D_FF), D_MODEL ** -0.5),
        "ffn1_w_up": nrm(ks[3], (Dd, D_MODEL, D_FF), D_MODEL ** -0.5),
        "ffn1_w_down": nrm(ks[4], (Dd, D_FF, D_MODEL), D_FF ** -0.5),
        "norm_mix": gain(ks[5], (Dd, D_MODEL)),
        "w_in": nrm(ks[6], (Dd, D_MODEL, D_IN), D_MODEL ** -0.5),
        "rwkv_mu": jax.random.uniform(ks[7], (Dd, D_IN_RWKV), f32),
        "rwkv_w0": jax.random.uniform(ks[8], (Dd, D_RWKV), f32, -6.0, 1.0),
        "rwkv_w2": nrm(ks[9], (Dd, DECAY_LORA, D_RWKV), 0.5 * DECAY_LORA ** -0.5),
        "rwkv_a0": nrm(ks[10], (Dd, D_RWKV), 0.1),
        "rwkv_a2": nrm(ks[11], (Dd, ICLR_LORA, D_RWKV), ICLR_LORA ** -0.5),
        "rwkv_g2": nrm(ks[12], (Dd, GATE_LORA, D_RWKV), GATE_LORA ** -0.5),
        "rwkv_k_k": 0.85 + 0.02 * jax.random.normal(ks[13], (Dd, D_RWKV), f32),
        "rwkv_k_a": gain(ks[14], (Dd, D_RWKV)),
        "rwkv_r_k": nrm(ks[15], (Dd, RWKV_HEADS, RWKV_HEAD_DIM), 0.1),
        "rwkv_gn_g": gain(ks[16], (Dd, D_RWKV)),
        "rwkv_gn_b": nrm(ks[17], (Dd, D_RWKV), 0.01),
        "ssm_conv_w": nrm(ks[18], (Dd, CONV_WIDTH, D_CONV), CONV_WIDTH ** -0.5),
        "ssm_conv_b": nrm(ks[19], (Dd, D_CONV), 0.01),
        "ssm_dt_bias": dt0 + jnp.log(-jnp.expm1(-dt0)),
        "ssm_a_log": jnp.log(jax.random.uniform(ks[21], (Dd, SSM_HEADS), f32, 1.0, 16.0)),
        "ssm_d": gain(ks[22], (Dd, SSM_HEADS)),
        "ssm_norm": gain(ks[23], (Dd, D_SSM)),
        "w_out": nrm(ks[24], (Dd, D_MIX, D_MODEL), D_MIX ** -0.5),
        "norm_ffn2": gain(ks[25], (Dd, D_MODEL)),
        "ffn2_w_gate": nrm(ks[26], (Dd, D_MODEL, D_FF), D_MODEL ** -0.5),
        "ffn2_w_up": nrm(ks[27], (Dd, D_MODEL, D_FF), D_MODEL ** -0.5),
        "ffn2_w_down": nrm(ks[28], (Dd, D_FF, D_MODEL), D_FF ** -0.5),
        "norm_final": gain(ks[29], (D_MODEL,)),
    }


def reference(x, norm_ffn1, ffn1_w_gate, ffn1_w_up, ffn1_w_down, norm_mix, w_in,
              rwkv_mu, rwkv_w0, rwkv_w2, rwkv_a0, rwkv_a2, rwkv_g2, rwkv_k_k, rwkv_k_a,
              rwkv_r_k, rwkv_gn_g, rwkv_gn_b, ssm_conv_w, ssm_conv_b, ssm_dt_bias,
              ssm_a_log, ssm_d, ssm_norm, w_out, norm_ffn2, ffn2_w_gate, ffn2_w_up,
              ffn2_w_down, norm_final):
    for i in range(DEPTH):
        h = rms_norm(x, norm_ffn1[i])
        x = x + 0.5 * swiglu_ffn(h, ffn1_w_gate[i], ffn1_w_up[i], ffn1_w_down[i])
        h = rms_norm(x, norm_mix[i])
        p = h @ w_in[i]
        y_rwkv = rwkv7_mix(p[..., :D_IN_RWKV], rwkv_mu[i], rwkv_w0[i], rwkv_w2[i], rwkv_a0[i],
                           rwkv_a2[i], rwkv_g2[i], rwkv_k_k[i], rwkv_k_a[i], rwkv_r_k[i],
                           rwkv_gn_g[i], rwkv_gn_b[i])
        y_ssm = mamba2_mix(p[..., D_IN_RWKV:], ssm_conv_w[i], ssm_conv_b[i], ssm_dt_bias[i],
                           ssm_a_log[i], ssm_d[i], ssm_norm[i])
        x = x + jnp.concatenate([y_rwkv, y_ssm], axis=-1) @ w_out[i]
        h = rms_norm(x, norm_ffn2[i])
        x = x + 0.5 * swiglu_ffn(h, ffn2_w_gate[i], ffn2_w_up[i], ffn2_w_down[i])
    return rms_norm(x, norm_final)
```

```cpp
#include <hip/hip_runtime.h>
#include <hip/hip_cooperative_groups.h>
#include <cstdio>
#include <cstdint>
namespace cg = cooperative_groups;
#define MK_N_LAUNCHES 12
namespace pg8 {
#define PG8_LAS __attribute__((address_space(3)))
typedef unsigned short bf16_t;
typedef short bf16x8 __attribute__((ext_vector_type(8)));
typedef float f32x4 __attribute__((ext_vector_type(4)));
typedef unsigned u32x4 __attribute__((ext_vector_type(4)));
constexpr int BM = 256, BK = 64, HALF = 128, HTB = HALF * BK * 2  , STAGE_BYTES = 8 * HTB, NXCD = 8, WGM = 8;

__host__ __device__ __forceinline__ int lds_byte(int r, int c) { const int st = (r >> 4) * 2 + (c >> 5), rr = r & 15, cc = c & 31, ob = rr * 64 + cc * 2; return st * 1024 + (ob ^ (((ob >> 9) & 1) << 5)); }
__host__ __device__ __forceinline__ void stage_rc(int b, int& R, int& C) { const int st = b / 1024, sb = b % 1024, swz = sb ^ (((sb >> 9) & 1) << 5); R = (st >> 1) * 16 + swz / 64; C = (st & 1) * 32 + (swz % 64) / 2; }
__host__ __device__ __forceinline__ int perm32(int rho) { const int n = rho >> 4, i = rho & 15; return 8 * (i >> 2) + 4 * n + (i & 3); }

struct Unit { int pm, pn; };
struct Gemm { const bf16_t* A; const bf16_t* Bt; int M, N, K; };

struct StaticOrder {
    int nM, nN, nwg, G, c;
    __host__ __device__ void init(int M, int N, int G_, int c_) { nM = M / BM; nN = N / BM; nwg = nM * nN; G = G_; c = c_; }
    __host__ __device__ bool next(int i, Unit& u) const {
        const long L = (long)i * G + c; if (L >= nwg) return false;
        int wgid = (int)L; { const int q = nwg / NXCD, r = nwg % NXCD, xcd = wgid % NXCD, off = wgid / NXCD; wgid = (xcd < r ? xcd * (q + 1) : r * (q + 1) + (xcd - r) * q) + off; }
        const int nig = WGM * nN, gid = wgid / nig, fm = gid * WGM, gsz = (nM - fm) < WGM ? (nM - fm) : WGM;
        u.pm = fm + ((wgid % nig) % gsz); u.pn = (wgid % nig) / gsz; return true;
    }
    __device__ __forceinline__ void a_ready(const Unit&) const {}
    __device__ __forceinline__ void done(const Unit&) const {}
};
__device__ __forceinline__ unsigned cvt_pk_bf16(float lo, float hi) { unsigned r; asm volatile("v_cvt_pk_bf16_f32 %0, %1, %2" : "=v"(r) : "v"(lo), "v"(hi)); return r; }
typedef unsigned u32x2 __attribute__((ext_vector_type(2)));
__device__ __forceinline__ float sigmoidf_(float x) { return __builtin_amdgcn_rcpf(1.0f + __expf(-x)); }
__device__ __forceinline__ float row_rscale(const float* part, int row) {
    const f32x4* p = (const f32x4*)(part + (size_t)row * 16);
    const f32x4 a = p[0], b = p[1], c = p[2], d = p[3];
    const f32x4 s = (a + b) + (c + d);
    return __builtin_amdgcn_rsqf(((s[0] + s[1]) + (s[2] + s[3])) * (1.0f / 1024.0f) + 1e-6f);
}
struct EpiSwiGLU {
    static constexpr bool PERM = true, AFTER_DRAIN = false;
    bf16_t* O; int ldc; const float* part;
    __device__ __forceinline__ void operator()(const f32x4 (&acc)[2][2][4][2], const Unit& u, int wr, int wc, int fr, int fq) const {
        const int row0 = u.pm * BM + wr * 64 + fr, col0 = u.pn * HALF + wc * 32 + 8 * fq;
#pragma unroll
        for (int ai = 0; ai < 2; ++ai)
#pragma unroll
            for (int m = 0; m < 4; ++m) {
                const int row = row0 + ai * HALF + m * 16;
                const float rs = part ? row_rscale(part, row) : 1.0f;
                float h[8];
#pragma unroll
                for (int n = 0; n < 2; ++n)
#pragma unroll
                    for (int j = 0; j < 4; ++j) { const float g = acc[ai][0][m][n][j] * rs, up = acc[ai][1][m][n][j] * rs; h[4 * n + j] = g * sigmoidf_(g) * up; }
                u32x4 w; w.x = cvt_pk_bf16(h[0], h[1]); w.y = cvt_pk_bf16(h[2], h[3]); w.z = cvt_pk_bf16(h[4], h[5]); w.w = cvt_pk_bf16(h[6], h[7]);
                *(u32x4*)(O + (size_t)row * ldc + col0) = w;
            }
    }
};
struct EpiResid {
    static constexpr bool PERM = false, AFTER_DRAIN = false;
    const float* base; float* out; const float* gain; bf16_t* xg; float* part; float scale;
    __device__ __forceinline__ void operator()(const f32x4 (&acc)[2][2][4][2], const Unit& u, int wr, int wc, int fr, int fq) const {
#pragma unroll
        for (int ai = 0; ai < 2; ++ai)
#pragma unroll
            for (int m = 0; m < 4; ++m) {
                const int row = u.pm * BM + ai * HALF + wr * 64 + m * 16 + fr; float ss = 0.f;
#pragma unroll
                for (int bj = 0; bj < 2; ++bj)
#pragma unroll
                    for (int n = 0; n < 2; ++n) {
                        const int col = u.pn * BM + bj * HALF + wc * 32 + n * 16 + 4 * fq; const size_t off = (size_t)row * 1024 + col;
                        const f32x4 bs = *(const f32x4*)(base + off); const f32x4 v = bs + acc[ai][bj][m][n] * scale;
                        *(f32x4*)(out + off) = v;
                        ss += (v[0] * v[0] + v[1] * v[1]) + (v[2] * v[2] + v[3] * v[3]);
                        if (xg) { const f32x4 g4 = *(const f32x4*)(gain + col); const f32x4 w = v * g4; u32x2 o; o.x = cvt_pk_bf16(w[0], w[1]); o.y = cvt_pk_bf16(w[2], w[3]); *(u32x2*)(xg + off) = o; }
                    }
                ss += __shfl_xor(ss, 16); ss += __shfl_xor(ss, 32);
                if (fq == 0) part[(size_t)row * 16 + u.pn * 4 + wc] = ss;
            }
    }
};
struct EpiScaleBf16 {
    static constexpr bool PERM = true, AFTER_DRAIN = false;
    bf16_t* O; int ldc; int ncols; const float* part;
    __device__ __forceinline__ void operator()(const f32x4 (&acc)[2][2][4][2], const Unit& u, int wr, int wc, int fr, int fq) const {
        const int row0 = u.pm * BM + wr * 64 + fr, col0 = u.pn * BM + wc * 32 + 8 * fq;
#pragma unroll
        for (int ai = 0; ai < 2; ++ai)
#pragma unroll
            for (int m = 0; m < 4; ++m) {
                const int row = row0 + ai * HALF + m * 16; const float rs = row_rscale(part, row);
#pragma unroll
                for (int bj = 0; bj < 2; ++bj) { const int col = col0 + bj * HALF;
                    if (col < ncols) { const f32x4 v0 = acc[ai][bj][m][0] * rs, v1 = acc[ai][bj][m][1] * rs;
                        u32x4 w; w.x = cvt_pk_bf16(v0[0], v0[1]); w.y = cvt_pk_bf16(v0[2], v0[3]); w.z = cvt_pk_bf16(v1[0], v1[1]); w.w = cvt_pk_bf16(v1[2], v1[3]);
                        *(u32x4*)(O + (size_t)row * ldc + col) = w; } }
            }
    }
};
struct EpiLora {
    static constexpr bool PERM = true, AFTER_DRAIN = false;
    bf16_t* EA; bf16_t* G;
    __device__ __forceinline__ void operator()(const f32x4 (&acc)[2][2][4][2], const Unit& u, int wr, int wc, int fr, int fq) const {
        const int row0 = u.pm * BM + wr * 64 + fr, colt = (u.pn & 3) * BM + wc * 32 + 8 * fq;
        bf16_t* base = u.pn < 4 ? EA : G; const int ldc = u.pn < 4 ? 1024 : 512;
#pragma unroll
        for (int ai = 0; ai < 2; ++ai)
#pragma unroll
            for (int m = 0; m < 4; ++m) {
                bf16_t* rowp = base + (size_t)(row0 + ai * HALF + m * 16) * ldc + colt;
#pragma unroll
                for (int bj = 0; bj < 2; ++bj) { const f32x4 v0 = acc[ai][bj][m][0], v1 = acc[ai][bj][m][1];
                    u32x4 w; w.x = cvt_pk_bf16(v0[0], v0[1]); w.y = cvt_pk_bf16(v0[2], v0[3]); w.z = cvt_pk_bf16(v1[0], v1[1]); w.w = cvt_pk_bf16(v1[2], v1[3]);
                    *(u32x4*)(rowp + bj * HALF) = w; }
            }
    }
};

template <class Epi, class Sched, bool ALIGN_EPI = false, bool SP2 = false>
__device__ __forceinline__ void gemm_phase(PG8_LAS unsigned char* lds, const Gemm g, const Sched& S, const Epi& E) {
    const int tid = threadIdx.x, wid = __builtin_amdgcn_readfirstlane(tid >> 6), lane = tid & 63, wr = wid >> 2, wc = wid & 3, fr = lane & 15, fq = lane >> 4;
    const int K = g.K, nt = K / BK;
    unsigned voffA[2], voffB[2];
#pragma unroll
    for (int i = 0; i < 2; ++i) { int R, C; stage_rc(tid * 16 + i * 8192, R, C); const int Rb = Epi::PERM ? ((R & ~31) + perm32(R & 31)) : R;
        voffA[i] = (unsigned)(R * K + C) * 2u; voffB[i] = (unsigned)(Rb * K + C) * 2u; }
    const size_t kstep = (size_t)(BK * 2);
    const size_t hstep = (size_t)HALF * K * 2;
    const size_t tstep = 2 * hstep;
    const unsigned ldsw = (unsigned)wid * 1024u;
    const int aoff = lds_byte(wr * 64 + fr, fq * 8), boff = lds_byte(wc * 32 + fr, fq * 8);
#define PG8_SA(b, h) (((b) * 2 + (h)) * HTB)
#define PG8_SB(b, h) ((4 + (b) * 2 + (h)) * HTB)
#define PG8_STAGE(bufoff, gbase, voff) do { _Pragma("unroll") for (int _i = 0; _i < 2; ++_i) \
        __builtin_amdgcn_global_load_lds((const unsigned*)((const char*)(gbase) + (voff)[_i]), (PG8_LAS unsigned*)(lds + (bufoff) + ldsw + _i * 8192), 16, 0, 0); } while (0)
#define PG8_LDA(dst, b, h) do { _Pragma("unroll") for (int m = 0; m < 4; ++m) _Pragma("unroll") for (int k = 0; k < 2; ++k) dst[m][k] = *(const PG8_LAS bf16x8*)(lds + PG8_SA(b, h) + aoff + m * 2048 + k * 1024); } while (0)
#define PG8_LDB(dst, b, h) do { _Pragma("unroll") for (int n = 0; n < 2; ++n) _Pragma("unroll") for (int k = 0; k < 2; ++k) dst[n][k] = *(const PG8_LAS bf16x8*)(lds + PG8_SB(b, h) + boff + n * 2048 + k * 1024); } while (0)
#define PG8_MMA(ai, bj, At, Bt) do { __builtin_amdgcn_s_setprio(1); _Pragma("unroll") for (int m = 0; m < 4; ++m) _Pragma("unroll") for (int n = 0; n < 2; ++n) _Pragma("unroll") for (int k = 0; k < 2; ++k) \
        acc[ai][bj][m][n] = __builtin_amdgcn_mfma_f32_16x16x32_bf16(Bt[n][k], At[m][k], acc[ai][bj][m][n], 0, 0, 0); __builtin_amdgcn_s_setprio(0); } while (0)
#define PG8_WAIT_V(n) asm volatile("s_waitcnt vmcnt(" #n ")" ::: "memory")
#define PG8_WAIT_L(n) asm volatile("s_waitcnt lgkmcnt(" #n ")" ::: "memory")
#define PG8_BAR __builtin_amdgcn_s_barrier()
#define PG8_SCHED __builtin_amdgcn_sched_barrier(0)
    Unit cur, nxt; int ui = 0;
    if (!S.next(0, cur)) return;
    f32x4 acc[2][2][4][2];
#pragma unroll
    for (int a = 0; a < 2; ++a)
#pragma unroll
        for (int b = 0; b < 2; ++b)
#pragma unroll
            for (int m = 0; m < 4; ++m)
#pragma unroll
                for (int n = 0; n < 2; ++n) acc[a][b][m][n] = (f32x4){0.f, 0.f, 0.f, 0.f};
    bf16x8 At[4][2], B0[2][2], B1[2][2];
    const char* cA = (const char*)g.A + (size_t)cur.pm * tstep; const char* cB = (const char*)g.Bt + (size_t)cur.pn * tstep;
    S.a_ready(cur);
    if constexpr (SP2) {
        PG8_STAGE(PG8_SB(0, 0), cB, voffB); PG8_STAGE(PG8_SB(0, 1), cB + hstep, voffB); PG8_STAGE(PG8_SA(0, 0), cA, voffA); PG8_STAGE(PG8_SA(0, 1), cA + hstep, voffA);
        if (wr == 1) PG8_BAR;
        PG8_WAIT_V(2); PG8_BAR;
        PG8_STAGE(PG8_SB(1, 0), cB + kstep, voffB); PG8_STAGE(PG8_SA(1, 0), cA + kstep, voffA); PG8_STAGE(PG8_SB(1, 1), cB + hstep + kstep, voffB);
        PG8_WAIT_V(6); PG8_BAR;
    } else {
        PG8_STAGE(PG8_SB(0, 0), cB, voffB); PG8_STAGE(PG8_SA(0, 0), cA, voffA); PG8_STAGE(PG8_SB(0, 1), cB + hstep, voffB); PG8_STAGE(PG8_SA(0, 1), cA + hstep, voffA);
        if (wr == 1) PG8_BAR;
        PG8_WAIT_V(4); PG8_BAR;
        PG8_STAGE(PG8_SB(1, 0), cB + kstep, voffB); PG8_STAGE(PG8_SA(1, 0), cA + kstep, voffA); PG8_STAGE(PG8_SB(1, 1), cB + hstep + kstep, voffB);
        PG8_WAIT_V(6); PG8_BAR;
    }
    for (;;) {
        const bool has_next = S.next(ui + 1, nxt);
        const char* nA = has_next ? (const char*)g.A + (size_t)nxt.pm * tstep : cA; const char* nB = has_next ? (const char*)g.Bt + (size_t)nxt.pn * tstep : cB;
        for (int t = 0; t < nt; t += 2) {
            const bool last = (t == nt - 2);
            const char* a1 = cA + (size_t)(t + 1) * kstep;
            const char* a2 = last ? nA : cA + (size_t)(t + 2) * kstep; const char* b2 = last ? nB : cB + (size_t)(t + 2) * kstep;
            const char* a3 = a2 + kstep; const char* b3 = b2 + kstep;
            if (last && has_next) S.a_ready(nxt);
            if constexpr (SP2) {
            PG8_LDB(B0, 0, 0); PG8_LDB(B1, 0, 1); PG8_SCHED; PG8_LDA(At, 0, 0); PG8_STAGE(PG8_SA(1, 1), a1 + hstep, voffA);
            PG8_WAIT_V(8); PG8_WAIT_L(0); PG8_BAR; PG8_MMA(0, 0, At, B0); PG8_MMA(0, 1, At, B1); PG8_BAR; PG8_SCHED;
            PG8_LDA(At, 0, 1); PG8_STAGE(PG8_SB(0, 0), b2, voffB); PG8_STAGE(PG8_SB(0, 1), b2 + hstep, voffB); PG8_STAGE(PG8_SA(0, 0), a2, voffA);
            PG8_WAIT_V(8); PG8_WAIT_L(0); PG8_BAR; PG8_MMA(1, 0, At, B0); PG8_MMA(1, 1, At, B1); PG8_BAR; PG8_SCHED;
            PG8_LDB(B0, 1, 0); PG8_LDB(B1, 1, 1); PG8_SCHED; PG8_LDA(At, 1, 0); PG8_STAGE(PG8_SA(0, 1), a2 + hstep, voffA);
            PG8_WAIT_V(8); PG8_WAIT_L(0); PG8_BAR; PG8_MMA(0, 0, At, B0); PG8_MMA(0, 1, At, B1); PG8_BAR; PG8_SCHED;
            PG8_LDA(At, 1, 1); PG8_STAGE(PG8_SB(1, 0), b3, voffB); PG8_STAGE(PG8_SB(1, 1), b3 + hstep, voffB); PG8_STAGE(PG8_SA(1, 0), a3, voffA);
            PG8_WAIT_V(8); PG8_WAIT_L(0); PG8_BAR; PG8_MMA(1, 0, At, B0); PG8_MMA(1, 1, At, B1); PG8_BAR; PG8_SCHED;
            } else {
            PG8_LDB(B0, 0, 0); PG8_SCHED; PG8_LDA(At, 0, 0); PG8_STAGE(PG8_SA(1, 1), a1 + hstep, voffA);
            PG8_WAIT_L(8); PG8_BAR; PG8_WAIT_L(0); PG8_MMA(0, 0, At, B0); PG8_BAR; PG8_SCHED;
            PG8_LDB(B1, 0, 1); PG8_STAGE(PG8_SB(0, 0), b2, voffB);
            PG8_BAR; PG8_WAIT_L(0); PG8_MMA(0, 1, At, B1); PG8_BAR;
            PG8_LDA(At, 0, 1); PG8_STAGE(PG8_SA(0, 0), a2, voffA);
            PG8_BAR; PG8_WAIT_L(0); PG8_MMA(1, 0, At, B0); PG8_BAR; PG8_SCHED;
            PG8_STAGE(PG8_SB(0, 1), b2 + hstep, voffB);
            PG8_WAIT_V(6); PG8_BAR; PG8_MMA(1, 1, At, B1); PG8_BAR;
            PG8_LDB(B0, 1, 0); PG8_SCHED; PG8_LDA(At, 1, 0); PG8_STAGE(PG8_SA(0, 1), a2 + hstep, voffA);
            PG8_WAIT_L(8); PG8_BAR; PG8_WAIT_L(0); PG8_MMA(0, 0, At, B0); PG8_BAR; PG8_SCHED;
            PG8_LDB(B1, 1, 1); PG8_STAGE(PG8_SB(1, 0), b3, voffB);
            PG8_BAR; PG8_WAIT_L(0); PG8_MMA(0, 1, At, B1); PG8_BAR;
            PG8_LDA(At, 1, 1); PG8_STAGE(PG8_SA(1, 0), a3, voffA);
            PG8_BAR; PG8_WAIT_L(0); PG8_MMA(1, 0, At, B0); PG8_BAR; PG8_SCHED;
            PG8_STAGE(PG8_SB(1, 1), b3 + hstep, voffB);
            PG8_WAIT_V(6); PG8_BAR; PG8_MMA(1, 1, At, B1); PG8_BAR;
            }
        }
        if constexpr (ALIGN_EPI) { if (wr == 0) PG8_BAR; }
        if constexpr (!Epi::AFTER_DRAIN) { E(acc, cur, wr, wc, fr, fq); S.done(cur); }
        if (!has_next) break;
#pragma unroll
        for (int a = 0; a < 2; ++a)
#pragma unroll
            for (int b = 0; b < 2; ++b)
#pragma unroll
                for (int m = 0; m < 4; ++m)
#pragma unroll
                    for (int n = 0; n < 2; ++n) acc[a][b][m][n] = (f32x4){0.f, 0.f, 0.f, 0.f};
        cur = nxt; cA = nA; cB = nB; ++ui;
        if constexpr (ALIGN_EPI) { if (wr == 1) PG8_BAR; }
    }
    PG8_WAIT_V(0);
    if constexpr (!ALIGN_EPI) { if (wr == 0) PG8_BAR; }
    PG8_BAR;
    if constexpr (Epi::AFTER_DRAIN) { E.fused(acc, cur, wr, wc, fr, fq, lds, wid, lane); S.done(cur); }
#undef PG8_SA
#undef PG8_SB
#undef PG8_STAGE
#undef PG8_LDA
#undef PG8_LDB
#undef PG8_MMA
#undef PG8_WAIT_V
#undef PG8_WAIT_L
#undef PG8_BAR
#undef PG8_SCHED
}
}
#ifndef MK_N_LAUNCHES
#define MK_N_LAUNCHES 1
#endif
constexpr int NWAVES = 8, NTHREADS = 512;
constexpr int M = 16384, SEQ = 2048, D = 1024, FF = 2816, NGU = 2 * FF, NIN = 3336, NINP = 3584, PP = 3336, NLORA = 1536, KLORA = 256;
constexpr int NPHASE = 12;
constexpr size_t MiB = 1u << 20;
constexpr size_t WS_PART = 1 * MiB, WS_BONUS = 2 * MiB, WS_W1GU = 4 * MiB, WS_W1D = 15 * MiB, WS_WIN = 21 * MiB, WS_WOUT = 28 * MiB, WS_W2GU = 30 * MiB, WS_W2D = 41 * MiB, WS_WL = 47 * MiB;
constexpr size_t WS_XG = 48 * MiB;
constexpr size_t WS_P = 80 * MiB;
constexpr size_t WS_Y = 185 * MiB;
constexpr size_t WS_G = 217 * MiB;
constexpr size_t WS_LIN = 233 * MiB;
constexpr size_t WS_END = 241 * MiB;
constexpr int LDS_BYTES = 147456;

#define LAS __attribute__((address_space(3)))
typedef unsigned short bf16;
typedef unsigned v4u __attribute__((ext_vector_type(4)));
typedef unsigned v2u __attribute__((ext_vector_type(2)));
typedef float f32x4 __attribute__((ext_vector_type(4)));
typedef short bf16x8 __attribute__((ext_vector_type(8)));
#define LDS_WAIT() asm volatile("s_waitcnt lgkmcnt(0)" ::: "memory")
using pg8::cvt_pk_bf16;
__device__ __forceinline__ float bf_lo(unsigned u) { return __builtin_bit_cast(float, u << 16); }
__device__ __forceinline__ float bf_hi(unsigned u) { return __builtin_bit_cast(float, u & 0xffff0000u); }
__device__ __forceinline__ float bf1(bf16 s) { return __builtin_bit_cast(float, (unsigned)s << 16); }
__device__ __forceinline__ bf16 f2bf(float f) { return (bf16)(cvt_pk_bf16(f, 0.f) & 0xffffu); }
__device__ __forceinline__ f32x4 bf4(v2u u) { return (f32x4){bf_lo(u.x), bf_hi(u.x), bf_lo(u.y), bf_hi(u.y)}; }
__device__ __forceinline__ float sigm(float x) { return __builtin_amdgcn_rcpf(1.0f + __expf(-x)); }
__device__ __forceinline__ float wave_sum(float v) {
#pragma unroll
    for (int o = 1; o < 64; o <<= 1) v += __shfl_xor(v, o);
    return v;
}
template <int CTRL> __device__ __forceinline__ float dppf(float x) { return __builtin_bit_cast(float, __builtin_amdgcn_update_dpp(0, __builtin_bit_cast(int, x), CTRL, 0xf, 0xf, true)); }
__device__ __forceinline__ float allred16(float x) { x += dppf<0xB1>(x); x += dppf<0x4E>(x); x += dppf<0x124>(x); x += dppf<0x128>(x); return x; }

__device__ __forceinline__ void tr_item(const float* __restrict__ W, int N, int k0, int n0, bf16* dst, int dpitch, LAS float* scr, int lane) {
#pragma unroll 8
    for (int i = 0; i < 32; ++i) { const int kk = 2 * i + (lane >> 5), n = n0 + (lane & 31); scr[kk * 33 + (lane & 31)] = (n < N) ? W[(size_t)(k0 + kk) * N + n] : 0.f; }
    LDS_WAIT();
    const int c = lane & 7;
#pragma unroll
    for (int j = 0; j < 4; ++j) { const int n = (lane >> 3) + 8 * j; const LAS float* s = scr + (8 * c) * 33 + n;
        v4u o; o.x = cvt_pk_bf16(s[0 * 33], s[1 * 33]); o.y = cvt_pk_bf16(s[2 * 33], s[3 * 33]); o.z = cvt_pk_bf16(s[4 * 33], s[5 * 33]); o.w = cvt_pk_bf16(s[6 * 33], s[7 * 33]);
        *(v4u*)(dst + (size_t)n * dpitch + 8 * c) = o; }
    LDS_WAIT();
}
__device__ __forceinline__ void p0_prologue(LAS unsigned char* lds, const float* const* in, unsigned char* ws, int vcu, int G, int tid, int wave, int lane) {
    LAS float* scr = (LAS float*)(lds + wave * 16384);
    const int gw = vcu * NWAVES + wave, NGW = G * NWAVES;
    bf16* W1GU = (bf16*)(ws + WS_W1GU); bf16* W1D = (bf16*)(ws + WS_W1D); bf16* WIN = (bf16*)(ws + WS_WIN); bf16* WOUT = (bf16*)(ws + WS_WOUT);
    bf16* W2GU = (bf16*)(ws + WS_W2GU); bf16* W2D = (bf16*)(ws + WS_W2D); bf16* WL = (bf16*)(ws + WS_WL);
    constexpr int I_GU = 16 * 88, I_DN = 44 * 32, I_IN = 16 * 112, I_OUT = 16 * 32;
    constexpr int NITEMS = 6 * I_GU + I_IN + I_OUT + 64;
    for (int it = gw; it < NITEMS; it += NGW) {
        int r = it;
        if (r < 2 * I_GU) { const int up = r >= I_GU; r -= up * I_GU; const int kb = r / 88, n0 = 32 * (r % 88); tr_item(in[2 + up], FF, 64 * kb, n0, W1GU + (size_t)(256 * (n0 >> 7) + 128 * up + (n0 & 127)) * D + 64 * kb, D, scr, lane); continue; } r -= 2 * I_GU;
        if (r < I_DN) { const int kb = r / 32, n0 = 32 * (r % 32); tr_item(in[4], D, 64 * kb, n0, W1D + (size_t)n0 * FF + 64 * kb, FF, scr, lane); continue; } r -= I_DN;
        if (r < I_IN) { const int kb = r / 112, n0 = 32 * (r % 112); tr_item(in[6], NIN, 64 * kb, n0, WIN + (size_t)n0 * D + 64 * kb, D, scr, lane); continue; } r -= I_IN;
        if (r < I_OUT) { const int kb = r / 32, n0 = 32 * (r % 32); tr_item(in[24], D, 64 * kb, n0, WOUT + (size_t)n0 * D + 64 * kb, D, scr, lane); continue; } r -= I_OUT;
        if (r < 2 * I_GU) { const int up = r >= I_GU; r -= up * I_GU; const int kb = r / 88, n0 = 32 * (r % 88); tr_item(in[26 + up], FF, 64 * kb, n0, W2GU + (size_t)(256 * (n0 >> 7) + 128 * up + (n0 & 127)) * D + 64 * kb, D, scr, lane); continue; } r -= 2 * I_GU;
        if (r < I_DN) { const int kb = r / 32, n0 = 32 * (r % 32); tr_item(in[28], D, 64 * kb, n0, W2D + (size_t)n0 * FF + 64 * kb, FF, scr, lane); continue; } r -= I_DN;
        if (r < 16) { tr_item(in[9], 512, 0, 32 * r, WL + (size_t)(32 * r) * KLORA, KLORA, scr, lane); continue; } r -= 16;
        if (r < 16) { tr_item(in[11], 512, 0, 32 * r, WL + (size_t)(512 + 32 * r) * KLORA + 64, KLORA, scr, lane); continue; } r -= 16;
        { const int kb = r / 16, n0 = 32 * (r % 16); tr_item(in[12], 512, 64 * kb, n0, WL + (size_t)(1024 + n0) * KLORA + 128 + 64 * kb, KLORA, scr, lane); }
    }
    for (int id = vcu * NTHREADS + tid; id < NLORA * 32; id += G * NTHREADS) { const int row = id >> 5, col = 8 * (id & 31);
        const bool nz = (row < 512) ? (col < 64) : (row < 1024 ? (col >= 64 && col < 128) : (col >= 128));
        if (!nz) *(v4u*)(WL + (size_t)row * KLORA + col) = (v4u){0u, 0u, 0u, 0u}; }
    const float* x = in[0]; const float* g1 = in[1]; bf16* XG = (bf16*)(ws + WS_XG);
    f32x4 gv[4];
#pragma unroll
    for (int j = 0; j < 4; ++j) gv[j] = ((const f32x4*)g1)[64 * j + lane];
    for (int m = gw; m < M; m += NGW) {
        const f32x4* xr = (const f32x4*)(x + (size_t)m * D) + lane; f32x4 v[4]; float s = 0.f;
#pragma unroll
        for (int j = 0; j < 4; ++j) { v[j] = xr[64 * j]; s += (v[j].x * v[j].x + v[j].y * v[j].y) + (v[j].z * v[j].z + v[j].w * v[j].w); }
        const float rs = __builtin_amdgcn_rsqf(wave_sum(s) * (1.f / D) + 1e-6f);
        v2u* o8 = (v2u*)(XG + (size_t)m * D) + lane;
#pragma unroll
        for (int j = 0; j < 4; ++j) { const f32x4 w = v[j] * rs * gv[j]; v2u o; o.x = cvt_pk_bf16(w.x, w.y); o.y = cvt_pk_bf16(w.z, w.w); o8[64 * j] = o; }
    }
}
__device__ __forceinline__ void p4_lora_in(const bf16* P, const float* mu, bf16* LIN, int gtid, int NT) {
    for (int idx = gtid; idx < M * 32; idx += NT) {
        const int m = idx >> 5, cgp = idx & 31, t = m & (SEQ - 1);
        const bf16* pc = P + (size_t)m * PP + 1536 + 8 * cgp;
        const v4u cur = *(const v4u*)pc; v4u prv = (v4u){0u, 0u, 0u, 0u}; if (t) prv = *(const v4u*)(pc - PP);
        const f32x4 m0 = *(const f32x4*)(mu + 1536 + 8 * cgp), m1 = *(const f32x4*)(mu + 1540 + 8 * cgp);
        float xv[8];
#pragma unroll
        for (int e = 0; e < 4; ++e) { const unsigned cu = cur[e], pu = prv[e]; const float c0 = bf_lo(cu), c1 = bf_hi(cu), p0 = bf_lo(pu), p1 = bf_hi(pu);
            const float mA = (e < 2) ? m0[2 * e] : m1[2 * e - 4], mB = (e < 2) ? m0[2 * e + 1] : m1[2 * e - 3];
            xv[2 * e] = c0 + (p0 - c0) * mA; xv[2 * e + 1] = c1 + (p1 - c1) * mB; }
        if (cgp < 8) {
#pragma unroll
            for (int e = 0; e < 8; ++e) xv[e] = 2.f * sigm(2.f * xv[e]) - 1.f;
        } else if (cgp >= 16) {
#pragma unroll
            for (int e = 0; e < 8; ++e) xv[e] = sigm(xv[e]);
        }
        v4u o; o.x = cvt_pk_bf16(xv[0], xv[1]); o.y = cvt_pk_bf16(xv[2], xv[3]); o.z = cvt_pk_bf16(xv[4], xv[5]); o.w = cvt_pk_bf16(xv[6], xv[7]);
        *(v4u*)(LIN + (size_t)m * KLORA + 8 * cgp) = o;
    }
}
__device__ __forceinline__ void rwkv_scan_unit(LAS unsigned char* lds, int unit, const bf16* P, const bf16* EA, bf16* Y, float* BON,
                                               const float* mu, const float* k_k, const float* k_a, const float* r_k, const float* w0, const float* a0, int tid, int wave, int lane) {
    const int bh = unit >> 1, half = unit & 1, b = bh >> 3, h = bh & 7;
    LAS float* L = (LAS float*)lds;
    const int ts = tid >> 4, cg_ = tid & 15, c = 64 * h + 4 * cg_;
    const f32x4 mu_r = *(const f32x4*)(mu + c), mu_k = *(const f32x4*)(mu + 512 + c), mu_v = *(const f32x4*)(mu + 1024 + c);
    const f32x4 kk4 = *(const f32x4*)(k_k + c), ka4 = *(const f32x4*)(k_a + c), rk4 = *(const f32x4*)(r_k + c), w04 = *(const f32x4*)(w0 + c), a04 = *(const f32x4*)(a0 + c);
    const int rl = lane >> 4, cs = lane & 15, row = 4 * wave + rl;
    f32x4 S = (f32x4){0.f, 0.f, 0.f, 0.f};
    v2u cr, ck, cv, qr, qk, qv, ce, ca;
#define RW_LOAD(blk_) do { const int t_ = (blk_) * 32 + ts; const size_t m_ = (size_t)b * SEQ + t_; const bf16* pc_ = P + m_ * PP + c; \
        cr = *(const v2u*)pc_; ck = *(const v2u*)(pc_ + 512); cv = *(const v2u*)(pc_ + 1024); \
        if (t_) { qr = *(const v2u*)(pc_ - PP); qk = *(const v2u*)(pc_ - PP + 512); qv = *(const v2u*)(pc_ - PP + 1024); } else { qr = (v2u){0u, 0u}; qk = qr; qv = qr; } \
        ce = *(const v2u*)(EA + m_ * 1024 + c); ca = *(const v2u*)(EA + m_ * 1024 + 512 + c); } while (0)
#define RW_FLUSH(bk_) do { const LAS float* yb_ = L + ((bk_) & 1) * 12288 + 11264 + ts * 32 + 2 * cg_; const size_t m_ = (size_t)b * SEQ + (bk_) * 32 + ts; \
        *(unsigned*)(Y + m_ * 1024 + 64 * h + 32 * half + 2 * cg_) = cvt_pk_bf16(yb_[0], yb_[1]); } while (0)
    RW_LOAD(0);
    for (int blk = 0; blk < 64; ++blk) {
        LAS float* B0 = L + (blk & 1) * 12288;
        {
            const f32x4 r0 = bf4(cr), r1 = bf4(qr), k0 = bf4(ck), k1 = bf4(qk), v0 = bf4(cv), v1 = bf4(qv), ep = bf4(ce) + w04, ap = bf4(ca) + a04;
            f32x4 e, a; e.x = 0.60653066f * sigm(ep.x); e.y = 0.60653066f * sigm(ep.y); e.z = 0.60653066f * sigm(ep.z); e.w = 0.60653066f * sigm(ep.w); a.x = sigm(ap.x); a.y = sigm(ap.y); a.z = sigm(ap.z); a.w = sigm(ap.w);
            const f32x4 r = r0 + (r1 - r0) * mu_r, k = k0 + (k1 - k0) * mu_k, v = v0 + (v1 - v0) * mu_v;
            f32x4 kk = k * kk4; float ss = (kk.x * kk.x + kk.y * kk.y) + (kk.z * kk.z + kk.w * kk.w); ss = allred16(ss);
            const float inv = 1.0f / fmaxf(sqrtf(ss), 1e-12f); kk = kk * inv;
            const f32x4 km = k * (1.0f + (a - 1.0f) * ka4);
            f32x4 w; w.x = __expf(-e.x); w.y = __expf(-e.y); w.z = __expf(-e.z); w.w = __expf(-e.w);
            const f32x4 bv = kk * a, rb = r * km * rk4;
            float bon = (rb.x + rb.y) + (rb.z + rb.w); bon = allred16(bon);
            if (half == 0 && cg_ == 0) BON[((size_t)b * SEQ + blk * 32 + ts) * 8 + h] = bon;
            LAS float* d = B0 + ts * 64 + 4 * cg_;
            *(LAS f32x4*)(d) = r; *(LAS f32x4*)(d + 2048) = w; *(LAS f32x4*)(d + 4096) = km; *(LAS f32x4*)(d + 6144) = -kk; *(LAS f32x4*)(d + 8192) = bv;
            if ((cg_ >> 3) == half) *(LAS f32x4*)(B0 + 10240 + ts * 32 + 4 * (cg_ & 7)) = v;
        }
        __syncthreads();
        if (blk > 0) RW_FLUSH(blk - 1);
        if (blk < 63) RW_LOAD(blk + 1);
        const LAS float* Rp = B0 + 4 * cs;
#pragma unroll 4
        for (int s = 0; s < 32; ++s) {
            const f32x4 nk = *(const LAS f32x4*)(Rp + 6144 + 64 * s), w4 = *(const LAS f32x4*)(Rp + 2048 + 64 * s), b4 = *(const LAS f32x4*)(Rp + 8192 + 64 * s);
            const f32x4 k4 = *(const LAS f32x4*)(Rp + 4096 + 64 * s), r4 = *(const LAS f32x4*)(Rp + 64 * s); const float v = B0[10240 + 32 * s + row];
            float sa = (S.x * nk.x + S.y * nk.y) + (S.z * nk.z + S.w * nk.w); sa = allred16(sa);
            S = S * w4 + sa * b4 + v * k4;
            float y = (S.x * r4.x + S.y * r4.y) + (S.z * r4.z + S.w * r4.w); y = allred16(y);
            if (cs == 0) B0[11264 + 32 * s + row] = y;
        }
    }
    __syncthreads();
    RW_FLUSH(63);
    __syncthreads();
#undef RW_LOAD
#undef RW_FLUSH
}
__device__ __forceinline__ void ssd_unit(LAS unsigned char* lds, int unit, const bf16* P, bf16* Y, const float* conv_w, const float* conv_b,
                                         const float* dt_bias, const float* a_log, const float* d_skip, int tid, int wave, int lane) {
    const int bh = unit >> 1, ph = unit & 1, b = bh >> 3, h = bh & 7, g = h >> 2;
    LAS bf16* Cn = (LAS bf16*)(lds); LAS bf16* Bn = (LAS bf16*)(lds + 17408); LAS bf16* BdT = (LAS bf16*)(lds + 34816); LAS bf16* XT = (LAS bf16*)(lds + 53248);
    LAS bf16* Ms = (LAS bf16*)(lds + 57856); LAS bf16* ST = (LAS bf16*)(lds + 67072); LAS bf16* Xr = (LAS bf16*)(lds + 75776); LAS float* ACS = (LAS float*)(lds + 79872);
    for (int i = tid; i < 2176; i += NTHREADS) ((LAS unsigned*)ST)[i] = 0u;
    const float Ah = -__expf(a_log[h]), dtb = dt_bias[h], dsk = d_skip[h];
    f32x4 st[2]; st[0] = (f32x4){0.f, 0.f, 0.f, 0.f}; st[1] = st[0];
    const int r = lane & 15, q = lane >> 4;
    __syncthreads();
    for (int c = 0; c < 32; ++c) {
        const size_t m0 = (size_t)b * SEQ + 64 * c; const bf16* prow = P + (m0 + lane) * PP;
        const float xdt = bf1(prow[3328 + h]) + dtb; const float dt = xdt > 20.f ? xdt : log1pf(__expf(xdt));
        float acs = dt * Ah;
#pragma unroll
        for (int o = 1; o < 64; o <<= 1) { const float t = __shfl_up(acs, o); if (lane >= o) acs += t; }
        const float a_end = __shfl(acs, 63);
        if (wave == 0) ACS[lane] = acs;
        const float dte = __expf(a_end - acs);
        for (int i = 0; i < 5; ++i) { const int cgp = wave + 8 * i; if (cgp >= 36) break;
            const int chb = cgp < 4 ? 2304 + 64 * h + 32 * ph + 8 * cgp : (cgp < 20 ? 2816 + 128 * g + 8 * (cgp - 4) : 3072 + 128 * g + 8 * (cgp - 20));
            const int cw = chb - 2304;
            float o8[8];
#pragma unroll
            for (int e = 0; e < 8; ++e) o8[e] = conv_b[cw + e];
#pragma unroll
            for (int k = 0; k < 4; ++k) { const int tt = 64 * c + lane - 3 + k; v4u iv = (v4u){0u, 0u, 0u, 0u}; if (tt >= 0) iv = *(const v4u*)(prow + (ptrdiff_t)(k - 3) * PP + chb);
#pragma unroll
                for (int e = 0; e < 4; ++e) { o8[2 * e] += conv_w[k * 1024 + cw + 2 * e] * bf_lo(iv[e]); o8[2 * e + 1] += conv_w[k * 1024 + cw + 2 * e + 1] * bf_hi(iv[e]); } }
#pragma unroll
            for (int e = 0; e < 8; ++e) o8[e] = o8[e] * sigm(o8[e]);
            if (cgp < 4) {
#pragma unroll
                for (int e = 0; e < 8; ++e) XT[(8 * cgp + e) * 72 + lane] = f2bf(o8[e] * dt);
                v4u o; o.x = cvt_pk_bf16(o8[0], o8[1]); o.y = cvt_pk_bf16(o8[2], o8[3]); o.z = cvt_pk_bf16(o8[4], o8[5]); o.w = cvt_pk_bf16(o8[6], o8[7]);
                *(LAS v4u*)(Xr + lane * 32 + 8 * cgp) = o;
            } else if (cgp < 20) { const int n = 8 * (cgp - 4);
                v4u o; o.x = cvt_pk_bf16(o8[0], o8[1]); o.y = cvt_pk_bf16(o8[2], o8[3]); o.z = cvt_pk_bf16(o8[4], o8[5]); o.w = cvt_pk_bf16(o8[6], o8[7]);
                *(LAS v4u*)(Bn + lane * 136 + n) = o;
#pragma unroll
                for (int e = 0; e < 8; ++e) BdT[(n + e) * 72 + lane] = f2bf(o8[e] * dte);
            } else { const int n = 8 * (cgp - 20);
                v4u o; o.x = cvt_pk_bf16(o8[0], o8[1]); o.y = cvt_pk_bf16(o8[2], o8[3]); o.z = cvt_pk_bf16(o8[4], o8[5]); o.w = cvt_pk_bf16(o8[6], o8[7]);
                *(LAS v4u*)(Cn + lane * 136 + n) = o; }
        }
        __syncthreads();
        {
            const int lb = wave >> 1;
#pragma unroll
            for (int sbi = 0; sbi < 2; ++sbi) { const int sb = 2 * (wave & 1) + sbi;
                f32x4 acc = (f32x4){0.f, 0.f, 0.f, 0.f};
                if (sb <= lb) {
#pragma unroll
                    for (int kk = 0; kk < 4; ++kk) { const bf16x8 av = *(const LAS bf16x8*)(Cn + (16 * lb + r) * 136 + 32 * kk + 8 * q), bv = *(const LAS bf16x8*)(Bn + (16 * sb + r) * 136 + 32 * kk + 8 * q);
                        acc = __builtin_amdgcn_mfma_f32_16x16x32_bf16(av, bv, acc, 0, 0, 0); }
                }
                const int s = 16 * sb + r; const float as = ACS[s];
#pragma unroll
                for (int j = 0; j < 4; ++j) { const int l = 16 * lb + 4 * q + j; const float v = (l >= s && sb <= lb) ? acc[j] * __expf(ACS[l] - as) : 0.f; Ms[l * 72 + s] = f2bf(v); }
            }
        }
        __syncthreads();
        {
            const int lb = wave >> 1, pb = wave & 1;
            f32x4 accd = (f32x4){0.f, 0.f, 0.f, 0.f}, acco = accd;
#pragma unroll
            for (int kk = 0; kk < 2; ++kk) { const bf16x8 av = *(const LAS bf16x8*)(Ms + (16 * lb + r) * 72 + 32 * kk + 8 * q), bv = *(const LAS bf16x8*)(XT + (16 * pb + r) * 72 + 32 * kk + 8 * q);
                accd = __builtin_amdgcn_mfma_f32_16x16x32_bf16(av, bv, accd, 0, 0, 0); }
#pragma unroll
            for (int kk = 0; kk < 4; ++kk) { const bf16x8 av = *(const LAS bf16x8*)(Cn + (16 * lb + r) * 136 + 32 * kk + 8 * q), bv = *(const LAS bf16x8*)(ST + (16 * pb + r) * 136 + 32 * kk + 8 * q);
                acco = __builtin_amdgcn_mfma_f32_16x16x32_bf16(av, bv, acco, 0, 0, 0); }
            const int p = 16 * pb + r;
#pragma unroll
            for (int j = 0; j < 4; ++j) { const int l = 16 * lb + 4 * q + j; const float y = accd[j] + __expf(ACS[l]) * acco[j] + dsk * bf1(Xr[l * 32 + p]);
                Y[(m0 + l) * 1024 + 512 + 64 * h + 32 * ph + p] = f2bf(y); }
            const float dec = __expf(a_end);
#pragma unroll
            for (int i = 0; i < 2; ++i) { const int nb = 2 * (wave >> 1) + i; st[i] = st[i] * dec;
#pragma unroll
                for (int kk = 0; kk < 2; ++kk) { const bf16x8 av = *(const LAS bf16x8*)(XT + (16 * pb + r) * 72 + 32 * kk + 8 * q), bv = *(const LAS bf16x8*)(BdT + (16 * nb + r) * 72 + 32 * kk + 8 * q);
                    st[i] = __builtin_amdgcn_mfma_f32_16x16x32_bf16(av, bv, st[i], 0, 0, 0); } }
        }
        __syncthreads();
        { const int pb = wave & 1;
#pragma unroll
            for (int i = 0; i < 2; ++i) { const int nb = 2 * (wave >> 1) + i;
#pragma unroll
                for (int j = 0; j < 4; ++j) ST[(16 * pb + 4 * q + j) * 136 + 16 * nb + r] = f2bf(st[i][j]); } }
    }
    __syncthreads();
}
__device__ __forceinline__ void p7_post(const bf16* P, const bf16* G, const float* BON, bf16* Y, const float* mu, const float* gn_g, const float* gn_b, const float* ssm_norm, int gw, int NGW, int lane) {
    const int c8 = 8 * lane, h = lane >> 3;
    float gg[8], gb[8], muv[8], sn[8];
#pragma unroll
    for (int e = 0; e < 8; ++e) { gg[e] = gn_g[c8 + e]; gb[e] = gn_b[c8 + e]; muv[e] = mu[1024 + c8 + e]; sn[e] = ssm_norm[c8 + e]; }
    for (int m = gw; m < M; m += NGW) {
        const int t = m & (SEQ - 1);
        bf16* yr = Y + (size_t)m * 1024; const bf16* pr = P + (size_t)m * PP;
        const v4u yv = *(const v4u*)(yr + c8), gv = *(const v4u*)(G + (size_t)m * 512 + c8), vc = *(const v4u*)(pr + 1024 + c8);
        v4u vp = (v4u){0u, 0u, 0u, 0u}; if (t) vp = *(const v4u*)(pr - PP + 1024 + c8);
        const v4u ys = *(const v4u*)(yr + 512 + c8), zv = *(const v4u*)(pr + 1792 + c8);
        const float bon = BON[(size_t)m * 8 + h];
        float y[8], s = 0.f;
#pragma unroll
        for (int e = 0; e < 4; ++e) { y[2 * e] = bf_lo(yv[e]); y[2 * e + 1] = bf_hi(yv[e]); s += y[2 * e] + y[2 * e + 1]; }
        s += __shfl_xor(s, 1); s += __shfl_xor(s, 2); s += __shfl_xor(s, 4);
        const float mean = s * (1.f / 64.f); float qv_ = 0.f;
#pragma unroll
        for (int e = 0; e < 8; ++e) { y[e] -= mean; qv_ += y[e] * y[e]; }
        qv_ += __shfl_xor(qv_, 1); qv_ += __shfl_xor(qv_, 2); qv_ += __shfl_xor(qv_, 4);
        const float rstd = __builtin_amdgcn_rsqf(qv_ * (1.f / 64.f) + 64e-5f);
        float o[8];
#pragma unroll
        for (int e = 0; e < 4; ++e) {
            const float v0 = bf_lo(vc[e]), v1 = bf_hi(vc[e]), p0 = bf_lo(vp[e]), p1 = bf_hi(vp[e]);
            const float va = v0 + (p0 - v0) * muv[2 * e], vb = v1 + (p1 - v1) * muv[2 * e + 1];
            o[2 * e] = (y[2 * e] * rstd * gg[2 * e] + gb[2 * e] + bon * va) * bf_lo(gv[e]);
            o[2 * e + 1] = (y[2 * e + 1] * rstd * gg[2 * e + 1] + gb[2 * e + 1] + bon * vb) * bf_hi(gv[e]);
        }
        v4u w; w.x = cvt_pk_bf16(o[0], o[1]); w.y = cvt_pk_bf16(o[2], o[3]); w.z = cvt_pk_bf16(o[4], o[5]); w.w = cvt_pk_bf16(o[6], o[7]);
        *(v4u*)(yr + c8) = w;
        float u[8], ss = 0.f;
#pragma unroll
        for (int e = 0; e < 4; ++e) { const float z0 = bf_lo(zv[e]), z1 = bf_hi(zv[e]); u[2 * e] = bf_lo(ys[e]) * z0 * sigm(z0); u[2 * e + 1] = bf_hi(ys[e]) * z1 * sigm(z1); ss += u[2 * e] * u[2 * e] + u[2 * e + 1] * u[2 * e + 1]; }
        const float rs = __builtin_amdgcn_rsqf(wave_sum(ss) * (1.f / 512.f) + 1e-5f);
        v4u w2; w2.x = cvt_pk_bf16(u[0] * rs * sn[0], u[1] * rs * sn[1]); w2.y = cvt_pk_bf16(u[2] * rs * sn[2], u[3] * rs * sn[3]); w2.z = cvt_pk_bf16(u[4] * rs * sn[4], u[5] * rs * sn[5]); w2.w = cvt_pk_bf16(u[6] * rs * sn[6], u[7] * rs * sn[7]);
        *(v4u*)(yr + 512 + c8) = w2;
    }
}
__device__ __forceinline__ void p11_final(float* out, const float* part, const float* gf, int gw, int NGW, int lane) {
    f32x4 gv[4];
#pragma unroll
    for (int j = 0; j < 4; ++j) gv[j] = ((const f32x4*)gf)[64 * j + lane];
    for (int m = gw; m < M; m += NGW) {
        const float rs = pg8::row_rscale(part, m);
        f32x4* xr = (f32x4*)(out + (size_t)m * D) + lane;
#pragma unroll
        for (int j = 0; j < 4; ++j) xr[64 * j] = xr[64 * j] * rs * gv[j];
    }
}

struct Args { const float* in[30]; float* out; unsigned char* ws; int ph_lo, ph_hi; };
__global__ void __launch_bounds__(NTHREADS, 2) fwd_kernel(Args args) {
    extern __shared__ __attribute__((aligned(16))) unsigned char lds_raw[];
    LAS unsigned char* lds = (LAS unsigned char*)lds_raw;
    const int tid = threadIdx.x, lane = tid & 63, wave = __builtin_amdgcn_readfirstlane(tid >> 6);
    const int G = gridDim.x, bx = blockIdx.x; const int vcu = (G % 8 == 0) ? (bx % 8) * (G / 8) + bx / 8 : bx;
    const int gw = vcu * NWAVES + wave, NGW = G * NWAVES;
    unsigned char* ws = args.ws;
    const float* const* in = args.in;
    bf16* W1GU = (bf16*)(ws + WS_W1GU); bf16* W1D = (bf16*)(ws + WS_W1D); bf16* WIN = (bf16*)(ws + WS_WIN); bf16* WOUT = (bf16*)(ws + WS_WOUT);
    bf16* W2GU = (bf16*)(ws + WS_W2GU); bf16* W2D = (bf16*)(ws + WS_W2D); bf16* WL = (bf16*)(ws + WS_WL);
    bf16* XG = (bf16*)(ws + WS_XG); bf16* PB = (bf16*)(ws + WS_P); bf16* YB = (bf16*)(ws + WS_Y); bf16* GB = (bf16*)(ws + WS_G); bf16* LIN = (bf16*)(ws + WS_LIN);
    float* PART = (float*)(ws + WS_PART); float* BON = (float*)(ws + WS_BONUS);
    const int lo = args.ph_lo, hi = args.ph_hi;
    cg::grid_group grid = cg::this_grid();
#ifndef PH_MASK
#define PH_MASK 0xfff
#endif
#define IN(k) (((PH_MASK >> (k)) & 1) && lo <= (k) && (k) < hi)
#define SEAM(k) do { if (IN(k) && IN((k) + 1)) grid.sync(); } while (0)
    if (IN(0)) { p0_prologue(lds, in, ws, vcu, G, tid, wave, lane); SEAM(0); }
    if (IN(1)) {
        pg8::Gemm g{XG, W1GU, M, NGU, D}; pg8::StaticOrder S; S.init(M, NGU, G, bx);
        pg8::EpiSwiGLU E{PB, FF, nullptr};
        pg8::gemm_phase<pg8::EpiSwiGLU, pg8::StaticOrder, true, true>(lds, g, S, E);
        SEAM(1);
    }
    if (IN(2)) {
        pg8::Gemm g{PB, W1D, M, D, FF}; pg8::StaticOrder S; S.init(M, D, G, bx);
        pg8::EpiResid E{in[0], args.out, in[5], XG, PART, 0.5f};
        pg8::gemm_phase<pg8::EpiResid, pg8::StaticOrder, true, true>(lds, g, S, E);
        SEAM(2);
    }
    if (IN(3)) {
        pg8::Gemm g{XG, WIN, M, NINP, D}; pg8::StaticOrder S; S.init(M, NINP, G, bx);
        pg8::EpiScaleBf16 E{PB, PP, NIN, PART};
        pg8::gemm_phase<pg8::EpiScaleBf16, pg8::StaticOrder, true, true>(lds, g, S, E);
        SEAM(3);
    }
    if (IN(4)) { p4_lora_in(PB, in[7], LIN, vcu * NTHREADS + tid, G * NTHREADS); SEAM(4); }
    if (IN(5)) {
        int kl = KLORA; asm volatile("" : "+s"(kl));
        pg8::Gemm g{LIN, WL, M, NLORA, kl}; pg8::StaticOrder S; S.init(M, NLORA, G, bx);
        pg8::EpiLora E{XG, GB};
        pg8::gemm_phase<pg8::EpiLora, pg8::StaticOrder, true, true>(lds, g, S, E);
        SEAM(5);
    }
    if (IN(6)) {
        for (int u = vcu; u < 256; u += G) {
            if (u < 128) rwkv_scan_unit(lds, u, PB, XG, YB, BON, in[7], in[13], in[14], in[15], in[8], in[10], tid, wave, lane);
            else ssd_unit(lds, u - 128, PB, YB, in[18], in[19], in[20], in[21], in[22], tid, wave, lane);
        }
        SEAM(6);
    }
    if (IN(7)) { p7_post(PB, GB, BON, YB, in[7], in[16], in[17], in[23], gw, NGW, lane); SEAM(7); }
    if (IN(8)) {
        pg8::Gemm g{YB, WOUT, M, D, D}; pg8::StaticOrder S; S.init(M, D, G, bx);
        pg8::EpiResid E{args.out, args.out, in[25], XG, PART, 1.0f};
        pg8::gemm_phase<pg8::EpiResid, pg8::StaticOrder, true, true>(lds, g, S, E);
        SEAM(8);
    }
    if (IN(9)) {
        pg8::Gemm g{XG, W2GU, M, NGU, D}; pg8::StaticOrder S; S.init(M, NGU, G, bx);
        pg8::EpiSwiGLU E{PB, FF, PART};
        pg8::gemm_phase<pg8::EpiSwiGLU, pg8::StaticOrder, true, true>(lds, g, S, E);
        SEAM(9);
    }
    if (IN(10)) {
        pg8::Gemm g{PB, W2D, M, D, FF}; pg8::StaticOrder S; S.init(M, D, G, bx);
        pg8::EpiResid E{args.out, args.out, nullptr, nullptr, PART, 0.5f};
        pg8::gemm_phase<pg8::EpiResid, pg8::StaticOrder, true, true>(lds, g, S, E);
        SEAM(10);
    }
    if (IN(11)) p11_final(args.out, PART, in[29], gw, NGW, lane);
#undef IN
#undef SEAM
}

extern "C" void kernel_launch(void* const* d_in, const int* in_sizes, int n_in, void* d_out, int out_size, void* d_ws, size_t ws_size, hipStream_t stream) {
    static int grid = 0;
    if (grid == 0) {
        if (n_in != 30 || out_size != M * D || ws_size < WS_END) { fprintf(stderr, "kernel_launch: unexpected shapes (n_in %d out %d ws %zu)\n", n_in, out_size, ws_size); grid = -1; return; }
        int dev = 0, cus = 0, per_cu = 0;
        hipGetDevice(&dev); hipDeviceGetAttribute(&cus, hipDeviceAttributeMultiprocessorCount, dev);
        if (hipFuncSetAttribute((const void*)fwd_kernel, hipFuncAttributeMaxDynamicSharedMemorySize, LDS_BYTES) != hipSuccess) { fprintf(stderr, "kernel_launch: hipFuncSetAttribute failed\n"); grid = -1; return; }
        hipOccupancyMaxActiveBlocksPerMultiprocessor(&per_cu, (const void*)fwd_kernel, NTHREADS, LDS_BYTES);
        (void)hipGetLastError();
        if (per_cu < 1) per_cu = 1;
        grid = cus * 1;
        if (grid != 256) fprintf(stderr, "kernel_launch: note: grid %d\n", grid);
    }
    if (grid < 0) return;
    Args a{};
    for (int i = 0; i < 30; ++i) a.in[i] = (const float*)d_in[i];
    a.out = (float*)d_out; a.ws = (unsigned char*)d_ws;
#if MK_N_LAUNCHES == 1
    a.ph_lo = 0; a.ph_hi = NPHASE;
    void* kargs[] = {&a};
    hipError_t e = hipLaunchCooperativeKernel((const void*)fwd_kernel, dim3(grid), dim3(NTHREADS), kargs, LDS_BYTES, stream);
    if (e != hipSuccess) fprintf(stderr, "cooperative launch failed: %s (grid %d)\n", hipGetErrorString(e), grid);
#else
    for (int p = 0; p < NPHASE; ++p) { a.ph_lo = p; a.ph_hi = p + 1; hipLaunchKernelGGL(fwd_kernel, dim3(grid), dim3(NTHREADS), LDS_BYTES, stream, a); }
#endif
}
```

```cpp
#include <hip/hip_runtime.h>
#include <hip/hip_cooperative_groups.h>
#include <cstdio>
#include <cstdint>
namespace cg = cooperative_groups;
#define MK_N_LAUNCHES 1
namespace pg8 {
#define PG8_LAS __attribute__((address_space(3)))
typedef unsigned short bf16_t;
typedef short bf16x8 __attribute__((ext_vector_type(8)));
typedef float f32x4 __attribute__((ext_vector_type(4)));
typedef unsigned u32x4 __attribute__((ext_vector_type(4)));
constexpr int BM = 256, BK = 64, HALF = 128, HTB = HALF * BK * 2  , STAGE_BYTES = 8 * HTB, NXCD = 8, WGM = 8;

__host__ __device__ __forceinline__ int lds_byte(int r, int c) { const int st = (r >> 4) * 2 + (c >> 5), rr = r & 15, cc = c & 31, ob = rr * 64 + cc * 2; return st * 1024 + (ob ^ (((ob >> 9) & 1) << 5)); }
__host__ __device__ __forceinline__ void stage_rc(int b, int& R, int& C) { const int st = b / 1024, sb = b % 1024, swz = sb ^ (((sb >> 9) & 1) << 5); R = (st >> 1) * 16 + swz / 64; C = (st & 1) * 32 + (swz % 64) / 2; }
__host__ __device__ __forceinline__ int perm32(int rho) { const int n = rho >> 4, i = rho & 15; return 8 * (i >> 2) + 4 * n + (i & 3); }

struct Unit { int pm, pn; };
struct Gemm { const bf16_t* A; const bf16_t* Bt; int M, N, K; int ld; };

struct StaticOrder {
    int nM, nN, nwg, G, c;
    __host__ __device__ void init(int M, int N, int G_, int c_) { nM = M / BM; nN = N / BM; nwg = nM * nN; G = G_; c = c_; }
    __host__ __device__ bool next(int i, Unit& u) const {
        const long L = (long)i * G + c; if (L >= nwg) return false;
        int wgid = (int)L; { const int q = nwg / NXCD, r = nwg % NXCD, xcd = wgid % NXCD, off = wgid / NXCD; wgid = (xcd < r ? xcd * (q + 1) : r * (q + 1) + (xcd - r) * q) + off; }
        const int nig = WGM * nN, gid = wgid / nig, fm = gid * WGM, gsz = (nM - fm) < WGM ? (nM - fm) : WGM;
        u.pm = fm + ((wgid % nig) % gsz); u.pn = (wgid % nig) / gsz; return true;
    }
    __device__ __forceinline__ void a_ready(const Unit&) const {}
    __device__ __forceinline__ void done(const Unit&) const {}
};
typedef float f32x2c_ __attribute__((ext_vector_type(2)));
typedef __bf16 bf16x2c_ __attribute__((ext_vector_type(2)));
__device__ __forceinline__ unsigned cvt_pk_bf16(float lo, float hi) { const f32x2c_ v = {lo, hi}; const bf16x2c_ b = __builtin_convertvector(v, bf16x2c_); return __builtin_bit_cast(unsigned, b); }
typedef unsigned u32x2 __attribute__((ext_vector_type(2)));
__device__ __forceinline__ float sigmoidf_(float x) { return __builtin_amdgcn_rcpf(1.0f + __expf(-x)); }
__device__ __forceinline__ float row_rscale(const float* part, int row) {
    const f32x4* p = (const f32x4*)(part + (size_t)row * 16);
    const f32x4 a = p[0], b = p[1], c = p[2], d = p[3];
    const f32x4 s = (a + b) + (c + d);
    return __builtin_amdgcn_rsqf(((s[0] + s[1]) + (s[2] + s[3])) * (1.0f / 1024.0f) + 1e-6f);
}
struct EpiSwiGLU {
    static constexpr bool PERM = true, AFTER_DRAIN = false;
    bf16_t* O; int ldc; const float* part;
    __device__ __forceinline__ void operator()(const f32x4 (&acc)[2][2][4][2], const Unit& u, int wr, int wc, int fr, int fq) const {
        const int row0 = u.pm * BM + wr * 64 + fr, col0 = u.pn * HALF + wc * 32 + 8 * fq;
#pragma unroll
        for (int ai = 0; ai < 2; ++ai)
#pragma unroll
            for (int m = 0; m < 4; ++m) {
                const int row = row0 + ai * HALF + m * 16;
                const float rs = part ? row_rscale(part, row) : 1.0f;
                float h[8];
#pragma unroll
                for (int n = 0; n < 2; ++n)
#pragma unroll
                    for (int j = 0; j < 4; ++j) { const float g = acc[ai][0][m][n][j] * rs, up = acc[ai][1][m][n][j] * rs; h[4 * n + j] = g * sigmoidf_(g) * up; }
                u32x4 w; w.x = cvt_pk_bf16(h[0], h[1]); w.y = cvt_pk_bf16(h[2], h[3]); w.z = cvt_pk_bf16(h[4], h[5]); w.w = cvt_pk_bf16(h[6], h[7]);
                *(u32x4*)(O + (size_t)row * ldc + col0) = w;
            }
    }
};
struct EpiScaleBf16 {
    static constexpr bool PERM = true, AFTER_DRAIN = false;
    bf16_t* O; int ldc; int ncols; const float* part;
    __device__ __forceinline__ void operator()(const f32x4 (&acc)[2][2][4][2], const Unit& u, int wr, int wc, int fr, int fq) const {
        const int row0 = u.pm * BM + wr * 64 + fr, col0 = u.pn * BM + wc * 32 + 8 * fq;
#pragma unroll
        for (int ai = 0; ai < 2; ++ai)
#pragma unroll
            for (int m = 0; m < 4; ++m) {
                const int row = row0 + ai * HALF + m * 16; const float rs = row_rscale(part, row);
#pragma unroll
                for (int bj = 0; bj < 2; ++bj) { const int col = col0 + bj * HALF;
                    if (col < ncols) { const f32x4 v0 = acc[ai][bj][m][0] * rs, v1 = acc[ai][bj][m][1] * rs;
                        u32x4 w; w.x = cvt_pk_bf16(v0[0], v0[1]); w.y = cvt_pk_bf16(v0[2], v0[3]); w.z = cvt_pk_bf16(v1[0], v1[1]); w.w = cvt_pk_bf16(v1[2], v1[3]);
                        *(u32x4*)(O + (size_t)row * ldc + col) = w; } }
            }
    }
};
struct EpiLora {
    static constexpr bool PERM = true, AFTER_DRAIN = false;
    bf16_t* EA; bf16_t* G;
    __device__ __forceinline__ void operator()(const f32x4 (&acc)[2][2][4][2], const Unit& u, int wr, int wc, int fr, int fq) const {
        const int row0 = u.pm * BM + wr * 64 + fr, colt = (u.pn & 3) * BM + wc * 32 + 8 * fq;
        bf16_t* base = u.pn < 4 ? EA : G; const int ldc = u.pn < 4 ? 1024 : 512;
#pragma unroll
        for (int ai = 0; ai < 2; ++ai)
#pragma unroll
            for (int m = 0; m < 4; ++m) {
                bf16_t* rowp = base + (size_t)(row0 + ai * HALF + m * 16) * ldc + colt;
#pragma unroll
                for (int bj = 0; bj < 2; ++bj) { const f32x4 v0 = acc[ai][bj][m][0], v1 = acc[ai][bj][m][1];
                    u32x4 w; w.x = cvt_pk_bf16(v0[0], v0[1]); w.y = cvt_pk_bf16(v0[2], v0[3]); w.z = cvt_pk_bf16(v1[0], v1[1]); w.w = cvt_pk_bf16(v1[2], v1[3]);
                    *(u32x4*)(rowp + bj * HALF) = w; }
            }
    }
};

struct EpiLoraG {
    static constexpr bool PERM = true, AFTER_DRAIN = false;
    bf16_t* G;
    __device__ __forceinline__ void operator()(const f32x4 (&acc)[2][2][4][2], const Unit& u, int wr, int wc, int fr, int fq) const {
        const int row0 = u.pm * BM + wr * 64 + fr, colt = u.pn * BM + wc * 32 + 8 * fq;
#pragma unroll
        for (int ai = 0; ai < 2; ++ai)
#pragma unroll
            for (int m = 0; m < 4; ++m) {
                bf16_t* rowp = G + (size_t)(row0 + ai * HALF + m * 16) * 512 + colt;
#pragma unroll
                for (int bj = 0; bj < 2; ++bj) { const f32x4 v0 = acc[ai][bj][m][0], v1 = acc[ai][bj][m][1];
                    u32x4 w; w.x = cvt_pk_bf16(v0[0], v0[1]); w.y = cvt_pk_bf16(v0[2], v0[3]); w.z = cvt_pk_bf16(v1[0], v1[1]); w.w = cvt_pk_bf16(v1[2], v1[3]);
                    *(u32x4*)(rowp + bj * HALF) = w; }
            }
    }
};
__device__ __forceinline__ f32x4 bf4_(u32x2 u) { return (f32x4){__builtin_bit_cast(float, u.x << 16), __builtin_bit_cast(float, u.x & 0xffff0000u), __builtin_bit_cast(float, u.y << 16), __builtin_bit_cast(float, u.y & 0xffff0000u)}; }
template <bool BASE_BF16> struct EpiResidB {
    static constexpr bool PERM = false, AFTER_DRAIN = false;
    const void* base; bf16_t* xo; bf16_t* xo2; float* part; float scale;
    const float* unrs; const float* ungain;
    __device__ __forceinline__ void operator()(const f32x4 (&acc)[2][2][4][2], const Unit& u, int wr, int wc, int fr, int fq) const {
#pragma unroll
        for (int ai = 0; ai < 2; ++ai)
#pragma unroll
            for (int m = 0; m < 4; ++m) {
                const int row = u.pm * BM + ai * HALF + wr * 64 + m * 16 + fr; float ss = 0.f;
                const float irs = unrs ? __builtin_amdgcn_rcpf(unrs[row]) : 1.0f;
#pragma unroll
                for (int bj = 0; bj < 2; ++bj)
#pragma unroll
                    for (int n = 0; n < 2; ++n) {
                        const int col = u.pn * BM + bj * HALF + wc * 32 + n * 16 + 4 * fq; const size_t off = (size_t)row * 1024 + col;
                        f32x4 bs = BASE_BF16 ? bf4_(*(const u32x2*)((const bf16_t*)base + off)) : *(const f32x4*)((const float*)base + off);
                        if (unrs) { const f32x4 gi = *(const f32x4*)(ungain + col); bs = bs * irs * (f32x4){__builtin_amdgcn_rcpf(gi[0]), __builtin_amdgcn_rcpf(gi[1]), __builtin_amdgcn_rcpf(gi[2]), __builtin_amdgcn_rcpf(gi[3])}; }
                        const f32x4 v = bs + acc[ai][bj][m][n] * scale;
                        ss += (v[0] * v[0] + v[1] * v[1]) + (v[2] * v[2] + v[3] * v[3]);
                        u32x2 o; o.x = cvt_pk_bf16(v[0], v[1]); o.y = cvt_pk_bf16(v[2], v[3]); *(u32x2*)(xo + off) = o; if (xo2) *(u32x2*)(xo2 + off) = o;
                    }
                ss += __shfl_xor(ss, 16); ss += __shfl_xor(ss, 32);
                if (fq == 0) part[(size_t)row * 16 + u.pn * 4 + wc] = ss;
            }
    }
};
struct EpiResidNormFinal {
    static constexpr bool PERM = false, AFTER_DRAIN = true;
    const bf16_t* base; float* out; const float* gain; float* xbuf; unsigned* cnt; float scale;
    __device__ __forceinline__ void fused(f32x4 (&acc)[2][2][4][2], const Unit& u, int wr, int wc, int fr, int fq, PG8_LAS unsigned char* lds, int wid, int lane) const {
        PG8_LAS float* Pw = (PG8_LAS float*)lds;
        PG8_LAS float* Sr = (PG8_LAS float*)(lds + 4096);
#pragma unroll
        for (int ai = 0; ai < 2; ++ai)
#pragma unroll
            for (int m = 0; m < 4; ++m) {
                const int rl = ai * HALF + wr * 64 + m * 16 + fr; const size_t rowoff = (size_t)(u.pm * BM + rl) * 1024; float ss = 0.f;
#pragma unroll
                for (int bj = 0; bj < 2; ++bj)
#pragma unroll
                    for (int n = 0; n < 2; ++n) { const int col = u.pn * BM + bj * HALF + wc * 32 + n * 16 + 4 * fq;
                        const f32x4 v = bf4_(*(const u32x2*)(base + rowoff + col)) + acc[ai][bj][m][n] * scale; acc[ai][bj][m][n] = v;
                        ss += (v[0] * v[0] + v[1] * v[1]) + (v[2] * v[2] + v[3] * v[3]); }
                ss += __shfl_xor(ss, 16); ss += __shfl_xor(ss, 32);
                if (fq == 0) Pw[rl * 4 + wc] = ss;
                asm volatile("" : "+v"(acc[ai][0][m][0]), "+v"(acc[ai][0][m][1]), "+v"(acc[ai][1][m][0]), "+v"(acc[ai][1][m][1]));
                if (m & 1) asm volatile("" ::: "memory");
            }
        asm volatile("s_waitcnt lgkmcnt(0)" ::: "memory"); __builtin_amdgcn_s_barrier(); asm volatile("" ::: "memory");
        const int row = wid * 32 + (lane & 31);
        if (lane < 32) { const f32x4 pp = *(const PG8_LAS f32x4*)(Pw + row * 4); const float t = (pp[0] + pp[1]) + (pp[2] + pp[3]);
            __hip_atomic_store(xbuf + (size_t)(u.pm * BM + row) * 4 + u.pn, t, __ATOMIC_RELAXED, __HIP_MEMORY_SCOPE_AGENT); }
        asm volatile("s_waitcnt vmcnt(0)" ::: "memory");
        if (lane == 0) __hip_atomic_fetch_add(cnt + 64 * u.pm, 1u, __ATOMIC_RELAXED, __HIP_MEMORY_SCOPE_AGENT);
        if (wid == 0) {
            unsigned sp = 0;
            while ((unsigned)__builtin_amdgcn_readfirstlane(__hip_atomic_load(cnt + 64 * u.pm, __ATOMIC_RELAXED, __HIP_MEMORY_SCOPE_AGENT)) < 32u) { __builtin_amdgcn_s_sleep(2); if (++sp > (1u << 22)) break; }
            __builtin_amdgcn_fence(__ATOMIC_ACQUIRE, "agent");
        }
        asm volatile("s_waitcnt vmcnt(0) lgkmcnt(0)" ::: "memory"); __builtin_amdgcn_s_barrier(); asm volatile("" ::: "memory");
        if (lane < 32) { const float* sl = xbuf + (size_t)(u.pm * BM + row) * 4; float t = 0.f;
#pragma unroll
            for (int k = 0; k < 4; ++k) t += __hip_atomic_load(sl + k, __ATOMIC_RELAXED, __HIP_MEMORY_SCOPE_AGENT);
            Sr[row] = __builtin_amdgcn_rsqf(t * (1.0f / 1024.0f) + 1e-6f); }
        asm volatile("s_waitcnt vmcnt(0) lgkmcnt(0)" ::: "memory"); __builtin_amdgcn_s_barrier(); asm volatile("" ::: "memory");
#pragma unroll
        for (int ai = 0; ai < 2; ++ai)
#pragma unroll
            for (int m = 0; m < 4; ++m) {
                const int rl = ai * HALF + wr * 64 + m * 16 + fr; const size_t rowoff = (size_t)(u.pm * BM + rl) * 1024; const float rs = Sr[rl];
#pragma unroll
                for (int bj = 0; bj < 2; ++bj)
#pragma unroll
                    for (int n = 0; n < 2; ++n) { const int col = u.pn * BM + bj * HALF + wc * 32 + n * 16 + 4 * fq;
                        *(f32x4*)(out + rowoff + col) = acc[ai][bj][m][n] * rs * *(const f32x4*)(gain + col); }
            }
    }
};

template <class Epi, class Sched, bool ALIGN_EPI = false, bool SP2 = false>
__device__ __forceinline__ void gemm_phase(PG8_LAS unsigned char* lds, const Gemm g, const Sched& S, const Epi& E) {
    const int tid = threadIdx.x, wid = __builtin_amdgcn_readfirstlane(tid >> 6), lane = tid & 63, wr = wid >> 2, wc = wid & 3, fr = lane & 15, fq = lane >> 4;
    const int K = g.K, nt = K / BK, LD = g.ld ? g.ld : g.K;
    unsigned voffA[2], voffB[2];
#pragma unroll
    for (int i = 0; i < 2; ++i) { int R, C; stage_rc(tid * 16 + i * 8192, R, C); const int Rb = Epi::PERM ? ((R & ~31) + perm32(R & 31)) : R;
        voffA[i] = (unsigned)(R * LD + C) * 2u; voffB[i] = (unsigned)(Rb * LD + C) * 2u; }
    const size_t kstep = (size_t)(BK * 2);
    const size_t hstep = (size_t)HALF * LD * 2;
    const size_t tstep = 2 * hstep;
    const unsigned ldsw = (unsigned)wid * 1024u;
    const int aoff = lds_byte(wr * 64 + fr, fq * 8), boff = lds_byte(wc * 32 + fr, fq * 8);
#define PG8_SA(b, h) (((b) * 2 + (h)) * HTB)
#define PG8_SB(b, h) ((4 + (b) * 2 + (h)) * HTB)
#define PG8_STAGE(bufoff, gbase, voff) do { _Pragma("unroll") for (int _i = 0; _i < 2; ++_i) \
        __builtin_amdgcn_global_load_lds((const unsigned*)((const char*)(gbase) + (voff)[_i]), (PG8_LAS unsigned*)(lds + (bufoff) + ldsw + _i * 8192), 16, 0, 0); } while (0)
#define PG8_LDA(dst, b, h) do { _Pragma("unroll") for (int m = 0; m < 4; ++m) _Pragma("unroll") for (int k = 0; k < 2; ++k) dst[m][k] = *(const PG8_LAS bf16x8*)(lds + PG8_SA(b, h) + aoff + m * 2048 + k * 1024); } while (0)
#define PG8_LDB(dst, b, h) do { _Pragma("unroll") for (int n = 0; n < 2; ++n) _Pragma("unroll") for (int k = 0; k < 2; ++k) dst[n][k] = *(const PG8_LAS bf16x8*)(lds + PG8_SB(b, h) + boff + n * 2048 + k * 1024); } while (0)
#define PG8_MMA(ai, bj, At, Bt) do { __builtin_amdgcn_s_setprio(1); _Pragma("unroll") for (int m = 0; m < 4; ++m) _Pragma("unroll") for (int n = 0; n < 2; ++n) _Pragma("unroll") for (int k = 0; k < 2; ++k) \
        acc[ai][bj][m][n] = __builtin_amdgcn_mfma_f32_16x16x32_bf16(Bt[n][k], At[m][k], acc[ai][bj][m][n], 0, 0, 0); __builtin_amdgcn_s_setprio(0); } while (0)
#define PG8_WAIT_V(n) asm volatile("s_waitcnt vmcnt(" #n ")" ::: "memory")
#define PG8_WAIT_L(n) asm volatile("s_waitcnt lgkmcnt(" #n ")" ::: "memory")
#define PG8_BAR __builtin_amdgcn_s_barrier()
#define PG8_SCHED __builtin_amdgcn_sched_barrier(0)
    Unit cur, nxt; int ui = 0;
    if (!S.next(0, cur)) return;
    f32x4 acc[2][2][4][2];
#pragma unroll
    for (int a = 0; a < 2; ++a)
#pragma unroll
        for (int b = 0; b < 2; ++b)
#pragma unroll
            for (int m = 0; m < 4; ++m)
#pragma unroll
                for (int n = 0; n < 2; ++n) acc[a][b][m][n] = (f32x4){0.f, 0.f, 0.f, 0.f};
    bf16x8 At[4][2], B0[2][2], B1[2][2];
    const char* cA = (const char*)g.A + (size_t)cur.pm * tstep; const char* cB = (const char*)g.Bt + (size_t)cur.pn * tstep;
    S.a_ready(cur);
    if constexpr (SP2) {
        PG8_STAGE(PG8_SB(0, 0), cB, voffB); PG8_STAGE(PG8_SB(0, 1), cB + hstep, voffB); PG8_STAGE(PG8_SA(0, 0), cA, voffA); PG8_STAGE(PG8_SA(0, 1), cA + hstep, voffA);
        if (wr == 1) PG8_BAR;
        PG8_WAIT_V(2); PG8_BAR;
        PG8_STAGE(PG8_SB(1, 0), cB + kstep, voffB); PG8_STAGE(PG8_SA(1, 0), cA + kstep, voffA); PG8_STAGE(PG8_SB(1, 1), cB + hstep + kstep, voffB);
        PG8_WAIT_V(6); PG8_BAR;
    } else {
        PG8_STAGE(PG8_SB(0, 0), cB, voffB); PG8_STAGE(PG8_SA(0, 0), cA, voffA); PG8_STAGE(PG8_SB(0, 1), cB + hstep, voffB); PG8_STAGE(PG8_SA(0, 1), cA + hstep, voffA);
        if (wr == 1) PG8_BAR;
        PG8_WAIT_V(4); PG8_BAR;
        PG8_STAGE(PG8_SB(1, 0), cB + kstep, voffB); PG8_STAGE(PG8_SA(1, 0), cA + kstep, voffA); PG8_STAGE(PG8_SB(1, 1), cB + hstep + kstep, voffB);
        PG8_WAIT_V(6); PG8_BAR;
    }
    for (;;) {
        const bool has_next = S.next(ui + 1, nxt);
        const char* nA = has_next ? (const char*)g.A + (size_t)nxt.pm * tstep : cA; const char* nB = has_next ? (const char*)g.Bt + (size_t)nxt.pn * tstep : cB;
        for (int t = 0; t < nt; t += 2) {
            const bool last = (t == nt - 2);
            const char* a1 = cA + (size_t)(t + 1) * kstep;
            const char* a2 = last ? nA : cA + (size_t)(t + 2) * kstep; const char* b2 = last ? nB : cB + (size_t)(t + 2) * kstep;
            const char* a3 = a2 + kstep; const char* b3 = b2 + kstep;
            if (last && has_next) S.a_ready(nxt);
            if constexpr (SP2) {
            PG8_LDB(B0, 0, 0); PG8_LDB(B1, 0, 1); PG8_SCHED; PG8_LDA(At, 0, 0); PG8_STAGE(PG8_SA(1, 1), a1 + hstep, voffA);
            PG8_WAIT_V(8); PG8_WAIT_L(0); PG8_BAR; PG8_MMA(0, 0, At, B0); PG8_MMA(0, 1, At, B1); PG8_BAR; PG8_SCHED;
            PG8_LDA(At, 0, 1); PG8_STAGE(PG8_SB(0, 0), b2, voffB); PG8_STAGE(PG8_SB(0, 1), b2 + hstep, voffB); PG8_STAGE(PG8_SA(0, 0), a2, voffA);
            PG8_WAIT_V(8); PG8_WAIT_L(0); PG8_BAR; PG8_MMA(1, 0, At, B0); PG8_MMA(1, 1, At, B1); PG8_BAR; PG8_SCHED;
            PG8_LDB(B0, 1, 0); PG8_LDB(B1, 1, 1); PG8_SCHED; PG8_LDA(At, 1, 0); PG8_STAGE(PG8_SA(0, 1), a2 + hstep, voffA);
            PG8_WAIT_V(8); PG8_WAIT_L(0); PG8_BAR; PG8_MMA(0, 0, At, B0); PG8_MMA(0, 1, At, B1); PG8_BAR; PG8_SCHED;
            PG8_LDA(At, 1, 1); PG8_STAGE(PG8_SB(1, 0), b3, voffB); PG8_STAGE(PG8_SB(1, 1), b3 + hstep, voffB); PG8_STAGE(PG8_SA(1, 0), a3, voffA);
            PG8_WAIT_V(8); PG8_WAIT_L(0); PG8_BAR; PG8_MMA(1, 0, At, B0); PG8_MMA(1, 1, At, B1); PG8_BAR; PG8_SCHED;
            } else {
            PG8_LDB(B0, 0, 0); PG8_SCHED; PG8_LDA(At, 0, 0); PG8_STAGE(PG8_SA(1, 1), a1 + hstep, voffA);
            PG8_WAIT_L(8); PG8_BAR; PG8_WAIT_L(0); PG8_MMA(0, 0, At, B0); PG8_BAR; PG8_SCHED;
            PG8_LDB(B1, 0, 1); PG8_STAGE(PG8_SB(0, 0), b2, voffB);
            PG8_BAR; PG8_WAIT_L(0); PG8_MMA(0, 1, At, B1); PG8_BAR;
            PG8_LDA(At, 0, 1); PG8_STAGE(PG8_SA(0, 0), a2, voffA);
            PG8_BAR; PG8_WAIT_L(0); PG8_MMA(1, 0, At, B0); PG8_BAR; PG8_SCHED;
            PG8_STAGE(PG8_SB(0, 1), b2 + hstep, voffB);
            PG8_WAIT_V(6); PG8_BAR; PG8_MMA(1, 1, At, B1); PG8_BAR;
            PG8_LDB(B0, 1, 0); PG8_SCHED; PG8_LDA(At, 1, 0); PG8_STAGE(PG8_SA(0, 1), a2 + hstep, voffA);
            PG8_WAIT_L(8); PG8_BAR; PG8_WAIT_L(0); PG8_MMA(0, 0, At, B0); PG8_BAR; PG8_SCHED;
            PG8_LDB(B1, 1, 1); PG8_STAGE(PG8_SB(1, 0), b3, voffB);
            PG8_BAR; PG8_WAIT_L(0); PG8_MMA(0, 1, At, B1); PG8_BAR;
            PG8_LDA(At, 1, 1); PG8_STAGE(PG8_SA(1, 0), a3, voffA);
            PG8_BAR; PG8_WAIT_L(0); PG8_MMA(1, 0, At, B0); PG8_BAR; PG8_SCHED;
            PG8_STAGE(PG8_SB(1, 1), b3 + hstep, voffB);
            PG8_WAIT_V(6); PG8_BAR; PG8_MMA(1, 1, At, B1); PG8_BAR;
            }
        }
        if constexpr (ALIGN_EPI) { if (wr == 0) PG8_BAR; }
        if constexpr (!Epi::AFTER_DRAIN) { E(acc, cur, wr, wc, fr, fq); S.done(cur); }
        if (!has_next) break;
#pragma unroll
        for (int a = 0; a < 2; ++a)
#pragma unroll
            for (int b = 0; b < 2; ++b)
#pragma unroll
                for (int m = 0; m < 4; ++m)
#pragma unroll
                    for (int n = 0; n < 2; ++n) acc[a][b][m][n] = (f32x4){0.f, 0.f, 0.f, 0.f};
        cur = nxt; cA = nA; cB = nB; ++ui;
        if constexpr (ALIGN_EPI) { if (wr == 1) PG8_BAR; }
    }
    PG8_WAIT_V(0);
    if constexpr (!ALIGN_EPI) { if (wr == 0) PG8_BAR; }
    PG8_BAR;
    if constexpr (Epi::AFTER_DRAIN) { E.fused(acc, cur, wr, wc, fr, fq, lds, wid, lane); S.done(cur); }
#undef PG8_SA
#undef PG8_SB
#undef PG8_STAGE
#undef PG8_LDA
#undef PG8_LDB
#undef PG8_MMA
#undef PG8_WAIT_V
#undef PG8_WAIT_L
#undef PG8_BAR
#undef PG8_SCHED
}
}
#ifndef MK_N_LAUNCHES
#define MK_N_LAUNCHES 1
#endif
constexpr int NWAVES = 8, NTHREADS = 512;
constexpr int M = 16384, SEQ = 2048, D = 1024, FF = 2816, NGU = 2 * FF, NIN = 3336, NINP = 3584, PP = 3336, NLORA = 1536, KLORA = 256;
constexpr int NPHASE = 12;
constexpr size_t MiB = 1u << 20;
constexpr size_t WS_PART = 1 * MiB, WS_BONUS = 2 * MiB, WS_GC = 3 * MiB, WS_W1GU = 4 * MiB, WS_W1D = 15 * MiB, WS_WIN = 21 * MiB, WS_WOUT = 36 * MiB, WS_W2D = 38 * MiB, WS_WL = 44 * MiB;
constexpr size_t WS_CS = 4 * MiB;
constexpr size_t WS_CD = 3 * MiB + 512 * 1024;
constexpr size_t WS_XG = 48 * MiB;
constexpr size_t WS_P = 80 * MiB;
constexpr size_t WS_Y = 185 * MiB;
constexpr size_t WS_G = 217 * MiB;
constexpr size_t WS_LIN = 233 * MiB;
constexpr size_t WS_END = 249 * MiB;
constexpr int LDS_BYTES = 147456;

#define LAS __attribute__((address_space(3)))
typedef unsigned short bf16;
typedef unsigned v4u __attribute__((ext_vector_type(4)));
typedef unsigned v2u __attribute__((ext_vector_type(2)));
typedef float f32x4 __attribute__((ext_vector_type(4)));
typedef short bf16x8 __attribute__((ext_vector_type(8)));
#define LDS_WAIT() asm volatile("s_waitcnt lgkmcnt(0)" ::: "memory")
using pg8::cvt_pk_bf16;
__device__ __forceinline__ float bf_lo(unsigned u) { return __builtin_bit_cast(float, u << 16); }
__device__ __forceinline__ float bf_hi(unsigned u) { return __builtin_bit_cast(float, u & 0xffff0000u); }
__device__ __forceinline__ float bf1(bf16 s) { return __builtin_bit_cast(float, (unsigned)s << 16); }
__device__ __forceinline__ bf16 f2bf(float f) { return (bf16)(cvt_pk_bf16(f, 0.f) & 0xffffu); }
__device__ __forceinline__ f32x4 bf4(v2u u) { return (f32x4){bf_lo(u.x), bf_hi(u.x), bf_lo(u.y), bf_hi(u.y)}; }
__device__ __forceinline__ float sigm(float x) { return __builtin_amdgcn_rcpf(1.0f + __expf(-x)); }
__device__ __forceinline__ float wave_sum(float v) {
#pragma unroll
    for (int o = 1; o < 64; o <<= 1) v += __shfl_xor(v, o);
    return v;
}
template <int CTRL> __device__ __forceinline__ float dppf(float x) { return __builtin_bit_cast(float, __builtin_amdgcn_update_dpp(0, __builtin_bit_cast(int, x), CTRL, 0xf, 0xf, true)); }
__device__ __forceinline__ float allred16(float x) { x += dppf<0xB1>(x); x += dppf<0x4E>(x); x += dppf<0x124>(x); x += dppf<0x128>(x); return x; }

struct TrItem { const float* W; bf16* dst; const float* gk; int N, dpitch; };
__device__ __forceinline__ void tr_load(const TrItem& it, f32x4 (&v)[8]) {
#pragma unroll
    for (int i = 0; i < 8; ++i) { v[i] = it.N ? *(const f32x4*)(it.W + (size_t)i * it.N) : (f32x4){0.f, 0.f, 0.f, 0.f}; if (it.gk) v[i] = v[i] * it.gk[i]; }
}
__device__ __forceinline__ void tr_store(const TrItem& it, const f32x4 (&v)[8]) {
#pragma unroll
    for (int j = 0; j < 4; ++j) { v4u o; o.x = cvt_pk_bf16(v[0][j], v[1][j]); o.y = cvt_pk_bf16(v[2][j], v[3][j]); o.z = cvt_pk_bf16(v[4][j], v[5][j]); o.w = cvt_pk_bf16(v[6][j], v[7][j]);
        *(v4u*)(it.dst + (size_t)j * it.dpitch) = o; }
}
__device__ __forceinline__ TrItem tr_make(const float* W, int N, int kb, int nb, bf16* WT, int dpitch, int roff, int dk0, int mode, int up, int lane, const float* gain = nullptr) {
    const int ng = lane & 15, kg = lane >> 4, n = 64 * nb + 4 * ng, k = 32 * kb + 8 * kg;
    TrItem t; t.N = (n < N) ? N : 0; t.W = W + (size_t)k * N + n; t.dpitch = dpitch; t.gk = gain ? gain + k : nullptr;
    const int drow = mode ? (256 * (n >> 7) + 128 * up + (n & 127)) : (n + roff);
    t.dst = WT + (size_t)drow * dpitch + dk0 + k; return t;
}
constexpr int TR_I_GU = 44 * 32, TR_I_DN = 16 * 88, TR_I_IN = 56 * 32, TR_I_OUT = 16 * 32;
constexpr int TR_P0_ITEMS = 4 * TR_I_GU + TR_I_IN + TR_I_OUT + 64;
__device__ __forceinline__ TrItem p0_decode(int r, const float* const* in, unsigned char* ws, int lane) {
    bf16* W1GU = (bf16*)(ws + WS_W1GU); bf16* W1D = (bf16*)(ws + WS_W1D); bf16* WIN = (bf16*)(ws + WS_WIN); bf16* WOUT = (bf16*)(ws + WS_WOUT); bf16* W2D = (bf16*)(ws + WS_W2D); bf16* WL = (bf16*)(ws + WS_WL);
    if (r < 2 * TR_I_GU) { const int up = r >= TR_I_GU; r -= up * TR_I_GU; return tr_make(in[2 + up], FF, r / 44, r % 44, W1GU, D, 0, 0, 1, up, lane); } r -= 2 * TR_I_GU;
    if (r < TR_I_DN) return tr_make(in[4], D, r / 16, r % 16, W1D, FF, 0, 0, 0, 0, lane); r -= TR_I_DN;
    if (r < TR_I_IN) return tr_make(in[6], NIN, r / 56, r % 56, WIN, D, 0, 0, 0, 0, lane, in[5]); r -= TR_I_IN;
    if (r < TR_I_OUT) return tr_make(in[24], D, r / 16, r % 16, WOUT, D, 0, 0, 0, 0, lane); r -= TR_I_OUT;
    if (r < TR_I_DN) return tr_make(in[28], D, r / 16, r % 16, W2D, FF, 0, 0, 0, 0, lane); r -= TR_I_DN;
    if (r < 16) return tr_make(in[9], 512, r / 8, r % 8, WL, KLORA, 0, 0, 0, 0, lane); r -= 16;
    if (r < 16) return tr_make(in[11], 512, r / 8, r % 8, WL, KLORA, 512, 64, 0, 0, lane); r -= 16;
    return tr_make(in[12], 512, r / 8, r % 8, WL, KLORA, 1024, 128, 0, 0, lane);
}
__device__ __forceinline__ void tail_copy_range(const float* const* in, unsigned char* ws, int lo_, int hi_, int tw, int NTW, int lane) {
    for (int it = lo_ + tw; it < hi_; it += 2 * NTW) {
        const TrItem a = p0_decode(it, in, ws, lane); const bool hasb = it + NTW < hi_; const TrItem b = p0_decode(hasb ? it + NTW : it, in, ws, lane);
        f32x4 va[8], vb[8]; tr_load(a, va); tr_load(b, vb); tr_store(a, va); if (hasb) tr_store(b, vb);
    }
}
constexpr int TR_W2D_LO = 2 * TR_I_GU + TR_I_DN + TR_I_IN + TR_I_OUT, TR_W2D_HI = TR_W2D_LO + TR_I_DN;
__device__ __forceinline__ void p1_tail_copies(const float* const* in, unsigned char* ws, int tw, int NTW, int tthr, int NTT, int lane) {
    bf16* WL = (bf16*)(ws + WS_WL);
    tail_copy_range(in, ws, 2 * TR_I_GU, TR_W2D_LO, tw, NTW, lane);
    tail_copy_range(in, ws, TR_W2D_HI, TR_P0_ITEMS, tw, NTW, lane);
    for (int id = tthr; id < NLORA * 32; id += NTT) { const int row = id >> 5, col = 8 * (id & 31);
        const bool nz = (row < 512) ? (col < 64) : (row < 1024 ? (col >= 64 && col < 128) : (col >= 128));
        if (!nz) *(v4u*)(WL + (size_t)row * KLORA + col) = (v4u){0u, 0u, 0u, 0u}; }
}
__device__ __forceinline__ void p0_prologue(LAS unsigned char* lds, const float* const* in, unsigned char* ws, int vcu, int G, int tid, int wave, int lane) {
    const int gw = vcu * NWAVES + wave, NGW = G * NWAVES;
    bf16* WL = (bf16*)(ws + WS_WL);
    for (int it = gw; it < 2 * TR_I_GU; it += 2 * NGW) {
        const TrItem a = p0_decode(it, in, ws, lane); const bool hasb = it + NGW < 2 * TR_I_GU; const TrItem b = p0_decode(hasb ? it + NGW : it, in, ws, lane);
        f32x4 va[8], vb[8]; tr_load(a, va); tr_load(b, vb); tr_store(a, va); if (hasb) tr_store(b, vb);
    }
    const float* x = in[0]; const float* g1 = in[1]; bf16* XG = (bf16*)(ws + WS_XG);
    f32x4 gv[4];
#pragma unroll
    for (int j = 0; j < 4; ++j) gv[j] = ((const f32x4*)g1)[64 * j + lane];
    for (int m = gw; m < M; m += 2 * NGW) {
        const int m2 = m + NGW;
        const f32x4* xa = (const f32x4*)(x + (size_t)m * D) + lane; const f32x4* xb = (const f32x4*)(x + (size_t)m2 * D) + lane; f32x4 va[4], vb[4]; float sa = 0.f, sb = 0.f;
#pragma unroll
        for (int j = 0; j < 4; ++j) { va[j] = xa[64 * j]; vb[j] = xb[64 * j]; }
#pragma unroll
        for (int j = 0; j < 4; ++j) { sa += (va[j].x * va[j].x + va[j].y * va[j].y) + (va[j].z * va[j].z + va[j].w * va[j].w); sb += (vb[j].x * vb[j].x + vb[j].y * vb[j].y) + (vb[j].z * vb[j].z + vb[j].w * vb[j].w); }
        const float ra = __builtin_amdgcn_rsqf(wave_sum(sa) * (1.f / D) + 1e-6f), rb = __builtin_amdgcn_rsqf(wave_sum(sb) * (1.f / D) + 1e-6f);
        v2u* oa = (v2u*)(XG + (size_t)m * D) + lane; v2u* ob = (v2u*)(XG + (size_t)m2 * D) + lane;
#pragma unroll
        for (int j = 0; j < 4; ++j) { const f32x4 wa = va[j] * ra * gv[j], wb = vb[j] * rb * gv[j]; v2u o; o.x = cvt_pk_bf16(wa.x, wa.y); o.y = cvt_pk_bf16(wa.z, wa.w); oa[64 * j] = o;
            v2u o2; o2.x = cvt_pk_bf16(wb.x, wb.y); o2.y = cvt_pk_bf16(wb.z, wb.w); ob[64 * j] = o2; }
    }
}
__device__ __forceinline__ void p4_lora_in(const bf16* P, const float* mu, bf16* LIN, int gtid, int NT) {
    v4u cur[4], prv[4];
#pragma unroll
    for (int k = 0; k < 4; ++k) { const int idx = gtid + k * NT; const int m = idx >> 5, cgp = idx & 31, t = m & (SEQ - 1);
        const bf16* pc = P + (size_t)m * PP + 1536 + 8 * cgp; cur[k] = *(const v4u*)pc; prv[k] = (v4u){0u, 0u, 0u, 0u}; if (t) prv[k] = *(const v4u*)(pc - PP); }
    const int cgp = gtid & 31;
    const f32x4 m0 = *(const f32x4*)(mu + 1536 + 8 * cgp), m1 = *(const f32x4*)(mu + 1540 + 8 * cgp);
#pragma unroll
    for (int k = 0; k < 4; ++k) { const int idx = gtid + k * NT; const int m = idx >> 5;
        float xv[8];
#pragma unroll
        for (int e = 0; e < 4; ++e) { const unsigned cu = cur[k][e], pu = prv[k][e]; const float c0 = bf_lo(cu), c1 = bf_hi(cu), p0 = bf_lo(pu), p1 = bf_hi(pu);
            const float mA = (e < 2) ? m0[2 * e] : m1[2 * e - 4], mB = (e < 2) ? m0[2 * e + 1] : m1[2 * e - 3];
            xv[2 * e] = c0 + (p0 - c0) * mA; xv[2 * e + 1] = c1 + (p1 - c1) * mB; }
        if (cgp < 8) {
#pragma unroll
            for (int e = 0; e < 8; ++e) xv[e] = 2.f * sigm(2.f * xv[e]) - 1.f;
        } else if (cgp >= 16) {
#pragma unroll
            for (int e = 0; e < 8; ++e) xv[e] = sigm(xv[e]);
        }
        v4u o; o.x = cvt_pk_bf16(xv[0], xv[1]); o.y = cvt_pk_bf16(xv[2], xv[3]); o.z = cvt_pk_bf16(xv[4], xv[5]); o.w = cvt_pk_bf16(xv[6], xv[7]);
        *(v4u*)(LIN + (size_t)m * KLORA + 8 * cgp) = o;
    }
}
__device__ __forceinline__ int perm_pos(int s) { return (s & 32) + (((s & 15) >> 2) << 3) + (((s >> 4) & 1) << 2) + (s & 3); }
__device__ __forceinline__ bf16x8 pack8(const f32x4 a, const f32x4 b) { v4u u; u.x = cvt_pk_bf16(a[0], a[1]); u.y = cvt_pk_bf16(a[2], a[3]); u.z = cvt_pk_bf16(b[0], b[1]); u.w = cvt_pk_bf16(b[2], b[3]); return __builtin_bit_cast(bf16x8, u); }
#define MFMA16(a, b, c) __builtin_amdgcn_mfma_f32_16x16x32_bf16((a), (b), (c), 0, 0, 0)
constexpr int RW_PITCH = 72;
struct RwIn { v4u cr, ck, cv, qr, qk, qv, ce, ca; };
__device__ __forceinline__ void rwkv_chunk_load(RwIn& I, int unit, const bf16* P, const bf16* EA, int tid) {
    const int h = unit & 7, c = (unit >> 3) & 31, b = unit >> 8; const size_t m0 = (size_t)b * SEQ + 64 * c;
    const int t = tid >> 3, jg = tid & 7, ch = 64 * h + 8 * jg;
    const bf16* pc = P + (m0 + t) * PP + ch;
    I.cr = *(const v4u*)pc; I.ck = *(const v4u*)(pc + 512); I.cv = *(const v4u*)(pc + 1024);
    I.ce = *(const v4u*)(EA + (m0 + t) * 1024 + ch); I.ca = *(const v4u*)(EA + (m0 + t) * 1024 + 512 + ch);
}
__device__ __forceinline__ void rwkv_chunk_load_prev(RwIn& I, int unit, const bf16* P, int tid) {
    const int h = unit & 7, c = (unit >> 3) & 31, b = unit >> 8; const size_t m0 = (size_t)b * SEQ + 64 * c;
    const int t = tid >> 3, jg = tid & 7, ch = 64 * h + 8 * jg;
    const bf16* pc = P + (m0 + t) * PP + ch;
    I.qr = (v4u){0u, 0u, 0u, 0u}; I.qk = I.qr; I.qv = I.qr;
    if (64 * c + t > 0) { I.qr = *(const v4u*)(pc - PP); I.qk = *(const v4u*)(pc - PP + 512); I.qv = *(const v4u*)(pc - PP + 1024); }
}
__device__ __forceinline__ void rwkv_chunk_unit(LAS unsigned char* lds, int unit, RwIn& I, int next_unit, const bf16* P, bf16* EA, bf16* Y, float* BON, float* GCg, unsigned* SLg,
                                                int tid, int wave, int lane, bool st = true, int stop = 0) {
    const int h = unit & 7, c = (unit >> 3) & 31, b = unit >> 8;
    const size_t m0 = (size_t)b * SEQ + 64 * c;
    LAS bf16* At = (LAS bf16*)(lds); LAS bf16* Rt = (LAS bf16*)(lds + 9216); LAS bf16* Bm = (LAS bf16*)(lds + 18432); LAS bf16* Km = (LAS bf16*)(lds + 27648);
    LAS bf16* BmT = (LAS bf16*)(lds + 36864); LAS bf16* KmT = (LAS bf16*)(lds + 46080); LAS bf16* VT = (LAS bf16*)(lds + 55296);
    LAS bf16* AabT = (LAS bf16*)(lds + 64512); LAS bf16* AkbT = (LAS bf16*)(lds + 73728); LAS bf16* AbrT = (LAS bf16*)(lds + 82944); LAS bf16* AkrT = (LAS bf16*)(lds + 92160);
    LAS float* AD = (LAS float*)(lds + 101376); LAS bf16* TdA = (LAS bf16*)(lds + 105472); LAS float* GC = (LAS float*)(lds + 109568); LAS float* WT = (LAS float*)(lds + 109824);
    const LAS float* PRM = (const LAS float*)(lds + 140032);
    const int r = lane & 15, q = lane >> 4;
    {
        const int t = tid >> 3, jg = tid & 7;
        rwkv_chunk_load_prev(I, unit, P, tid);
        const v4u cr = I.cr, ck = I.ck, cv = I.cv, qr = I.qr, qk = I.qk, qv = I.qv, ce = I.ce, ca = I.ca;
        float rr[8], kx[8], vv[8], ee[8], aa[8], kk[8], km[8], bv[8], E[8];
        float ss = 0.f, bon = 0.f;
#pragma unroll
        for (int x = 0; x < 8; ++x) {
            const unsigned ur = cr[x >> 1], uk = ck[x >> 1], uv = cv[x >> 1], pr = qr[x >> 1], pk = qk[x >> 1], pv = qv[x >> 1], ue = ce[x >> 1], ua = ca[x >> 1];
            const float r0 = (x & 1) ? bf_hi(ur) : bf_lo(ur), k0 = (x & 1) ? bf_hi(uk) : bf_lo(uk), v0 = (x & 1) ? bf_hi(uv) : bf_lo(uv);
            const float r1 = (x & 1) ? bf_hi(pr) : bf_lo(pr), k1 = (x & 1) ? bf_hi(pk) : bf_lo(pk), v1 = (x & 1) ? bf_hi(pv) : bf_lo(pv);
            const LAS float* pj = PRM + 8 * jg + x;
            const float ep = ((x & 1) ? bf_hi(ue) : bf_lo(ue)) + pj[384], ap = ((x & 1) ? bf_hi(ua) : bf_lo(ua)) + pj[448];
            rr[x] = r0 + (r1 - r0) * pj[0]; kx[x] = k0 + (k1 - k0) * pj[64]; vv[x] = v0 + (v1 - v0) * pj[128];
            ee[x] = 0.60653066f * sigm(ep); aa[x] = sigm(ap);
            kk[x] = kx[x] * pj[192]; ss += kk[x] * kk[x];
            km[x] = kx[x] * (1.0f + (aa[x] - 1.0f) * pj[256]);
            bon += rr[x] * km[x] * pj[320];
            E[x] = ee[x];
        }
        ss += __shfl_xor(ss, 1); ss += __shfl_xor(ss, 2); ss += __shfl_xor(ss, 4);
        bon += __shfl_xor(bon, 1); bon += __shfl_xor(bon, 2); bon += __shfl_xor(bon, 4);
        if (jg == 0 && st) BON[(m0 + t) * 8 + h] = bon;
        const float inv = 1.0f / fmaxf(sqrtf(ss), 1e-12f);
#pragma unroll
        for (int x = 0; x < 8; ++x) { kk[x] *= inv; bv[x] = kk[x] * aa[x]; }
#pragma unroll
        for (int off = 8; off < 64; off <<= 1)
#pragma unroll
            for (int x = 0; x < 8; ++x) { const float tv = __shfl_up(E[x], off); if (lane >= off) E[x] += tv; }
        if ((lane >> 3) == 7) {
#pragma unroll
            for (int x = 0; x < 8; ++x) WT[wave * 64 + 8 * jg + x] = E[x];
        }
        __syncthreads();
        for (int w2 = 0; w2 < wave; ++w2)
#pragma unroll
            for (int x = 0; x < 8; ++x) E[x] += WT[w2 * 64 + 8 * jg + x];
        float av[8], rv[8], bt[8], kt[8];
#pragma unroll
        for (int x = 0; x < 8; ++x) { const float gi = __expf(-E[x]), ge = __expf(-(E[x] - ee[x])), gp = __expf(E[x]);
            av[x] = -kk[x] * ge; rv[x] = rr[x] * gi; bt[x] = bv[x] * gp; kt[x] = km[x] * gp;
            if (t == 63) { GC[8 * jg + x] = gi; if (st) GCg[(size_t)unit * 64 + 8 * jg + x] = gi; } }
#define PK8(a_) (v4u){cvt_pk_bf16(a_[0], a_[1]), cvt_pk_bf16(a_[2], a_[3]), cvt_pk_bf16(a_[4], a_[5]), cvt_pk_bf16(a_[6], a_[7])}
        *(LAS v4u*)(At + t * RW_PITCH + 8 * jg) = PK8(av); *(LAS v4u*)(Rt + t * RW_PITCH + 8 * jg) = PK8(rv);
        *(LAS v4u*)(Bm + t * RW_PITCH + 8 * jg) = PK8(bt); *(LAS v4u*)(Km + t * RW_PITCH + 8 * jg) = PK8(kt);
#undef PK8
#pragma unroll
        for (int x = 0; x < 8; ++x) { BmT[(8 * jg + x) * RW_PITCH + perm_pos(t)] = f2bf(bt[x]); KmT[(8 * jg + x) * RW_PITCH + t] = f2bf(kt[x]); VT[(8 * jg + x) * RW_PITCH + t] = f2bf(vv[x]); }
    }
    if (next_unit >= 0) rwkv_chunk_load(I, next_unit, P, EA, tid);
    __syncthreads();
    if (stop == 1) return;
    {
        const int mat = wave >> 1; const LAS bf16* Atile = mat < 2 ? At : Rt; const LAS bf16* Btile = (mat & 1) ? Km : Bm;
        LAS bf16* dst = mat == 0 ? AabT : (mat == 1 ? AkbT : (mat == 2 ? AbrT : AkrT));
        const bool strict = mat < 2, perm = (mat & 1) == 0;
#pragma unroll
        for (int tbi = 0; tbi < 2; ++tbi) { const int tb = 2 * (wave & 1) + tbi;
            const bf16x8 a0 = *(const LAS bf16x8*)(Atile + (16 * tb + r) * RW_PITCH + 8 * q), a1 = *(const LAS bf16x8*)(Atile + (16 * tb + r) * RW_PITCH + 32 + 8 * q);
#pragma unroll
            for (int sb = 0; sb < 4; ++sb) {
                f32x4 acc = (f32x4){0.f, 0.f, 0.f, 0.f};
                if (sb <= tb) { acc = MFMA16(a0, *(const LAS bf16x8*)(Btile + (16 * sb + r) * RW_PITCH + 8 * q), acc); acc = MFMA16(a1, *(const LAS bf16x8*)(Btile + (16 * sb + r) * RW_PITCH + 32 + 8 * q), acc); }
                const int sx = 16 * sb + r, pos = perm ? perm_pos(sx) : sx;
#pragma unroll
                for (int jj = 0; jj < 4; ++jj) { const int tx = 16 * tb + 4 * q + jj; const bool keep = (sb <= tb) && (strict ? sx < tx : sx <= tx); const float v = keep ? acc[jj] : 0.f;
                    dst[tx * RW_PITCH + pos] = f2bf(v);
                    if (mat == 0 && sb == tb) AD[tb * 256 + (4 * q + jj) * 16 + r] = v; }
            }
        }
    }
    __syncthreads();
    if (stop == 2) return;
    if (wave < 4) {
        const LAS float* ad = AD + wave * 256; float X[16];
#pragma unroll
        for (int sx = 15; sx >= 0; --sx) { float x = (sx == r) ? 1.f : 0.f;
#pragma unroll
            for (int k = sx + 1; k < 16; ++k) x += ad[k * 16 + sx] * X[k];
            X[sx] = x; }
        LAS bf16* td = TdA + wave * 512 + r * 32;
        if (q == 0) {
#pragma unroll
            for (int kg = 0; kg < 4; ++kg) { v4u o; o.x = cvt_pk_bf16(X[4 * kg], X[4 * kg + 1]); o.y = cvt_pk_bf16(X[4 * kg + 2], X[4 * kg + 3]); o.z = 0u; o.w = 0u; *(LAS v4u*)(td + 8 * kg) = o; }
        }
    }
    f32x4 z[4], qy[4], gs[4];
    const bool vpart = wave >= 4; const int cb = wave & 3;
    if (vpart) {
        const bf16x8 v0 = *(const LAS bf16x8*)(VT + (16 * cb + r) * RW_PITCH + 8 * q), v1 = *(const LAS bf16x8*)(VT + (16 * cb + r) * RW_PITCH + 32 + 8 * q);
#pragma unroll
        for (int tb = 0; tb < 4; ++tb) { const int ro = (16 * tb + r) * RW_PITCH + 8 * q;
            f32x4 acc = (f32x4){0.f, 0.f, 0.f, 0.f}; acc = MFMA16(*(const LAS bf16x8*)(AkbT + ro), v0, acc); acc = MFMA16(*(const LAS bf16x8*)(AkbT + ro + 32), v1, acc); z[tb] = acc;
            acc = (f32x4){0.f, 0.f, 0.f, 0.f}; acc = MFMA16(*(const LAS bf16x8*)(AkrT + ro), v0, acc); acc = MFMA16(*(const LAS bf16x8*)(AkrT + ro + 32), v1, acc); qy[tb] = acc;
            acc = (f32x4){0.f, 0.f, 0.f, 0.f}; acc = MFMA16(*(const LAS bf16x8*)(KmT + ro), v0, acc); acc = MFMA16(*(const LAS bf16x8*)(KmT + ro + 32), v1, acc); gs[tb] = acc; }
    } else {
#pragma unroll
        for (int tb = 0; tb < 4; ++tb)
#pragma unroll
            for (int jj = 0; jj < 4; ++jj) { const int tx = 16 * tb + 4 * q + jj; z[tb][jj] = bf1(At[tx * RW_PITCH + 16 * cb + r]); qy[tb][jj] = bf1(Rt[tx * RW_PITCH + 16 * cb + r]); gs[tb][jj] = 0.f; }
    }
    __syncthreads();
    if (stop == 3) return;
    const f32x4 zero4 = (f32x4){0.f, 0.f, 0.f, 0.f};
#pragma unroll
    for (int tb = 0; tb < 4; ++tb) {
        f32x4 rhs = z[tb];
        if (tb >= 1) rhs = MFMA16(*(const LAS bf16x8*)(AabT + (16 * tb + r) * RW_PITCH + 8 * q), pack8(z[0], tb >= 2 ? z[1] : zero4), rhs);
        if (tb >= 3) rhs = MFMA16(*(const LAS bf16x8*)(AabT + (16 * tb + r) * RW_PITCH + 32 + 8 * q), pack8(z[2], zero4), rhs);
        z[tb] = MFMA16(*(const LAS bf16x8*)(TdA + tb * 512 + r * 32 + 8 * q), pack8(rhs, zero4), zero4);
    }
    const bf16x8 zb0 = pack8(z[0], z[1]), zb1 = pack8(z[2], z[3]);
#pragma unroll
    for (int tb = 0; tb < 4; ++tb) { const int ro = (16 * tb + r) * RW_PITCH + 8 * q;
        qy[tb] = MFMA16(*(const LAS bf16x8*)(AbrT + ro), zb0, qy[tb]); qy[tb] = MFMA16(*(const LAS bf16x8*)(AbrT + ro + 32), zb1, qy[tb]);
        gs[tb] = MFMA16(*(const LAS bf16x8*)(BmT + ro), zb0, gs[tb]); gs[tb] = MFMA16(*(const LAS bf16x8*)(BmT + ro + 32), zb1, gs[tb]);
#pragma unroll
        for (int jj = 0; jj < 4; ++jj) gs[tb][jj] *= GC[16 * tb + 4 * q + jj]; }
    LAS bf16* QTs = At; LAS bf16* GTs = Rt; LAS bf16* YLs = Bm;
    if (vpart) {
#pragma unroll
        for (int tb = 0; tb < 4; ++tb) {
#pragma unroll
            for (int jj = 0; jj < 4; ++jj) YLs[(16 * tb + 4 * q + jj) * RW_PITCH + 16 * cb + r] = f2bf(qy[tb][jj]);
            v2u o; o.x = cvt_pk_bf16(gs[tb][0], gs[tb][1]); o.y = cvt_pk_bf16(gs[tb][2], gs[tb][3]);
            if (st) *(v2u*)(SLg + ((((size_t)unit * 4 + cb) * 4 + tb) * 64 + lane) * 2) = o; }
    } else {
        const int pj = perm_pos(16 * cb + r);
#pragma unroll
        for (int tb = 0; tb < 4; ++tb)
#pragma unroll
            for (int jj = 0; jj < 4; ++jj) { const int rw = (16 * tb + 4 * q + jj) * RW_PITCH + pj; QTs[rw] = f2bf(qy[tb][jj]); GTs[rw] = f2bf(gs[tb][jj]); }
    }
    __syncthreads();
    if (st) { const int row = tid >> 3, sg = 8 * (tid & 7); const size_t ro = (m0 + row) * 1024 + 64 * h + sg;
        *(v4u*)(EA + ro + 512) = *(const LAS v4u*)(QTs + row * RW_PITCH + sg); *(v4u*)(EA + ro) = *(const LAS v4u*)(GTs + row * RW_PITCH + sg); *(v4u*)(Y + ro) = *(const LAS v4u*)(YLs + row * RW_PITCH + sg); }
    __syncthreads();
}
struct SeqS { bf16x8 ga[2][2]; v2u sl[2]; f32x4 gc[2]; };
struct SeqY { bf16x8 qa[2][2]; bf16 yl[2][4]; };
#define SEQS_LOAD(S_, c_, HF_) do { const int cc_ = (c_) < 32 ? (c_) : 31; const int unit_ = (b * 32 + cc_) * 8 + h; const size_t mm_ = (size_t)b * SEQ + 64 * cc_; \
    _Pragma("unroll") for (int t2 = 0; t2 < 2; ++t2) { const int tb = 2 * (HF_) + t2; \
        const bf16* grow_ = EA + (mm_ + 16 * tb + r) * 1024 + 64 * h + 8 * q; S_.ga[t2][0] = *(const bf16x8*)grow_; S_.ga[t2][1] = *(const bf16x8*)(grow_ + 32); \
        S_.sl[t2] = *(const v2u*)(SLg + ((((size_t)unit_ * 4 + ib) * 4 + tb) * 64 + lane) * 2); \
        S_.gc[t2] = *(const f32x4*)(GCg + (size_t)unit_ * 64 + 16 * tb + 4 * q); } } while (0)
#define SEQS_COMP(S_, HF_) do { \
    _Pragma("unroll") for (int t2 = 0; t2 < 2; ++t2) { const int tb = 2 * (HF_) + t2; \
        f32x4 sv = bf4(S_.sl[t2]) + S_.gc[t2] * sT[tb]; \
        sv = MFMA16(S_.ga[t2][0], bh0, sv); sv = MFMA16(S_.ga[t2][1], bh1, sv); sv = MFMA16(S_.ga[t2][0], bl0, sv); sv = MFMA16(S_.ga[t2][1], bl1, sv); \
        sT[tb] = sv; } } while (0)
#define SEQS_SPLIT(c_) do { f32x4 hi[4], lo[4]; \
    _Pragma("unroll") for (int jb = 0; jb < 4; ++jb) _Pragma("unroll") for (int jj = 0; jj < 4; ++jj) { const float hv = bf1(f2bf(sT[jb][jj])); hi[jb][jj] = hv; lo[jb][jj] = sT[jb][jj] - hv; } \
    bh0 = pack8(hi[0], hi[1]); bh1 = pack8(hi[2], hi[3]); bl0 = pack8(lo[0], lo[1]); bl1 = pack8(lo[2], lo[3]); \
    LAS bf16x8* slot_ = (LAS bf16x8*)(lds + (c_) * 4096) + lane; slot_[0] = bh0; slot_[64] = bh1; slot_[128] = bl0; slot_[192] = bl1; \
    asm volatile("s_waitcnt lgkmcnt(0)" ::: "memory"); *prog = (unsigned)(c_) + 1u; } while (0)
#define SEQY_LOAD(S_, c_, HF_) do { const int cc_ = (c_) < 32 ? (c_) : 31; const size_t mm_ = (size_t)b * SEQ + 64 * cc_; \
    _Pragma("unroll") for (int t2 = 0; t2 < 2; ++t2) { const int tb = 2 * (HF_) + t2; \
        const bf16* qrow_ = EA + (mm_ + 16 * tb + r) * 1024 + 512 + 64 * h + 8 * q; S_.qa[t2][0] = *(const bf16x8*)qrow_; S_.qa[t2][1] = *(const bf16x8*)(qrow_ + 32); \
        _Pragma("unroll") for (int jj = 0; jj < 4; ++jj) S_.yl[t2][jj] = Y[(mm_ + 16 * tb + 4 * q + jj) * 1024 + 64 * h + 16 * ib + r]; } } while (0)
#define SEQY_WAIT(c_) do { unsigned sp_ = 0; while (*prog < (unsigned)(c_) + 1u) { __builtin_amdgcn_s_sleep(1); if (++sp_ > (1u << 24)) break; } \
    asm volatile("" ::: "memory"); \
    const LAS bf16x8* slot_ = (const LAS bf16x8*)(lds + (c_) * 4096) + lane; bh0 = slot_[0]; bh1 = slot_[64]; bl0 = slot_[128]; bl1 = slot_[192]; } while (0)
#define SEQY_COMP(S_, c_, HF_) do { const size_t m0 = (size_t)b * SEQ + 64 * (c_); \
    _Pragma("unroll") for (int t2 = 0; t2 < 2; ++t2) { const int tb = 2 * (HF_) + t2; \
        f32x4 y; _Pragma("unroll") for (int jj = 0; jj < 4; ++jj) y[jj] = bf1(S_.yl[t2][jj]); \
        y = MFMA16(S_.qa[t2][0], bh0, y); y = MFMA16(S_.qa[t2][1], bh1, y); y = MFMA16(S_.qa[t2][0], bl0, y); y = MFMA16(S_.qa[t2][1], bl1, y); \
        if (st) { _Pragma("unroll") for (int jj = 0; jj < 4; ++jj) Y[(m0 + 16 * tb + 4 * q + jj) * 1024 + 64 * h + 16 * ib + r] = f2bf(y[jj]); } } } while (0)
__device__ __forceinline__ void rwkv_seq_state(LAS unsigned char* lds, volatile LAS unsigned* prog, int job, const bf16* EA, const float* GCg, const unsigned* SLg, int lane) {
    const int ib = job & 3, h = (job >> 2) & 7, b = job >> 5; const int r = lane & 15, q = lane >> 4;
    f32x4 sT[4];
#pragma unroll
    for (int jb = 0; jb < 4; ++jb) sT[jb] = (f32x4){0.f, 0.f, 0.f, 0.f};
    bf16x8 bh0, bh1, bl0, bl1;
    SeqS B0, B1, B2, B3;
    SEQS_LOAD(B0, 0, 0); SEQS_LOAD(B1, 0, 1); SEQS_LOAD(B2, 1, 0);
    for (int c = 0; c < 32; c += 2) {
        SEQS_LOAD(B3, c + 1, 1); SEQS_SPLIT(c); SEQS_COMP(B0, 0);
        SEQS_LOAD(B0, c + 2, 0); SEQS_COMP(B1, 1);
        SEQS_LOAD(B1, c + 2, 1); SEQS_SPLIT(c + 1); SEQS_COMP(B2, 0);
        SEQS_LOAD(B2, c + 3, 0); SEQS_COMP(B3, 1);
    }
}
__device__ __forceinline__ void rwkv_seq_out(LAS unsigned char* lds, volatile LAS unsigned* prog, int job, const bf16* EA, bf16* Y, int lane, bool st) {
    const int ib = job & 3, h = (job >> 2) & 7, b = job >> 5; const int r = lane & 15, q = lane >> 4;
    bf16x8 bh0, bh1, bl0, bl1;
    SeqY B0, B1, B2, B3;
    SEQY_LOAD(B0, 0, 0); SEQY_LOAD(B1, 0, 1); SEQY_LOAD(B2, 1, 0);
    for (int c = 0; c < 32; c += 2) {
        SEQY_LOAD(B3, c + 1, 1); SEQY_WAIT(c); SEQY_COMP(B0, c, 0);
        SEQY_LOAD(B0, c + 2, 0); SEQY_COMP(B1, c, 1);
        SEQY_LOAD(B1, c + 2, 1); SEQY_WAIT(c + 1); SEQY_COMP(B2, c + 1, 0);
        SEQY_LOAD(B2, c + 3, 0); SEQY_COMP(B3, c + 1, 1);
    }
}
#undef SEQS_LOAD
#undef SEQS_COMP
#undef SEQS_SPLIT
#undef SEQY_LOAD
#undef SEQY_WAIT
#undef SEQY_COMP
__device__ __forceinline__ void ssd_chunk_group(LAS unsigned char* lds, int unit, const bf16* P, bf16* Y, bf16* CS, float* CD, const float* dt_bias, const float* a_log, const float* d_skip, int tid, int wave, int lane) {
    const int g = unit & 1, c = (unit >> 1) & 31, b = unit >> 6;
    LAS bf16* Cn = (LAS bf16*)(lds); LAS bf16* Bn = (LAS bf16*)(lds + 17408); LAS bf16* BT = (LAS bf16*)(lds + 34816); LAS bf16* RAWX = (LAS bf16*)(lds + 53248);
    LAS unsigned char* U = lds + 88640;
    LAS bf16* RAWBC = (LAS bf16*)U; LAS bf16* XT = (LAS bf16*)U; LAS bf16* XdT = (LAS bf16*)(U + 9216); LAS bf16* Xr = (LAS bf16*)(U + 18432); LAS bf16* Ms = (LAS bf16*)(U + 26624);
    LAS float* ACS4 = (LAS float*)(lds + 124480); const LAS float* CW = (const LAS float*)(lds + 133632);
    const int r = lane & 15, q = lane >> 4;
    const size_t m0 = (size_t)b * SEQ + 64 * c;
    {
        const int chb = lane < 16 ? 2816 + 128 * g + 8 * lane : (lane < 32 ? 3072 + 128 * g + 8 * (lane - 16) : 2304 + 256 * g + 8 * (lane - 32));
        const bf16* pbase = P + m0 * PP + chb;
        v4u rv[9];
#pragma unroll
        for (int i = 0; i < 9; ++i) { const int rr = wave + 8 * i; rv[i] = (v4u){0u, 0u, 0u, 0u}; if (rr < 67 && 64 * c + rr - 3 >= 0) rv[i] = *(const v4u*)(pbase + (ptrdiff_t)(rr - 3) * PP); }
        LAS bf16* dstb = lane < 32 ? RAWBC + 8 * lane : RAWX + 8 * (lane - 32);
#pragma unroll
        for (int i = 0; i < 9; ++i) { const int rr = wave + 8 * i; if (rr < 67) *(LAS v4u*)(dstb + rr * 264) = rv[i]; }
    }
    float dt[4], dd[4], aend[4];
#pragma unroll
    for (int hh = 0; hh < 4; ++hh) { const int h = 4 * g + hh;
        const float xdt = bf1(P[(m0 + lane) * PP + 3328 + h]) + dt_bias[h]; dt[hh] = xdt > 20.f ? xdt : log1pf(__expf(xdt));
        float acs = dt[hh] * (-__expf(a_log[h]));
#pragma unroll
        for (int o = 1; o < 64; o <<= 1) { const float t = __shfl_up(acs, o); if (lane >= o) acs += t; }
        aend[hh] = __shfl(acs, 63);
        if (wave == 0) ACS4[hh * 64 + lane] = acs;
        dd[hh] = dt[hh] * __expf(aend[hh] - acs); }
    __syncthreads();
#pragma unroll
    for (int i = 0; i < 4; ++i) { const int cgp = wave + 8 * i;
        const LAS float* cwl = CW + cgp * 40;
        float o8[8];
        { const f32x4 b0 = *(const LAS f32x4*)(cwl + 32), b1 = *(const LAS f32x4*)(cwl + 36);
#pragma unroll
          for (int e = 0; e < 4; ++e) { o8[e] = b0[e]; o8[4 + e] = b1[e]; } }
#pragma unroll
        for (int k = 0; k < 4; ++k) { const v4u iv = *(const LAS v4u*)(RAWBC + (lane + k) * 264 + 8 * cgp);
            const f32x4 w0v = *(const LAS f32x4*)(cwl + 8 * k), w1v = *(const LAS f32x4*)(cwl + 8 * k + 4);
            o8[0] += w0v[0] * bf_lo(iv[0]); o8[1] += w0v[1] * bf_hi(iv[0]); o8[2] += w0v[2] * bf_lo(iv[1]); o8[3] += w0v[3] * bf_hi(iv[1]);
            o8[4] += w1v[0] * bf_lo(iv[2]); o8[5] += w1v[1] * bf_hi(iv[2]); o8[6] += w1v[2] * bf_lo(iv[3]); o8[7] += w1v[3] * bf_hi(iv[3]); }
#pragma unroll
        for (int e = 0; e < 8; ++e) o8[e] = o8[e] * sigm(o8[e]);
        v4u o; o.x = cvt_pk_bf16(o8[0], o8[1]); o.y = cvt_pk_bf16(o8[2], o8[3]); o.z = cvt_pk_bf16(o8[4], o8[5]); o.w = cvt_pk_bf16(o8[6], o8[7]);
        if (cgp < 16) { const int n = 8 * cgp; *(LAS v4u*)(Bn + lane * 136 + n) = o;
#pragma unroll
            for (int e = 0; e < 8; ++e) BT[(n + e) * 72 + lane] = f2bf(o8[e]);
        } else { const int n = 8 * (cgp - 16); *(LAS v4u*)(Cn + lane * 136 + n) = o; }
    }
    __syncthreads();
    f32x4 sc[2];
    {
        const int lb = wave >> 1;
#pragma unroll
        for (int sbi = 0; sbi < 2; ++sbi) { const int sb = 2 * (wave & 1) + sbi; sc[sbi] = (f32x4){0.f, 0.f, 0.f, 0.f};
            if (sb <= lb) {
#pragma unroll
                for (int kk = 0; kk < 4; ++kk) sc[sbi] = MFMA16(*(const LAS bf16x8*)(Cn + (16 * lb + r) * 136 + 32 * kk + 8 * q), *(const LAS bf16x8*)(Bn + (16 * sb + r) * 136 + 32 * kk + 8 * q), sc[sbi]);
            } }
    }
#pragma unroll
    for (int hh = 0; hh < 4; ++hh) { const int h = 4 * g + hh; const int unit_h = (b * 32 + c) * 8 + h;
        {
            const int cgx = 8 * hh + wave; const LAS float* cwl = CW + (32 + cgx) * 40;
            float o8[8];
            { const f32x4 b0 = *(const LAS f32x4*)(cwl + 32), b1 = *(const LAS f32x4*)(cwl + 36);
#pragma unroll
              for (int e = 0; e < 4; ++e) { o8[e] = b0[e]; o8[4 + e] = b1[e]; } }
#pragma unroll
            for (int k = 0; k < 4; ++k) { const v4u iv = *(const LAS v4u*)(RAWX + (lane + k) * 264 + 8 * cgx);
                const f32x4 w0v = *(const LAS f32x4*)(cwl + 8 * k), w1v = *(const LAS f32x4*)(cwl + 8 * k + 4);
                o8[0] += w0v[0] * bf_lo(iv[0]); o8[1] += w0v[1] * bf_hi(iv[0]); o8[2] += w0v[2] * bf_lo(iv[1]); o8[3] += w0v[3] * bf_hi(iv[1]);
                o8[4] += w1v[0] * bf_lo(iv[2]); o8[5] += w1v[1] * bf_hi(iv[2]); o8[6] += w1v[2] * bf_lo(iv[3]); o8[7] += w1v[3] * bf_hi(iv[3]); }
#pragma unroll
            for (int e = 0; e < 8; ++e) o8[e] = o8[e] * sigm(o8[e]);
            v4u o; o.x = cvt_pk_bf16(o8[0], o8[1]); o.y = cvt_pk_bf16(o8[2], o8[3]); o.z = cvt_pk_bf16(o8[4], o8[5]); o.w = cvt_pk_bf16(o8[6], o8[7]);
#pragma unroll
            for (int e = 0; e < 8; ++e) { XT[(8 * wave + e) * 72 + lane] = f2bf(o8[e] * dt[hh]); XdT[(8 * wave + e) * 72 + lane] = f2bf(o8[e] * dd[hh]); }
            *(LAS v4u*)(Xr + lane * 64 + 8 * wave) = o;
        }
        {
            const int lb = wave >> 1; const LAS float* acsh = ACS4 + hh * 64;
#pragma unroll
            for (int sbi = 0; sbi < 2; ++sbi) { const int sb = 2 * (wave & 1) + sbi; const int sx = 16 * sb + r; const float as = acsh[sx];
#pragma unroll
                for (int j = 0; j < 4; ++j) { const int l = 16 * lb + 4 * q + j; const float v = (l >= sx && sb <= lb) ? sc[sbi][j] * __expf(acsh[l] - as) : 0.f; Ms[l * 72 + sx] = f2bf(v); } }
        }
        __syncthreads();
        {
            const int lb = wave >> 1, l = 16 * lb + r; const float dsk = d_skip[h];
            const bf16x8 m0v = *(const LAS bf16x8*)(Ms + l * 72 + 8 * q), m1v = *(const LAS bf16x8*)(Ms + l * 72 + 32 + 8 * q);
#pragma unroll
            for (int pbi = 0; pbi < 2; ++pbi) { const int pb = 2 * (wave & 1) + pbi;
                f32x4 acc = (f32x4){0.f, 0.f, 0.f, 0.f};
                acc = MFMA16(*(const LAS bf16x8*)(XT + (16 * pb + r) * 72 + 8 * q), m0v, acc); acc = MFMA16(*(const LAS bf16x8*)(XT + (16 * pb + r) * 72 + 32 + 8 * q), m1v, acc);
                const int p0 = 16 * pb + 4 * q; const f32x4 xv = bf4(*(const LAS v2u*)(Xr + l * 64 + p0));
                v2u o; o.x = cvt_pk_bf16(acc[0] + dsk * xv[0], acc[1] + dsk * xv[1]); o.y = cvt_pk_bf16(acc[2] + dsk * xv[2], acc[3] + dsk * xv[3]);
                *(v2u*)(Y + (m0 + l) * 1024 + 512 + 64 * h + p0) = o;
            }
            const int pb = wave & 3;
            const bf16x8 x0 = *(const LAS bf16x8*)(XdT + (16 * pb + r) * 72 + 8 * q), x1 = *(const LAS bf16x8*)(XdT + (16 * pb + r) * 72 + 32 + 8 * q);
            bf16* cs = CS + (size_t)unit_h * 8192 + (16 * pb + r) * 128;
#pragma unroll
            for (int i = 0; i < 4; ++i) { const int nb = 4 * (wave >> 2) + i;
                f32x4 acc = (f32x4){0.f, 0.f, 0.f, 0.f};
                acc = MFMA16(*(const LAS bf16x8*)(BT + (16 * nb + r) * 72 + 8 * q), x0, acc); acc = MFMA16(*(const LAS bf16x8*)(BT + (16 * nb + r) * 72 + 32 + 8 * q), x1, acc);
                v2u o; o.x = cvt_pk_bf16(acc[0], acc[1]); o.y = cvt_pk_bf16(acc[2], acc[3]);
                *(v2u*)(cs + 16 * nb + 4 * q) = o;
            }
            if (tid == 0) CD[unit_h] = __expf(aend[hh]);
        }
        __syncthreads();
    }
}
__device__ __forceinline__ void ssd_scan_item(int item, bf16* CS, const float* CD, bool dost) {
    const int bh = item >> 10, e8 = (item & 1023) * 8, b = bh >> 3, h = bh & 7;
    float st[8];
#pragma unroll
    for (int e = 0; e < 8; ++e) st[e] = 0.f;
    for (int cb = 0; cb < 2; ++cb) {
        v4u v[16]; float d[16];
#pragma unroll
        for (int k = 0; k < 16; ++k) { const int unit = (b * 32 + 16 * cb + k) * 8 + h; v[k] = *(const v4u*)(CS + (size_t)unit * 8192 + e8); d[k] = CD[unit]; }
#pragma unroll
        for (int k = 0; k < 16; ++k) { const int unit = (b * 32 + 16 * cb + k) * 8 + h;
            v4u o; o.x = cvt_pk_bf16(st[0], st[1]); o.y = cvt_pk_bf16(st[2], st[3]); o.z = cvt_pk_bf16(st[4], st[5]); o.w = cvt_pk_bf16(st[6], st[7]);
            if (dost) *(v4u*)(CS + (size_t)unit * 8192 + e8) = o;
#pragma unroll
            for (int e = 0; e < 4; ++e) { st[2 * e] = st[2 * e] * d[k] + bf_lo(v[k][e]); st[2 * e + 1] = st[2 * e + 1] * d[k] + bf_hi(v[k][e]); } }
    }
}
__device__ __forceinline__ void mix_out_unit(LAS unsigned char* lds, int unit, const bf16* P, const bf16* G, const float* BON, bf16* Y, const bf16* CS, const float* mu, const float* gn_g, const float* gn_b,
                                             const float* ssm_norm, const float* conv_w, const float* conv_b, const float* dt_bias, const float* a_log, int tid, int wave, int lane, bool st = true) {
    const int c = unit & 31, b = unit >> 5, h = wave, g = h >> 2;
    LAS bf16* Cn2 = (LAS bf16*)(lds); LAS float* ACS8 = (LAS float*)(lds + 34816); LAS float* SS8 = (LAS float*)(lds + 36864);
    const int r = lane & 15, q = lane >> 4;
    const size_t m0 = (size_t)b * SEQ + 64 * c; const bf16* prow = P + (m0 + lane) * PP;
    {
        const float xdt = bf1(prow[3328 + h]) + dt_bias[h]; const float dt = xdt > 20.f ? xdt : log1pf(__expf(xdt));
        float acs = dt * (-__expf(a_log[h]));
#pragma unroll
        for (int o = 1; o < 64; o <<= 1) { const float t = __shfl_up(acs, o); if (lane >= o) acs += t; }
        ACS8[h * 64 + lane] = acs;
    }
    {
        const int cl = lane & 31, chb = 3072 + 8 * cl, cw = chb - 2304;
        const bf16* pbase = P + (m0 + 8 * wave) * PP + chb;
        v4u win[11];
#pragma unroll
        for (int k = 0; k < 11; ++k) { win[k] = (v4u){0u, 0u, 0u, 0u}; if (64 * c + 8 * wave + k - 3 >= 0) win[k] = *(const v4u*)(pbase + (ptrdiff_t)(k - 3) * PP); }
        float cwv[4][8], cbv[8];
#pragma unroll
        for (int e = 0; e < 8; ++e) { cbv[e] = conv_b[cw + e];
#pragma unroll
            for (int k = 0; k < 4; ++k) cwv[k][e] = conv_w[k * 1024 + cw + e]; }
#pragma unroll
        for (int tl = 0; tl < 8; ++tl) { const int t = 8 * wave + tl;
            float o8[8];
#pragma unroll
            for (int e = 0; e < 8; ++e) o8[e] = cbv[e];
#pragma unroll
            for (int k = 0; k < 4; ++k) { const v4u iv = win[tl + k];
#pragma unroll
                for (int e = 0; e < 4; ++e) { o8[2 * e] += cwv[k][2 * e] * bf_lo(iv[e]); o8[2 * e + 1] += cwv[k][2 * e + 1] * bf_hi(iv[e]); } }
#pragma unroll
            for (int e = 0; e < 8; ++e) o8[e] = o8[e] * sigm(o8[e]);
            v4u o; o.x = cvt_pk_bf16(o8[0], o8[1]); o.y = cvt_pk_bf16(o8[2], o8[3]); o.z = cvt_pk_bf16(o8[4], o8[5]); o.w = cvt_pk_bf16(o8[6], o8[7]);
            if (lane < 32) *(LAS v4u*)(Cn2 + (cl >> 4) * 8704 + t * 136 + 8 * (cl & 15)) = o;
        }
    }
    __syncthreads();
    float ssl[4];
    {
        const bf16* cs = CS + (size_t)((b * 32 + c) * 8 + h) * 8192; const LAS bf16* Cg = Cn2 + g * 8704;
#pragma unroll
        for (int lb = 0; lb < 4; ++lb) ssl[lb] = 0.f;
#pragma unroll
        for (int pb = 0; pb < 4; ++pb) {
            bf16x8 bo[4];
#pragma unroll
            for (int kk = 0; kk < 4; ++kk) bo[kk] = *(const bf16x8*)(cs + (16 * pb + r) * 128 + 32 * kk + 8 * q);
            const int p0 = 16 * pb + 4 * q;
#pragma unroll
            for (int lb = 0; lb < 4; ++lb) { const int l = 16 * lb + r;
                bf16* yp = Y + (m0 + l) * 1024 + 512 + 64 * h + p0;
                const v2u yv = *(const v2u*)yp, zv = *(const v2u*)(P + (m0 + l) * PP + 1792 + 64 * h + p0);
                f32x4 acc = (f32x4){0.f, 0.f, 0.f, 0.f};
#pragma unroll
                for (int kk = 0; kk < 4; ++kk) acc = MFMA16(bo[kk], *(const LAS bf16x8*)(Cg + l * 136 + 32 * kk + 8 * q), acc);
                const float ea = __expf(ACS8[h * 64 + l]); const f32x4 y4 = bf4(yv) + ea * acc, z4 = bf4(zv);
                f32x4 u4;
#pragma unroll
                for (int j = 0; j < 4; ++j) { u4[j] = y4[j] * z4[j] * sigm(z4[j]); ssl[lb] += u4[j] * u4[j]; }
                v2u o; o.x = cvt_pk_bf16(u4[0], u4[1]); o.y = cvt_pk_bf16(u4[2], u4[3]);
                if (st) *(v2u*)yp = o;
            }
            asm volatile("" ::: "memory");
        }
#pragma unroll
        for (int lb = 0; lb < 4; ++lb) { float t = ssl[lb]; t += __shfl_xor(t, 16); t += __shfl_xor(t, 32); if (q == 0) SS8[h * 64 + 16 * lb + r] = t; }
    }
    __syncthreads();
    {
#pragma unroll
        for (int lb = 0; lb < 4; ++lb) { const int l = 16 * lb + r; float t = 0.f;
#pragma unroll
            for (int hh = 0; hh < 8; ++hh) t += SS8[hh * 64 + l];
            const float rs = __builtin_amdgcn_rsqf(t * (1.f / 512.f) + 1e-5f);
#pragma unroll
            for (int pb = 0; pb < 4; ++pb) { const int p0 = 16 * pb + 4 * q; bf16* yp = Y + (m0 + l) * 1024 + 512 + 64 * h + p0;
                const f32x4 u4 = bf4(*(const v2u*)yp) * rs * *(const f32x4*)(ssm_norm + 64 * h + p0);
                v2u o; o.x = cvt_pk_bf16(u4[0], u4[1]); o.y = cvt_pk_bf16(u4[2], u4[3]); if (st) *(v2u*)yp = o; }
        }
    }
    {
        const int c8 = 8 * lane, hh = lane >> 3;
        float gg[8], gb[8], muv[8];
#pragma unroll
        for (int e = 0; e < 8; ++e) { gg[e] = gn_g[c8 + e]; gb[e] = gn_b[c8 + e]; muv[e] = mu[1024 + c8 + e]; }
#pragma unroll
        for (int bt = 0; bt < 2; ++bt) {
            v4u yv[4], gv[4], vc[4], vp[4]; float bon[4];
#pragma unroll
            for (int k = 0; k < 4; ++k) { const size_t m = m0 + 8 * wave + 4 * bt + k; const int t = (int)(m & (SEQ - 1)); const bf16* pr = P + m * PP;
                yv[k] = *(const v4u*)(Y + m * 1024 + c8); gv[k] = *(const v4u*)(G + m * 512 + c8); vc[k] = *(const v4u*)(pr + 1024 + c8);
                vp[k] = (v4u){0u, 0u, 0u, 0u}; if (t) vp[k] = *(const v4u*)(pr - PP + 1024 + c8); bon[k] = BON[m * 8 + hh]; }
#pragma unroll
            for (int k = 0; k < 4; ++k) { const size_t m = m0 + 8 * wave + 4 * bt + k;
                float y[8], sm = 0.f;
#pragma unroll
                for (int e = 0; e < 4; ++e) { y[2 * e] = bf_lo(yv[k][e]); y[2 * e + 1] = bf_hi(yv[k][e]); sm += y[2 * e] + y[2 * e + 1]; }
                sm += __shfl_xor(sm, 1); sm += __shfl_xor(sm, 2); sm += __shfl_xor(sm, 4);
                const float mean = sm * (1.f / 64.f); float qv_ = 0.f;
#pragma unroll
                for (int e = 0; e < 8; ++e) { y[e] -= mean; qv_ += y[e] * y[e]; }
                qv_ += __shfl_xor(qv_, 1); qv_ += __shfl_xor(qv_, 2); qv_ += __shfl_xor(qv_, 4);
                const float rstd = __builtin_amdgcn_rsqf(qv_ * (1.f / 64.f) + 64e-5f);
                float o[8];
#pragma unroll
                for (int e = 0; e < 4; ++e) {
                    const float v0 = bf_lo(vc[k][e]), v1 = bf_hi(vc[k][e]), p0 = bf_lo(vp[k][e]), p1 = bf_hi(vp[k][e]);
                    const float va = v0 + (p0 - v0) * muv[2 * e], vb = v1 + (p1 - v1) * muv[2 * e + 1];
                    o[2 * e] = (y[2 * e] * rstd * gg[2 * e] + gb[2 * e] + bon[k] * va) * bf_lo(gv[k][e]);
                    o[2 * e + 1] = (y[2 * e + 1] * rstd * gg[2 * e + 1] + gb[2 * e + 1] + bon[k] * vb) * bf_hi(gv[k][e]);
                }
                v4u w; w.x = cvt_pk_bf16(o[0], o[1]); w.y = cvt_pk_bf16(o[2], o[3]); w.z = cvt_pk_bf16(o[4], o[5]); w.w = cvt_pk_bf16(o[6], o[7]);
                if (st) *(v4u*)(Y + m * 1024 + c8) = w;
            }
        }
    }
    __syncthreads();
}
#define XB_TMO      128
#define XB_XCNT(j)  (256  + 64 * (j))
#define XB_XSUB(j)  (1280 + 64 * (j))
#define XB_XGEN(j)  (2304 + 64 * (j))
#define XB_TOP      3328
#define XB_TOPGEN   3392
#define XCD_BAR_WORDS 3456
#define XB_SPIN_CAP (1u << 18)

__device__ __forceinline__ unsigned xb_ld(unsigned* p)              { return __hip_atomic_load(p, __ATOMIC_RELAXED, __HIP_MEMORY_SCOPE_AGENT); }
__device__ __forceinline__ unsigned xb_add(unsigned* p, unsigned v) { return __hip_atomic_fetch_add(p, v, __ATOMIC_RELAXED, __HIP_MEMORY_SCOPE_AGENT); }
__device__ __forceinline__ unsigned xb_xcc_id() { return (unsigned)__builtin_amdgcn_s_getreg((3 << 11) | 20) & 0xFu; }
#define XB_SPIN(cond, bar) do { unsigned _sp = 0; while (cond) { __builtin_amdgcn_s_sleep(1); \
    if ((++_sp & 255u) == 0u) { if (xb_ld(&(bar)[XB_TMO])) break; if (_sp > XB_SPIN_CAP) { atomicAdd(&(bar)[XB_TMO], 1u); break; } } } } while (0)

struct XcdBarrier {
    unsigned* bar; unsigned x;
    volatile LAS unsigned* st;
};

__device__ __forceinline__ XcdBarrier xcd_barrier_post(unsigned* bar, volatile LAS unsigned* st) {
    XcdBarrier b; b.bar = bar; b.x = xb_xcc_id(); b.st = st;
    if (threadIdx.x == 0) (void)xb_add(&bar[XB_XCNT(b.x)], 1u);
    return b;
}
__device__ __forceinline__ void xcd_barrier_complete(unsigned* bar, unsigned x, unsigned& nloc, unsigned& nx) {
    const unsigned G = gridDim.x * gridDim.y * gridDim.z;
    unsigned sum, cnt, mine, sp = 0u;
    for (;;) {
        sum = 0u; cnt = 0u; mine = 0u;
#pragma unroll
        for (unsigned j = 0; j < 16; ++j) { const unsigned c = xb_ld(&bar[XB_XCNT(j)]); sum += c; cnt += (c > 0u) ? 1u : 0u; mine = (j == x) ? c : mine; }
        if (sum == G) break;
        __builtin_amdgcn_s_sleep(1);
        if ((++sp & 255u) == 0u) { if (xb_ld(&bar[XB_TMO])) break; if (sp > XB_SPIN_CAP) { atomicAdd(&bar[XB_TMO], 1u); break; } }
    }
    nloc = mine > 0u ? mine : 1u; nx = cnt > 0u ? cnt : 1u;
}

__device__ __forceinline__ void xcd_barrier(const XcdBarrier& b) {
    asm volatile("s_waitcnt vmcnt(0)" ::: "memory");
    __syncthreads();
    if (threadIdx.x == 0) {
        unsigned* bar = b.bar;
        __builtin_amdgcn_s_waitcnt(0);
        unsigned nloc = b.st[0], nx = b.st[1];
        if (nloc == 0u) { xcd_barrier_complete(bar, b.x, nloc, nx); b.st[0] = nloc; b.st[1] = nx; }
        const unsigned old = xb_add(&bar[XB_XSUB(b.x)], 1u);
        const unsigned gen = old / nloc;
        if (old + 1u == (gen + 1u) * nloc) {
            __builtin_amdgcn_fence(__ATOMIC_RELEASE, "agent");
            asm volatile("s_waitcnt vmcnt(0)" ::: "memory");
            const unsigned og = xb_add(&bar[XB_TOP], 1u);
            const unsigned tg = og / nx;
            if (og + 1u == (tg + 1u) * nx) xb_add(&bar[XB_TOPGEN], 1u);
            else XB_SPIN(xb_ld(&bar[XB_TOPGEN]) == tg, bar);
            __builtin_amdgcn_fence(__ATOMIC_ACQUIRE, "agent");
            xb_add(&bar[XB_XGEN(b.x)], 1u);
            asm volatile("s_waitcnt vmcnt(0)" ::: "memory");
        } else {
            XB_SPIN(xb_ld(&bar[XB_XGEN(b.x)]) == gen, bar);
            __builtin_amdgcn_fence(__ATOMIC_ACQUIRE, "agent");
            asm volatile("s_waitcnt vmcnt(0)" ::: "memory");
        }
    }
    __syncthreads();
}

struct Args { const float* in[30]; float* out; unsigned char* ws; int ph_lo, ph_hi, dry, pad; };
__global__ void __launch_bounds__(NTHREADS, 2) fwd_kernel(Args args) {
    extern __shared__ __attribute__((aligned(16))) unsigned char lds_raw[];
    LAS unsigned char* lds = (LAS unsigned char*)lds_raw;
    const int tid = threadIdx.x, lane = tid & 63, wave = __builtin_amdgcn_readfirstlane(tid >> 6);
    const int G = gridDim.x, bx = blockIdx.x; const int vcu = (G % 8 == 0) ? (bx % 8) * (G / 8) + bx / 8 : bx;
    const int gw = vcu * NWAVES + wave, NGW = G * NWAVES;
    unsigned char* ws = args.ws;
    const float* const* in = args.in;
    bf16* W1GU = (bf16*)(ws + WS_W1GU); bf16* W1D = (bf16*)(ws + WS_W1D); bf16* WIN = (bf16*)(ws + WS_WIN); bf16* WOUT = (bf16*)(ws + WS_WOUT);
    bf16* W2GU = (bf16*)((unsigned char*)args.out + 32 * MiB);     bf16* W2D = (bf16*)(ws + WS_W2D); bf16* WL = (bf16*)(ws + WS_WL);
    bf16* XG = (bf16*)(ws + WS_XG); bf16* PB = (bf16*)(ws + WS_P); bf16* YB = (bf16*)(ws + WS_Y); bf16* GB = (bf16*)(ws + WS_G); bf16* LIN = (bf16*)(ws + WS_LIN);
    bf16* EAB = (bf16*)args.out;
    float* PART = (float*)(ws + WS_PART); float* BON = (float*)(ws + WS_BONUS); float* GCG = (float*)(ws + WS_GC); unsigned* SLG = (unsigned*)(ws + WS_LIN); bf16* CSB = (bf16*)(ws + WS_CS); float* CDB = (float*)(ws + WS_CD);
    const int lo = args.ph_lo, hi = args.ph_hi;
    cg::grid_group grid = cg::this_grid();
    volatile LAS unsigned* xbst = (volatile LAS unsigned*)(lds + 147440);
    if (tid < 2) xbst[tid] = 0u;
    __syncthreads();
    XcdBarrier xbar; xbar.bar = (unsigned*)ws; xbar.x = 0; xbar.st = nullptr;
    if (hi - lo > 1) xbar = xcd_barrier_post((unsigned*)ws, xbst);
#ifndef PH_MASK
#define PH_MASK 0xfff
#endif
#ifndef REPG
#define REPG 1
#endif
#ifndef REP0
#define REP0 1
#endif
#define IN(k) (((PH_MASK >> (k)) & 1) && lo <= (k) && (k) < hi)
#define SEAM(k) do { if (IN(k) && IN((k) + 1)) { if (args.pad != 0) grid.sync(); else xcd_barrier(xbar); } } while (0)
    if (IN(0)) { p0_prologue(lds, in, ws, vcu, G, tid, wave, lane); SEAM(0); }
    if (IN(1)) {
        pg8::Gemm g{XG, W1GU, M, NGU, D}; pg8::StaticOrder S; S.init(M, NGU, G, bx);
        pg8::EpiSwiGLU E{PB, FF, nullptr};
        pg8::gemm_phase<pg8::EpiSwiGLU, pg8::StaticOrder, true, true>(lds, g, S, E);
        if (G == 256 ? bx >= 128 : true) { const int tb_ = G == 256 ? bx - 128 : bx, ntb = G == 256 ? 128 : G; p1_tail_copies(in, ws, tb_ * NWAVES + wave, ntb * NWAVES, tb_ * NTHREADS + tid, ntb * NTHREADS, lane); }
        SEAM(1);
    }
    if (IN(2)) {
        pg8::Gemm g{PB, W1D, M, D, FF}; pg8::StaticOrder S; S.init(M, D, G, bx);
        pg8::EpiResidB<false> E{in[0], XG, nullptr, PART, 0.5f, nullptr, nullptr};
        pg8::gemm_phase<pg8::EpiResidB<false>, pg8::StaticOrder, true, true>(lds, g, S, E);
        SEAM(2);
    }
    if (IN(3)) {
        pg8::Gemm g{XG, WIN, M, NINP, D}; pg8::StaticOrder S; S.init(M, NINP, G, bx);
        pg8::EpiScaleBf16 E{PB, PP, NIN, PART};
        pg8::gemm_phase<pg8::EpiScaleBf16, pg8::StaticOrder, true, true>(lds, g, S, E);
        if (G == 256 ? bx >= 128 : true) {
            const int tb_ = G == 256 ? bx - 128 : bx, ntw = (G == 256 ? 128 : G) * NWAVES;
            for (int it = tb_ * NWAVES + wave; it < 2 * TR_I_GU; it += 2 * ntw) {
                int ra = it; const int upa = ra >= TR_I_GU; ra -= upa * TR_I_GU; const TrItem a = tr_make(in[26 + upa], FF, ra / 44, ra % 44, W2GU, D, 0, 0, 1, upa, lane, in[25]);
                const bool hasb = it + ntw < 2 * TR_I_GU; int rb = hasb ? it + ntw : it; const int upb = rb >= TR_I_GU; rb -= upb * TR_I_GU; const TrItem b = tr_make(in[26 + upb], FF, rb / 44, rb % 44, W2GU, D, 0, 0, 1, upb, lane, in[25]);
                f32x4 va[8], vb[8]; tr_load(a, va); tr_load(b, vb); tr_store(a, va); if (hasb) tr_store(b, vb);
            }
        }
        SEAM(3);
    }
    if (IN(4)) { p4_lora_in(PB, in[7], LIN, vcu * NTHREADS + tid, G * NTHREADS); SEAM(4); }
    if (IN(5)) {
        int kl = 128; asm volatile("" : "+s"(kl));
        { pg8::Gemm g{LIN, WL, M, 1024, kl, KLORA}; pg8::StaticOrder S; S.init(M, 1024, G, bx);
          pg8::EpiLora E{EAB, GB};
          pg8::gemm_phase<pg8::EpiLora, pg8::StaticOrder, true, true>(lds, g, S, E); }
        { pg8::Gemm g{LIN + 128, WL + (size_t)1024 * KLORA + 128, M, 512, kl, KLORA}; pg8::StaticOrder S; S.init(M, 512, G, (bx + 128) % G);
          pg8::EpiLoraG E2{GB};
          pg8::gemm_phase<pg8::EpiLoraG, pg8::StaticOrder, true, true>(lds, g, S, E2); }
        SEAM(5);
    }
    const int dry = args.dry;
    if (IN(6)) {
        {
            const int h6 = vcu & 7, g6 = h6 >> 2; LAS float* CW = (LAS float*)(lds + 133632); LAS float* PRMw = (LAS float*)(lds + 140032);
            for (int idx = tid; idx < 1600; idx += NTHREADS) { const int cgp = idx / 40, rem = idx % 40, k = rem >> 3, e = rem & 7;
                const int chb = cgp < 8 ? 2304 + 64 * h6 + 8 * cgp : (cgp < 24 ? 2816 + 128 * g6 + 8 * (cgp - 8) : 3072 + 128 * g6 + 8 * (cgp - 24));
                CW[idx] = k < 4 ? in[18][k * 1024 + chb - 2304 + e] : in[19][chb - 2304 + e]; }
            { const int a = tid >> 6, j = tid & 63; const float* src = a < 3 ? in[7] + 512 * a : (a == 3 ? in[13] : (a == 4 ? in[14] : (a == 5 ? in[15] : (a == 6 ? in[8] : in[10]))));
              PRMw[tid] = src[64 * h6 + j]; }
            __syncthreads();
        }
        if (dry == 0 || (dry & 1)) { RwIn rin; rwkv_chunk_load(rin, vcu, PB, EAB, tid);
            for (int u = vcu; u < 2048; u += G) { rwkv_chunk_unit(lds, u, rin, u + G < 2048 ? u + G : -1, PB, EAB, YB, BON, GCG, SLG, tid, wave, lane, dry == 0, dry >> 4); } }
        if (dry == 0 || (dry & 2)) {
            {
                __syncthreads();
                const int g6 = vcu & 1; LAS float* CW = (LAS float*)(lds + 133632);
                for (int idx = tid; idx < 2560; idx += NTHREADS) { const int cgp = idx / 40, rem = idx % 40, k = rem >> 3, e = rem & 7;
                    const int chb = cgp < 16 ? 2816 + 128 * g6 + 8 * cgp : (cgp < 32 ? 3072 + 128 * g6 + 8 * (cgp - 16) : 2304 + 256 * g6 + 8 * (cgp - 32));
                    CW[idx] = k < 4 ? in[18][k * 1024 + chb - 2304 + e] : in[19][chb - 2304 + e]; }
                __syncthreads();
            }
            for (int u = vcu; u < 512; u += G) ssd_chunk_group(lds, u, PB, YB, CSB, CDB, in[20], in[21], in[22], tid, wave, lane);
        }
        SEAM(6);
    }
    if (IN(7)) {
        volatile LAS unsigned* prog = (volatile LAS unsigned*)(lds + 131072);
        if (tid == 0) *prog = 0u;
        __syncthreads();
        if (wave == 0) { if ((dry == 0 || (dry & 1)) && vcu < 256) rwkv_seq_state(lds, prog, vcu, EAB, GCG, SLG, lane); }
        else if (wave == 1) { if ((dry == 0 || (dry & 1)) && vcu < 256) rwkv_seq_out(lds, prog, vcu, EAB, YB, lane, dry == 0); }
        else if (dry == 0 || (dry & 2)) { for (int it = (vcu * 6 + wave - 2) * 64 + lane; it < 65536; it += G * 6 * 64) ssd_scan_item(it, CSB, CDB, dry == 0); }
        SEAM(7);
    }
    if (IN(8)) {
        if (dry == 0 || (dry & 1)) for (int u = vcu; u < 256; u += G) mix_out_unit(lds, u, PB, GB, BON, YB, CSB, in[7], in[16], in[17], in[23], in[18], in[19], in[20], in[21], tid, wave, lane, dry == 0);
        SEAM(8);
    }
    if (IN(9)) {
        pg8::Gemm g{YB, WOUT, M, D, D}; pg8::StaticOrder S; S.init(M, D, G, bx);
        pg8::EpiResidB<true> E{XG, XG, nullptr, PART, 1.0f, nullptr, nullptr};
        pg8::gemm_phase<pg8::EpiResidB<true>, pg8::StaticOrder, true, true>(lds, g, S, E);
        SEAM(9);
    }
    if (IN(10)) {
        pg8::Gemm g{XG, W2GU, M, NGU, D}; pg8::StaticOrder S; S.init(M, NGU, G, bx);
        pg8::EpiSwiGLU E{PB, FF, PART};
        pg8::gemm_phase<pg8::EpiSwiGLU, pg8::StaticOrder, true, true>(lds, g, S, E);
        if (G == 256 ? bx >= 128 : true) { const int tb_ = G == 256 ? bx - 128 : bx, ntb = G == 256 ? 128 : G; tail_copy_range(in, ws, TR_W2D_LO, TR_W2D_HI, tb_ * NWAVES + wave, ntb * NWAVES, lane); }
        SEAM(10);
    }
    if (IN(11)) {
        pg8::Gemm g{PB, W2D, M, D, FF}; pg8::StaticOrder S; S.init(M, D, G, bx);
        pg8::EpiResidNormFinal E{XG, args.out, in[29], (float*)(ws + 65536), (unsigned*)(ws + 16384), 0.5f};
        pg8::gemm_phase<pg8::EpiResidNormFinal, pg8::StaticOrder, false, true>(lds, g, S, E);
    }
#undef IN
#undef SEAM
}

extern "C" void kernel_launch(void* const* d_in, const int* in_sizes, int n_in, void* d_out, int out_size, void* d_ws, size_t ws_size, hipStream_t stream) {
    static int grid = 0;
    if (grid == 0) {
        if (n_in != 30 || out_size != M * D || ws_size < WS_END) { fprintf(stderr, "kernel_launch: unexpected shapes (n_in %d out %d ws %zu)\n", n_in, out_size, ws_size); grid = -1; return; }
        int dev = 0, cus = 0, per_cu = 0;
        hipGetDevice(&dev); hipDeviceGetAttribute(&cus, hipDeviceAttributeMultiprocessorCount, dev);
        if (hipFuncSetAttribute((const void*)fwd_kernel, hipFuncAttributeMaxDynamicSharedMemorySize, LDS_BYTES) != hipSuccess) { fprintf(stderr, "kernel_launch: hipFuncSetAttribute failed\n"); grid = -1; return; }
        hipOccupancyMaxActiveBlocksPerMultiprocessor(&per_cu, (const void*)fwd_kernel, NTHREADS, LDS_BYTES);
        (void)hipGetLastError();
        if (per_cu < 1) per_cu = 1;
        grid = cus * 1;
        if (grid != 256) fprintf(stderr, "kernel_launch: note: grid %d\n", grid);
    }
    if (grid < 0) return;
    Args a{};
    for (int i = 0; i < 30; ++i) a.in[i] = (const float*)d_in[i];
    a.out = (float*)d_out; a.ws = (unsigned char*)d_ws;
    if (hipMemsetAsync(d_ws, 0, 32768, stream) != hipSuccess) { fprintf(stderr, "kernel_launch: memset of the control words failed\n"); return; }
#if MK_N_LAUNCHES == 1
    a.ph_lo = 0; a.ph_hi = NPHASE;
    void* kargs[] = {&a};
    hipError_t e = hipLaunchCooperativeKernel((const void*)fwd_kernel, dim3(grid), dim3(NTHREADS), kargs, LDS_BYTES, stream);
    if (e != hipSuccess) fprintf(stderr, "cooperative launch failed: %s (grid %d)\n", hipGetErrorString(e), grid);
#else
    #ifndef REP_PHASE_MASK
#define REP_PHASE_MASK 0
#endif
#ifndef PROBE_PHASE
#define PROBE_PHASE -1
#define PROBE_SEL 0
#endif
    for (int p = 0; p < NPHASE; ++p) { a.ph_lo = p; a.ph_hi = p + 1; const int nrep = ((REP_PHASE_MASK >> p) & 1) ? 2 : 1;
        if (p == PROBE_PHASE) { a.dry = PROBE_SEL; hipLaunchKernelGGL(fwd_kernel, dim3(grid), dim3(NTHREADS), LDS_BYTES, stream, a); a.dry = 0; }
        for (int rr = 0; rr < nrep; ++rr) hipLaunchKernelGGL(fwd_kernel, dim3(grid), dim3(NTHREADS), LDS_BYTES, stream, a); }
#endif
}
```

```cpp
#include <hip/hip_runtime.h>
#include <hip/hip_cooperative_groups.h>
#include <cstdio>
#include <cstdint>
namespace cg = cooperative_groups;
#define MK_N_LAUNCHES 1
namespace pg8 {
#define PG8_LAS __attribute__((address_space(3)))
typedef unsigned short bf16_t;
typedef short bf16x8 __attribute__((ext_vector_type(8)));
typedef float f32x4 __attribute__((ext_vector_type(4)));
typedef unsigned u32x4 __attribute__((ext_vector_type(4)));
constexpr int BM = 256, BK = 64, HALF = 128, HTB = HALF * BK * 2  , STAGE_BYTES = 8 * HTB, NXCD = 8, WGM = 4;

__host__ __device__ __forceinline__ int lds_byte(int r, int c) { const int st = (r >> 4) * 2 + (c >> 5), rr = r & 15, cc = c & 31, ob = rr * 64 + cc * 2; return st * 1024 + (ob ^ (((ob >> 9) & 1) << 5)); }
__host__ __device__ __forceinline__ void stage_rc(int b, int& R, int& C) { const int st = b / 1024, sb = b % 1024, swz = sb ^ (((sb >> 9) & 1) << 5); R = (st >> 1) * 16 + swz / 64; C = (st & 1) * 32 + (swz % 64) / 2; }
__host__ __device__ __forceinline__ int perm32(int rho) { const int n = rho >> 4, i = rho & 15; return 8 * (i >> 2) + 4 * n + (i & 3); }

struct Unit { int pm, pn; };
struct Gemm { const bf16_t* A; const bf16_t* Bt; int M, N, K; int ld; };

struct StaticOrder {
    int nM, nN, nwg, G, c;
    __host__ __device__ void init(int M, int N, int G_, int c_) { nM = M / BM; nN = N / BM; nwg = nM * nN; G = G_; c = c_; }
    __host__ __device__ bool next(int i, Unit& u) const {
        const long L = (long)i * G + c; if (L >= nwg) return false;
        int wgid = (int)L; { const int q = nwg / NXCD, r = nwg % NXCD, xcd = wgid % NXCD, off = wgid / NXCD; wgid = (xcd < r ? xcd * (q + 1) : r * (q + 1) + (xcd - r) * q) + off; }
        const int nig = WGM * nN, gid = wgid / nig, fm = gid * WGM, gsz = (nM - fm) < WGM ? (nM - fm) : WGM;
        u.pm = fm + ((wgid % nig) % gsz); u.pn = (wgid % nig) / gsz; return true;
    }
    __device__ __forceinline__ void a_ready(const Unit&) const {}
    __device__ __forceinline__ void done(const Unit&) const {}
};
typedef float f32x2c_ __attribute__((ext_vector_type(2)));
typedef __bf16 bf16x2c_ __attribute__((ext_vector_type(2)));
__device__ __forceinline__ unsigned cvt_pk_bf16(float lo, float hi) { const f32x2c_ v = {lo, hi}; const bf16x2c_ b = __builtin_convertvector(v, bf16x2c_); return __builtin_bit_cast(unsigned, b); }
typedef unsigned u32x2 __attribute__((ext_vector_type(2)));
__device__ __forceinline__ float sigmoidf_(float x) { return __builtin_amdgcn_rcpf(1.0f + __expf(-x)); }
__device__ __forceinline__ float row_rscale(const float* part, int row) {
    const f32x4* p = (const f32x4*)(part + (size_t)row * 16);
    const f32x4 a = p[0], b = p[1], c = p[2], d = p[3];
    const f32x4 s = (a + b) + (c + d);
    return __builtin_amdgcn_rsqf(((s[0] + s[1]) + (s[2] + s[3])) * (1.0f / 1024.0f) + 1e-6f);
}
struct EpiSwiGLU {
    static constexpr bool PERM = true, AFTER_DRAIN = false;
    bf16_t* O; int ldc; const float* part;
    __device__ __forceinline__ void operator()(const f32x4 (&acc)[2][2][4][2], const Unit& u, int wr, int wc, int fr, int fq) const {
        const int row0 = u.pm * BM + wr * 64 + fr, col0 = u.pn * HALF + wc * 32 + 8 * fq;
#pragma unroll
        for (int ai = 0; ai < 2; ++ai)
#pragma unroll
            for (int m = 0; m < 4; ++m) {
                const int row = row0 + ai * HALF + m * 16;
                const float rs = part ? row_rscale(part, row) : 1.0f;
                float h[8];
#pragma unroll
                for (int n = 0; n < 2; ++n)
#pragma unroll
                    for (int j = 0; j < 4; ++j) { const float g = acc[ai][0][m][n][j] * rs, up = acc[ai][1][m][n][j] * rs; h[4 * n + j] = g * sigmoidf_(g) * up; }
                u32x4 w; w.x = cvt_pk_bf16(h[0], h[1]); w.y = cvt_pk_bf16(h[2], h[3]); w.z = cvt_pk_bf16(h[4], h[5]); w.w = cvt_pk_bf16(h[6], h[7]);
                *(u32x4*)(O + (size_t)row * ldc + col0) = w;
            }
    }
};
struct EpiScaleBf16 {
    static constexpr bool PERM = true, AFTER_DRAIN = false;
    bf16_t* O; int ldc; int ncols; const float* part;
    __device__ __forceinline__ void operator()(const f32x4 (&acc)[2][2][4][2], const Unit& u, int wr, int wc, int fr, int fq) const {
        const int row0 = u.pm * BM + wr * 64 + fr, col0 = u.pn * BM + wc * 32 + 8 * fq;
#pragma unroll
        for (int ai = 0; ai < 2; ++ai)
#pragma unroll
            for (int m = 0; m < 4; ++m) {
                const int row = row0 + ai * HALF + m * 16; const float rs = row_rscale(part, row);
#pragma unroll
                for (int bj = 0; bj < 2; ++bj) { const int col = col0 + bj * HALF;
                    if (col < ncols) { const f32x4 v0 = acc[ai][bj][m][0] * rs, v1 = acc[ai][bj][m][1] * rs;
                        u32x4 w; w.x = cvt_pk_bf16(v0[0], v0[1]); w.y = cvt_pk_bf16(v0[2], v0[3]); w.z = cvt_pk_bf16(v1[0], v1[1]); w.w = cvt_pk_bf16(v1[2], v1[3]);
                        *(u32x4*)(O + (size_t)row * ldc + col) = w; } }
            }
    }
};
struct EpiLora {
    static constexpr bool PERM = true, AFTER_DRAIN = false;
    bf16_t* EA; bf16_t* G;
    __device__ __forceinline__ void operator()(const f32x4 (&acc)[2][2][4][2], const Unit& u, int wr, int wc, int fr, int fq) const {
        const int row0 = u.pm * BM + wr * 64 + fr, colt = (u.pn & 3) * BM + wc * 32 + 8 * fq;
        bf16_t* base = u.pn < 4 ? EA : G; const int ldc = u.pn < 4 ? 1024 : 512;
#pragma unroll
        for (int ai = 0; ai < 2; ++ai)
#pragma unroll
            for (int m = 0; m < 4; ++m) {
                bf16_t* rowp = base + (size_t)(row0 + ai * HALF + m * 16) * ldc + colt;
#pragma unroll
                for (int bj = 0; bj < 2; ++bj) { const f32x4 v0 = acc[ai][bj][m][0], v1 = acc[ai][bj][m][1];
                    u32x4 w; w.x = cvt_pk_bf16(v0[0], v0[1]); w.y = cvt_pk_bf16(v0[2], v0[3]); w.z = cvt_pk_bf16(v1[0], v1[1]); w.w = cvt_pk_bf16(v1[2], v1[3]);
                    *(u32x4*)(rowp + bj * HALF) = w; }
            }
    }
};

struct EpiLoraG {
    static constexpr bool PERM = true, AFTER_DRAIN = false;
    bf16_t* G;
    __device__ __forceinline__ void operator()(const f32x4 (&acc)[2][2][4][2], const Unit& u, int wr, int wc, int fr, int fq) const {
        const int row0 = u.pm * BM + wr * 64 + fr, colt = u.pn * BM + wc * 32 + 8 * fq;
#pragma unroll
        for (int ai = 0; ai < 2; ++ai)
#pragma unroll
            for (int m = 0; m < 4; ++m) {
                bf16_t* rowp = G + (size_t)(row0 + ai * HALF + m * 16) * 512 + colt;
#pragma unroll
                for (int bj = 0; bj < 2; ++bj) { const f32x4 v0 = acc[ai][bj][m][0], v1 = acc[ai][bj][m][1];
                    u32x4 w; w.x = cvt_pk_bf16(v0[0], v0[1]); w.y = cvt_pk_bf16(v0[2], v0[3]); w.z = cvt_pk_bf16(v1[0], v1[1]); w.w = cvt_pk_bf16(v1[2], v1[3]);
                    *(u32x4*)(rowp + bj * HALF) = w; }
            }
    }
};
__device__ __forceinline__ f32x4 bf4_(u32x2 u) { return (f32x4){__builtin_bit_cast(float, u.x << 16), __builtin_bit_cast(float, u.x & 0xffff0000u), __builtin_bit_cast(float, u.y << 16), __builtin_bit_cast(float, u.y & 0xffff0000u)}; }
template <bool BASE_BF16> struct EpiResidB {
    static constexpr bool PERM = false, AFTER_DRAIN = false;
    const void* base; bf16_t* xo; bf16_t* xo2; float* part; float scale;
    const float* unrs; const float* ungain;
    __device__ __forceinline__ void operator()(const f32x4 (&acc)[2][2][4][2], const Unit& u, int wr, int wc, int fr, int fq) const {
#pragma unroll
        for (int ai = 0; ai < 2; ++ai)
#pragma unroll
            for (int m = 0; m < 4; ++m) {
                const int row = u.pm * BM + ai * HALF + wr * 64 + m * 16 + fr; float ss = 0.f;
                const float irs = unrs ? __builtin_amdgcn_rcpf(unrs[row]) : 1.0f;
#pragma unroll
                for (int bj = 0; bj < 2; ++bj)
#pragma unroll
                    for (int n = 0; n < 2; ++n) {
                        const int col = u.pn * BM + bj * HALF + wc * 32 + n * 16 + 4 * fq; const size_t off = (size_t)row * 1024 + col;
                        f32x4 bs = BASE_BF16 ? bf4_(*(const u32x2*)((const bf16_t*)base + off)) : *(const f32x4*)((const float*)base + off);
                        if (unrs) { const f32x4 gi = *(const f32x4*)(ungain + col); bs = bs * irs * (f32x4){__builtin_amdgcn_rcpf(gi[0]), __builtin_amdgcn_rcpf(gi[1]), __builtin_amdgcn_rcpf(gi[2]), __builtin_amdgcn_rcpf(gi[3])}; }
                        const f32x4 v = bs + acc[ai][bj][m][n] * scale;
                        ss += (v[0] * v[0] + v[1] * v[1]) + (v[2] * v[2] + v[3] * v[3]);
                        u32x2 o; o.x = cvt_pk_bf16(v[0], v[1]); o.y = cvt_pk_bf16(v[2], v[3]); *(u32x2*)(xo + off) = o; if (xo2) *(u32x2*)(xo2 + off) = o;
                    }
                ss += __shfl_xor(ss, 16); ss += __shfl_xor(ss, 32);
                if (fq == 0) part[(size_t)row * 16 + u.pn * 4 + wc] = ss;
            }
    }
};
struct EpiResidNormFinal {
    static constexpr bool PERM = false, AFTER_DRAIN = true;
    const bf16_t* base; float* out; const float* gain; float* xbuf; unsigned* cnt; float scale;
    __device__ __forceinline__ void fused(f32x4 (&acc)[2][2][4][2], const Unit& u, int wr, int wc, int fr, int fq, PG8_LAS unsigned char* lds, int wid, int lane) const {
        PG8_LAS float* Pw = (PG8_LAS float*)lds;
        PG8_LAS float* Sr = (PG8_LAS float*)(lds + 4096);
#pragma unroll
        for (int ai = 0; ai < 2; ++ai)
#pragma unroll
            for (int m = 0; m < 4; ++m) {
                const int rl = ai * HALF + wr * 64 + m * 16 + fr; const size_t rowoff = (size_t)(u.pm * BM + rl) * 1024; float ss = 0.f;
#pragma unroll
                for (int bj = 0; bj < 2; ++bj)
#pragma unroll
                    for (int n = 0; n < 2; ++n) { const int col = u.pn * BM + bj * HALF + wc * 32 + n * 16 + 4 * fq;
                        const f32x4 v = bf4_(*(const u32x2*)(base + rowoff + col)) + acc[ai][bj][m][n] * scale; acc[ai][bj][m][n] = v;
                        ss += (v[0] * v[0] + v[1] * v[1]) + (v[2] * v[2] + v[3] * v[3]); }
                ss += __shfl_xor(ss, 16); ss += __shfl_xor(ss, 32);
                if (fq == 0) Pw[rl * 4 + wc] = ss;
                asm volatile("" : "+v"(acc[ai][0][m][0]), "+v"(acc[ai][0][m][1]), "+v"(acc[ai][1][m][0]), "+v"(acc[ai][1][m][1]));
                if (m & 1) asm volatile("" ::: "memory");
            }
        asm volatile("s_waitcnt lgkmcnt(0)" ::: "memory"); __builtin_amdgcn_s_barrier(); asm volatile("" ::: "memory");
        const int row = wid * 32 + (lane & 31);
        if (lane < 32) { const f32x4 pp = *(const PG8_LAS f32x4*)(Pw + row * 4); const float t = (pp[0] + pp[1]) + (pp[2] + pp[3]);
            __hip_atomic_store(xbuf + (size_t)(u.pm * BM + row) * 4 + u.pn, t, __ATOMIC_RELAXED, __HIP_MEMORY_SCOPE_AGENT); }
        asm volatile("s_waitcnt vmcnt(0)" ::: "memory");
        if (lane == 0) __hip_atomic_fetch_add(cnt + 64 * u.pm, 1u, __ATOMIC_RELAXED, __HIP_MEMORY_SCOPE_AGENT);
        if (wid == 0) {
            unsigned sp = 0;
            while ((unsigned)__builtin_amdgcn_readfirstlane(__hip_atomic_load(cnt + 64 * u.pm, __ATOMIC_RELAXED, __HIP_MEMORY_SCOPE_AGENT)) < 32u) { __builtin_amdgcn_s_sleep(2); if (++sp > (1u << 22)) break; }
            __builtin_amdgcn_fence(__ATOMIC_ACQUIRE, "agent");
        }
        asm volatile("s_waitcnt vmcnt(0) lgkmcnt(0)" ::: "memory"); __builtin_amdgcn_s_barrier(); asm volatile("" ::: "memory");
        if (lane < 32) { const float* sl = xbuf + (size_t)(u.pm * BM + row) * 4; float t = 0.f;
#pragma unroll
            for (int k = 0; k < 4; ++k) t += __hip_atomic_load(sl + k, __ATOMIC_RELAXED, __HIP_MEMORY_SCOPE_AGENT);
            Sr[row] = __builtin_amdgcn_rsqf(t * (1.0f / 1024.0f) + 1e-6f); }
        asm volatile("s_waitcnt vmcnt(0) lgkmcnt(0)" ::: "memory"); __builtin_amdgcn_s_barrier(); asm volatile("" ::: "memory");
#pragma unroll
        for (int ai = 0; ai < 2; ++ai)
#pragma unroll
            for (int m = 0; m < 4; ++m) {
                const int rl = ai * HALF + wr * 64 + m * 16 + fr; const size_t rowoff = (size_t)(u.pm * BM + rl) * 1024; const float rs = Sr[rl];
#pragma unroll
                for (int bj = 0; bj < 2; ++bj)
#pragma unroll
                    for (int n = 0; n < 2; ++n) { const int col = u.pn * BM + bj * HALF + wc * 32 + n * 16 + 4 * fq;
                        *(f32x4*)(out + rowoff + col) = acc[ai][bj][m][n] * rs * *(const f32x4*)(gain + col); }
            }
    }
};

template <class Epi, class Sched, bool ALIGN_EPI = false, bool SP2 = false>
__device__ __forceinline__ void gemm_phase(PG8_LAS unsigned char* lds, const Gemm g, const Sched& S, const Epi& E) {
    const int tid = threadIdx.x, wid = __builtin_amdgcn_readfirstlane(tid >> 6), lane = tid & 63, wr = wid >> 2, wc = wid & 3, fr = lane & 15, fq = lane >> 4;
    const int K = g.K, nt = K / BK, LD = g.ld ? g.ld : g.K;
    unsigned voffA[2], voffB[2];
#pragma unroll
    for (int i = 0; i < 2; ++i) { int R, C; stage_rc(tid * 16 + i * 8192, R, C); const int Rb = Epi::PERM ? ((R & ~31) + perm32(R & 31)) : R;
        voffA[i] = (unsigned)(R * LD + C) * 2u; voffB[i] = (unsigned)(Rb * LD + C) * 2u; }
    const size_t kstep = (size_t)(BK * 2);
    const size_t hstep = (size_t)HALF * LD * 2;
    const size_t tstep = 2 * hstep;
    const unsigned ldsw = (unsigned)wid * 1024u;
    const int aoff = lds_byte(wr * 64 + fr, fq * 8), boff = lds_byte(wc * 32 + fr, fq * 8);
#define PG8_SA(b, h) (((b) * 2 + (h)) * HTB)
#define PG8_SB(b, h) ((4 + (b) * 2 + (h)) * HTB)
#define PG8_STAGE(bufoff, gbase, voff) do { _Pragma("unroll") for (int _i = 0; _i < 2; ++_i) \
        __builtin_amdgcn_global_load_lds((const unsigned*)((const char*)(gbase) + (voff)[_i]), (PG8_LAS unsigned*)(lds + (bufoff) + ldsw + _i * 8192), 16, 0, 0); } while (0)
#define PG8_LDA(dst, b, h) do { _Pragma("unroll") for (int m = 0; m < 4; ++m) _Pragma("unroll") for (int k = 0; k < 2; ++k) dst[m][k] = *(const PG8_LAS bf16x8*)(lds + PG8_SA(b, h) + aoff + m * 2048 + k * 1024); } while (0)
#define PG8_LDB(dst, b, h) do { _Pragma("unroll") for (int n = 0; n < 2; ++n) _Pragma("unroll") for (int k = 0; k < 2; ++k) dst[n][k] = *(const PG8_LAS bf16x8*)(lds + PG8_SB(b, h) + boff + n * 2048 + k * 1024); } while (0)
#define PG8_MMA(ai, bj, At, Bt) do { __builtin_amdgcn_s_setprio(1); _Pragma("unroll") for (int m = 0; m < 4; ++m) _Pragma("unroll") for (int n = 0; n < 2; ++n) _Pragma("unroll") for (int k = 0; k < 2; ++k) \
        acc[ai][bj][m][n] = __builtin_amdgcn_mfma_f32_16x16x32_bf16(Bt[n][k], At[m][k], acc[ai][bj][m][n], 0, 0, 0); __builtin_amdgcn_s_setprio(0); } while (0)
#define PG8_WAIT_V(n) asm volatile("s_waitcnt vmcnt(" #n ")" ::: "memory")
#define PG8_WAIT_L(n) asm volatile("s_waitcnt lgkmcnt(" #n ")" ::: "memory")
#define PG8_BAR __builtin_amdgcn_s_barrier()
#define PG8_SCHED __builtin_amdgcn_sched_barrier(0)
    Unit cur, nxt; int ui = 0;
    if (!S.next(0, cur)) return;
    f32x4 acc[2][2][4][2];
#pragma unroll
    for (int a = 0; a < 2; ++a)
#pragma unroll
        for (int b = 0; b < 2; ++b)
#pragma unroll
            for (int m = 0; m < 4; ++m)
#pragma unroll
                for (int n = 0; n < 2; ++n) acc[a][b][m][n] = (f32x4){0.f, 0.f, 0.f, 0.f};
    bf16x8 At[4][2], B0[2][2], B1[2][2];
    const char* cA = (const char*)g.A + (size_t)cur.pm * tstep; const char* cB = (const char*)g.Bt + (size_t)cur.pn * tstep;
    S.a_ready(cur);
    if constexpr (SP2) {
        PG8_STAGE(PG8_SB(0, 0), cB, voffB); PG8_STAGE(PG8_SB(0, 1), cB + hstep, voffB); PG8_STAGE(PG8_SA(0, 0), cA, voffA); PG8_STAGE(PG8_SA(0, 1), cA + hstep, voffA);
        if (wr == 1) PG8_BAR;
        PG8_WAIT_V(2); PG8_BAR;
        PG8_STAGE(PG8_SB(1, 0), cB + kstep, voffB); PG8_STAGE(PG8_SA(1, 0), cA + kstep, voffA); PG8_STAGE(PG8_SB(1, 1), cB + hstep + kstep, voffB);
        PG8_WAIT_V(6); PG8_BAR;
    } else {
        PG8_STAGE(PG8_SB(0, 0), cB, voffB); PG8_STAGE(PG8_SA(0, 0), cA, voffA); PG8_STAGE(PG8_SB(0, 1), cB + hstep, voffB); PG8_STAGE(PG8_SA(0, 1), cA + hstep, voffA);
        if (wr == 1) PG8_BAR;
        PG8_WAIT_V(4); PG8_BAR;
        PG8_STAGE(PG8_SB(1, 0), cB + kstep, voffB); PG8_STAGE(PG8_SA(1, 0), cA + kstep, voffA); PG8_STAGE(PG8_SB(1, 1), cB + hstep + kstep, voffB);
        PG8_WAIT_V(6); PG8_BAR;
    }
    for (;;) {
        const bool has_next = S.next(ui + 1, nxt);
        const char* nA = has_next ? (const char*)g.A + (size_t)nxt.pm * tstep : cA; const char* nB = has_next ? (const char*)g.Bt + (size_t)nxt.pn * tstep : cB;
        for (int t = 0; t < nt; t += 2) {
            const bool last = (t == nt - 2);
            const char* a1 = cA + (size_t)(t + 1) * kstep;
            const char* a2 = last ? nA : cA + (size_t)(t + 2) * kstep; const char* b2 = last ? nB : cB + (size_t)(t + 2) * kstep;
            const char* a3 = a2 + kstep; const char* b3 = b2 + kstep;
            if (last && has_next) S.a_ready(nxt);
            if constexpr (SP2) {
            PG8_LDB(B0, 0, 0); PG8_LDB(B1, 0, 1); PG8_SCHED; PG8_LDA(At, 0, 0); PG8_STAGE(PG8_SA(1, 1), a1 + hstep, voffA);
            PG8_WAIT_V(8); PG8_WAIT_L(0); PG8_BAR; PG8_MMA(0, 0, At, B0); PG8_MMA(0, 1, At, B1); PG8_BAR; PG8_SCHED;
            PG8_LDA(At, 0, 1); PG8_STAGE(PG8_SB(0, 0), b2, voffB); PG8_STAGE(PG8_SB(0, 1), b2 + hstep, voffB); PG8_STAGE(PG8_SA(0, 0), a2, voffA);
            PG8_WAIT_V(8); PG8_WAIT_L(0); PG8_BAR; PG8_MMA(1, 0, At, B0); PG8_MMA(1, 1, At, B1); PG8_BAR; PG8_SCHED;
            PG8_LDB(B0, 1, 0); PG8_LDB(B1, 1, 1); PG8_SCHED; PG8_LDA(At, 1, 0); PG8_STAGE(PG8_SA(0, 1), a2 + hstep, voffA);
            PG8_WAIT_V(8); PG8_WAIT_L(0); PG8_BAR; PG8_MMA(0, 0, At, B0); PG8_MMA(0, 1, At, B1); PG8_BAR; PG8_SCHED;
            PG8_LDA(At, 1, 1); PG8_STAGE(PG8_SB(1, 0), b3, voffB); PG8_STAGE(PG8_SB(1, 1), b3 + hstep, voffB); PG8_STAGE(PG8_SA(1, 0), a3, voffA);
            PG8_WAIT_V(8); PG8_WAIT_L(0); PG8_BAR; PG8_MMA(1, 0, At, B0); PG8_MMA(1, 1, At, B1); PG8_BAR; PG8_SCHED;
            } else {
            PG8_LDB(B0, 0, 0); PG8_SCHED; PG8_LDA(At, 0, 0); PG8_STAGE(PG8_SA(1, 1), a1 + hstep, voffA);
            PG8_WAIT_L(8); PG8_BAR; PG8_WAIT_L(0); PG8_MMA(0, 0, At, B0); PG8_BAR; PG8_SCHED;
            PG8_LDB(B1, 0, 1); PG8_STAGE(PG8_SB(0, 0), b2, voffB);
            PG8_BAR; PG8_WAIT_L(0); PG8_MMA(0, 1, At, B1); PG8_BAR;
            PG8_LDA(At, 0, 1); PG8_STAGE(PG8_SA(0, 0), a2, voffA);
            PG8_BAR; PG8_WAIT_L(0); PG8_MMA(1, 0, At, B0); PG8_BAR; PG8_SCHED;
            PG8_STAGE(PG8_SB(0, 1), b2 + hstep, voffB);
            PG8_WAIT_V(6); PG8_BAR; PG8_MMA(1, 1, At, B1); PG8_BAR;
            PG8_LDB(B0, 1, 0); PG8_SCHED; PG8_LDA(At, 1, 0); PG8_STAGE(PG8_SA(0, 1), a2 + hstep, voffA);
            PG8_WAIT_L(8); PG8_BAR; PG8_WAIT_L(0); PG8_MMA(0, 0, At, B0); PG8_BAR; PG8_SCHED;
            PG8_LDB(B1, 1, 1); PG8_STAGE(PG8_SB(1, 0), b3, voffB);
            PG8_BAR; PG8_WAIT_L(0); PG8_MMA(0, 1, At, B1); PG8_BAR;
            PG8_LDA(At, 1, 1); PG8_STAGE(PG8_SA(1, 0), a3, voffA);
            PG8_BAR; PG8_WAIT_L(0); PG8_MMA(1, 0, At, B0); PG8_BAR; PG8_SCHED;
            PG8_STAGE(PG8_SB(1, 1), b3 + hstep, voffB);
            PG8_WAIT_V(6); PG8_BAR; PG8_MMA(1, 1, At, B1); PG8_BAR;
            }
        }
        if constexpr (ALIGN_EPI) { if (wr == 0) PG8_BAR; }
        if constexpr (!Epi::AFTER_DRAIN) { E(acc, cur, wr, wc, fr, fq); S.done(cur); }
        if (!has_next) break;
#pragma unroll
        for (int a = 0; a < 2; ++a)
#pragma unroll
            for (int b = 0; b < 2; ++b)
#pragma unroll
                for (int m = 0; m < 4; ++m)
#pragma unroll
                    for (int n = 0; n < 2; ++n) acc[a][b][m][n] = (f32x4){0.f, 0.f, 0.f, 0.f};
        cur = nxt; cA = nA; cB = nB; ++ui;
        if constexpr (ALIGN_EPI) { if (wr == 1) PG8_BAR; }
    }
    PG8_WAIT_V(0);
    if constexpr (!ALIGN_EPI) { if (wr == 0) PG8_BAR; }
    PG8_BAR;
    if constexpr (Epi::AFTER_DRAIN) { E.fused(acc, cur, wr, wc, fr, fq, lds, wid, lane); S.done(cur); }
#undef PG8_SA
#undef PG8_SB
#undef PG8_STAGE
#undef PG8_LDA
#undef PG8_LDB
#undef PG8_MMA
#undef PG8_WAIT_V
#undef PG8_WAIT_L
#undef PG8_BAR
#undef PG8_SCHED
}
}
#ifndef MK_N_LAUNCHES
#define MK_N_LAUNCHES 1
#endif
constexpr int NWAVES = 8, NTHREADS = 512;
constexpr int M = 16384, SEQ = 2048, D = 1024, FF = 2816, NGU = 2 * FF, NIN = 3336, NINP = 3584, PP = 3336, NLORA = 1536, KLORA = 256;
constexpr int NPHASE = 12;
constexpr size_t MiB = 1u << 20;
constexpr size_t WS_PART = 1 * MiB, WS_BONUS = 2 * MiB, WS_GC = 3 * MiB, WS_W1GU = 4 * MiB, WS_W1D = 15 * MiB, WS_WIN = 21 * MiB, WS_WOUT = 36 * MiB, WS_W2D = 38 * MiB, WS_WL = 44 * MiB;
constexpr size_t WS_CS = 4 * MiB;
constexpr size_t WS_CD = 3 * MiB + 512 * 1024;
constexpr size_t WS_XG = 48 * MiB;
constexpr size_t WS_P = 80 * MiB;
constexpr size_t WS_Y = 185 * MiB;
constexpr size_t WS_G = 217 * MiB;
constexpr size_t WS_LIN = 233 * MiB;
constexpr size_t WS_END = 249 * MiB;
constexpr int LDS_BYTES = 147456;

#define LAS __attribute__((address_space(3)))
typedef unsigned short bf16;
typedef unsigned v4u __attribute__((ext_vector_type(4)));
typedef unsigned v2u __attribute__((ext_vector_type(2)));
typedef float f32x4 __attribute__((ext_vector_type(4)));
typedef short bf16x8 __attribute__((ext_vector_type(8)));
#define LDS_WAIT() asm volatile("s_waitcnt lgkmcnt(0)" ::: "memory")
using pg8::cvt_pk_bf16;
__device__ __forceinline__ float bf_lo(unsigned u) { return __builtin_bit_cast(float, u << 16); }
__device__ __forceinline__ float bf_hi(unsigned u) { return __builtin_bit_cast(float, u & 0xffff0000u); }
__device__ __forceinline__ float bf1(bf16 s) { return __builtin_bit_cast(float, (unsigned)s << 16); }
__device__ __forceinline__ bf16 f2bf(float f) { return (bf16)(cvt_pk_bf16(f, 0.f) & 0xffffu); }
__device__ __forceinline__ f32x4 bf4(v2u u) { return (f32x4){bf_lo(u.x), bf_hi(u.x), bf_lo(u.y), bf_hi(u.y)}; }
__device__ __forceinline__ float sigm(float x) { return __builtin_amdgcn_rcpf(1.0f + __expf(-x)); }
__device__ __forceinline__ float wave_sum(float v) {
#pragma unroll
    for (int o = 1; o < 64; o <<= 1) v += __shfl_xor(v, o);
    return v;
}
template <int CTRL> __device__ __forceinline__ float dppf(float x) { return __builtin_bit_cast(float, __builtin_amdgcn_update_dpp(0, __builtin_bit_cast(int, x), CTRL, 0xf, 0xf, true)); }
__device__ __forceinline__ float allred16(float x) { x += dppf<0xB1>(x); x += dppf<0x4E>(x); x += dppf<0x124>(x); x += dppf<0x128>(x); return x; }

struct TrItem { const float* W; bf16* dst; const float* gk; int N, dpitch; };
__device__ __forceinline__ void tr_load(const TrItem& it, f32x4 (&v)[8]) {
#pragma unroll
    for (int i = 0; i < 8; ++i) { v[i] = it.N ? *(const f32x4*)(it.W + (size_t)i * it.N) : (f32x4){0.f, 0.f, 0.f, 0.f}; if (it.gk) v[i] = v[i] * it.gk[i]; }
}
__device__ __forceinline__ void tr_store(const TrItem& it, const f32x4 (&v)[8]) {
#pragma unroll
    for (int j = 0; j < 4; ++j) { v4u o; o.x = cvt_pk_bf16(v[0][j], v[1][j]); o.y = cvt_pk_bf16(v[2][j], v[3][j]); o.z = cvt_pk_bf16(v[4][j], v[5][j]); o.w = cvt_pk_bf16(v[6][j], v[7][j]);
        *(v4u*)(it.dst + (size_t)j * it.dpitch) = o; }
}
__device__ __forceinline__ TrItem tr_make(const float* W, int N, int kb, int nb, bf16* WT, int dpitch, int roff, int dk0, int mode, int up, int lane, const float* gain = nullptr) {
    const int ng = lane & 15, kg = lane >> 4, n = 64 * nb + 4 * ng, k = 32 * kb + 8 * kg;
    TrItem t; t.N = (n < N) ? N : 0; t.W = W + (size_t)k * N + n; t.dpitch = dpitch; t.gk = gain ? gain + k : nullptr;
    const int drow = mode ? (256 * (n >> 7) + 128 * up + (n & 127)) : (n + roff);
    t.dst = WT + (size_t)drow * dpitch + dk0 + k; return t;
}
constexpr int TR_I_GU = 44 * 32, TR_I_DN = 16 * 88, TR_I_IN = 56 * 32, TR_I_OUT = 16 * 32;
constexpr int TR_P0_ITEMS = 4 * TR_I_GU + TR_I_IN + TR_I_OUT + 64;
__device__ __forceinline__ TrItem p0_decode(int r, const float* const* in, unsigned char* ws, int lane) {
    bf16* W1GU = (bf16*)(ws + WS_W1GU); bf16* W1D = (bf16*)(ws + WS_W1D); bf16* WIN = (bf16*)(ws + WS_WIN); bf16* WOUT = (bf16*)(ws + WS_WOUT); bf16* W2D = (bf16*)(ws + WS_W2D); bf16* WL = (bf16*)(ws + WS_WL);
    if (r < 2 * TR_I_GU) { const int up = r >= TR_I_GU; r -= up * TR_I_GU; return tr_make(in[2 + up], FF, r / 44, r % 44, W1GU, D, 0, 0, 1, up, lane); } r -= 2 * TR_I_GU;
    if (r < TR_I_DN) return tr_make(in[4], D, r / 16, r % 16, W1D, FF, 0, 0, 0, 0, lane); r -= TR_I_DN;
    if (r < TR_I_IN) return tr_make(in[6], NIN, r / 56, r % 56, WIN, D, 0, 0, 0, 0, lane, in[5]); r -= TR_I_IN;
    if (r < TR_I_OUT) return tr_make(in[24], D, r / 16, r % 16, WOUT, D, 0, 0, 0, 0, lane); r -= TR_I_OUT;
    if (r < TR_I_DN) return tr_make(in[28], D, r / 16, r % 16, W2D, FF, 0, 0, 0, 0, lane); r -= TR_I_DN;
    if (r < 16) return tr_make(in[9], 512, r / 8, r % 8, WL, KLORA, 0, 0, 0, 0, lane); r -= 16;
    if (r < 16) return tr_make(in[11], 512, r / 8, r % 8, WL, KLORA, 512, 64, 0, 0, lane); r -= 16;
    return tr_make(in[12], 512, r / 8, r % 8, WL, KLORA, 1024, 128, 0, 0, lane);
}
__device__ __forceinline__ void p1_tail_copies(const float* const* in, unsigned char* ws, int tw, int NTW, int tthr, int NTT, int lane) {
    bf16* WL = (bf16*)(ws + WS_WL);
    for (int it = 2 * TR_I_GU + tw; it < TR_P0_ITEMS; it += 2 * NTW) {
        const TrItem a = p0_decode(it, in, ws, lane); const bool hasb = it + NTW < TR_P0_ITEMS; const TrItem b = p0_decode(hasb ? it + NTW : it, in, ws, lane);
        f32x4 va[8], vb[8]; tr_load(a, va); tr_load(b, vb); tr_store(a, va); if (hasb) tr_store(b, vb);
    }
    for (int id = tthr; id < NLORA * 32; id += NTT) { const int row = id >> 5, col = 8 * (id & 31);
        const bool nz = (row < 512) ? (col < 64) : (row < 1024 ? (col >= 64 && col < 128) : (col >= 128));
        if (!nz) *(v4u*)(WL + (size_t)row * KLORA + col) = (v4u){0u, 0u, 0u, 0u}; }
}
__device__ __forceinline__ void p0_prologue(LAS unsigned char* lds, const float* const* in, unsigned char* ws, int vcu, int G, int tid, int wave, int lane) {
    const int gw = vcu * NWAVES + wave, NGW = G * NWAVES;
    bf16* WL = (bf16*)(ws + WS_WL);
    for (int it = gw; it < 2 * TR_I_GU; it += 2 * NGW) {
        const TrItem a = p0_decode(it, in, ws, lane); const bool hasb = it + NGW < 2 * TR_I_GU; const TrItem b = p0_decode(hasb ? it + NGW : it, in, ws, lane);
        f32x4 va[8], vb[8]; tr_load(a, va); tr_load(b, vb); tr_store(a, va); if (hasb) tr_store(b, vb);
    }
    const float* x = in[0]; const float* g1 = in[1]; bf16* XG = (bf16*)(ws + WS_XG);
    f32x4 gv[4];
#pragma unroll
    for (int j = 0; j < 4; ++j) gv[j] = ((const f32x4*)g1)[64 * j + lane];
    for (int m = gw; m < M; m += 2 * NGW) {
        const int m2 = m + NGW;
        const f32x4* xa = (const f32x4*)(x + (size_t)m * D) + lane; const f32x4* xb = (const f32x4*)(x + (size_t)m2 * D) + lane; f32x4 va[4], vb[4]; float sa = 0.f, sb = 0.f;
#pragma unroll
        for (int j = 0; j < 4; ++j) { va[j] = xa[64 * j]; vb[j] = xb[64 * j]; }
#pragma unroll
        for (int j = 0; j < 4; ++j) { sa += (va[j].x * va[j].x + va[j].y * va[j].y) + (va[j].z * va[j].z + va[j].w * va[j].w); sb += (vb[j].x * vb[j].x + vb[j].y * vb[j].y) + (vb[j].z * vb[j].z + vb[j].w * vb[j].w); }
        const float ra = __builtin_amdgcn_rsqf(wave_sum(sa) * (1.f / D) + 1e-6f), rb = __builtin_amdgcn_rsqf(wave_sum(sb) * (1.f / D) + 1e-6f);
        v2u* oa = (v2u*)(XG + (size_t)m * D) + lane; v2u* ob = (v2u*)(XG + (size_t)m2 * D) + lane;
#pragma unroll
        for (int j = 0; j < 4; ++j) { const f32x4 wa = va[j] * ra * gv[j], wb = vb[j] * rb * gv[j]; v2u o; o.x = cvt_pk_bf16(wa.x, wa.y); o.y = cvt_pk_bf16(wa.z, wa.w); oa[64 * j] = o;
            v2u o2; o2.x = cvt_pk_bf16(wb.x, wb.y); o2.y = cvt_pk_bf16(wb.z, wb.w); ob[64 * j] = o2; }
    }
}
__device__ __forceinline__ void p4_lora_in(const bf16* P, const float* mu, bf16* LIN, int gtid, int NT) {
    v4u cur[4], prv[4];
#pragma unroll
    for (int k = 0; k < 4; ++k) { const int idx = gtid + k * NT; const int m = idx >> 5, cgp = idx & 31, t = m & (SEQ - 1);
        const bf16* pc = P + (size_t)m * PP + 1536 + 8 * cgp; cur[k] = *(const v4u*)pc; prv[k] = (v4u){0u, 0u, 0u, 0u}; if (t) prv[k] = *(const v4u*)(pc - PP); }
    const int cgp = gtid & 31;
    const f32x4 m0 = *(const f32x4*)(mu + 1536 + 8 * cgp), m1 = *(const f32x4*)(mu + 1540 + 8 * cgp);
#pragma unroll
    for (int k = 0; k < 4; ++k) { const int idx = gtid + k * NT; const int m = idx >> 5;
        float xv[8];
#pragma unroll
        for (int e = 0; e < 4; ++e) { const unsigned cu = cur[k][e], pu = prv[k][e]; const float c0 = bf_lo(cu), c1 = bf_hi(cu), p0 = bf_lo(pu), p1 = bf_hi(pu);
            const float mA = (e < 2) ? m0[2 * e] : m1[2 * e - 4], mB = (e < 2) ? m0[2 * e + 1] : m1[2 * e - 3];
            xv[2 * e] = c0 + (p0 - c0) * mA; xv[2 * e + 1] = c1 + (p1 - c1) * mB; }
        if (cgp < 8) {
#pragma unroll
            for (int e = 0; e < 8; ++e) xv[e] = 2.f * sigm(2.f * xv[e]) - 1.f;
        } else if (cgp >= 16) {
#pragma unroll
            for (int e = 0; e < 8; ++e) xv[e] = sigm(xv[e]);
        }
        v4u o; o.x = cvt_pk_bf16(xv[0], xv[1]); o.y = cvt_pk_bf16(xv[2], xv[3]); o.z = cvt_pk_bf16(xv[4], xv[5]); o.w = cvt_pk_bf16(xv[6], xv[7]);
        *(v4u*)(LIN + (size_t)m * KLORA + 8 * cgp) = o;
    }
}
__device__ __forceinline__ int perm_pos(int s) { return (s & 32) + (((s & 15) >> 2) << 3) + (((s >> 4) & 1) << 2) + (s & 3); }
__device__ __forceinline__ bf16x8 pack8(const f32x4 a, const f32x4 b) { v4u u; u.x = cvt_pk_bf16(a[0], a[1]); u.y = cvt_pk_bf16(a[2], a[3]); u.z = cvt_pk_bf16(b[0], b[1]); u.w = cvt_pk_bf16(b[2], b[3]); return __builtin_bit_cast(bf16x8, u); }
#define MFMA16(a, b, c) __builtin_amdgcn_mfma_f32_16x16x32_bf16((a), (b), (c), 0, 0, 0)
constexpr int RW_PITCH = 72;
struct RwIn { v4u cr, ck, cv, qr, qk, qv, ce, ca; };
__device__ __forceinline__ void rwkv_chunk_load(RwIn& I, int unit, const bf16* P, const bf16* EA, int tid) {
    const int h = unit & 7, c = (unit >> 3) & 31, b = unit >> 8; const size_t m0 = (size_t)b * SEQ + 64 * c;
    const int t = tid >> 3, jg = tid & 7, ch = 64 * h + 8 * jg;
    const bf16* pc = P + (m0 + t) * PP + ch;
    I.cr = *(const v4u*)pc; I.ck = *(const v4u*)(pc + 512); I.cv = *(const v4u*)(pc + 1024);
    I.ce = *(const v4u*)(EA + (m0 + t) * 1024 + ch); I.ca = *(const v4u*)(EA + (m0 + t) * 1024 + 512 + ch);
}
__device__ __forceinline__ void rwkv_chunk_load_prev(RwIn& I, int unit, const bf16* P, int tid) {
    const int h = unit & 7, c = (unit >> 3) & 31, b = unit >> 8; const size_t m0 = (size_t)b * SEQ + 64 * c;
    const int t = tid >> 3, jg = tid & 7, ch = 64 * h + 8 * jg;
    const bf16* pc = P + (m0 + t) * PP + ch;
    I.qr = (v4u){0u, 0u, 0u, 0u}; I.qk = I.qr; I.qv = I.qr;
    if (64 * c + t > 0) { I.qr = *(const v4u*)(pc - PP); I.qk = *(const v4u*)(pc - PP + 512); I.qv = *(const v4u*)(pc - PP + 1024); }
}
__device__ __forceinline__ void rwkv_chunk_unit(LAS unsigned char* lds, int unit, RwIn& I, int next_unit, const bf16* P, bf16* EA, bf16* Y, float* BON, float* GCg, unsigned* SLg,
                                                int tid, int wave, int lane, bool st = true, int stop = 0) {
    const int h = unit & 7, c = (unit >> 3) & 31, b = unit >> 8;
    const size_t m0 = (size_t)b * SEQ + 64 * c;
    LAS bf16* At = (LAS bf16*)(lds); LAS bf16* Rt = (LAS bf16*)(lds + 9216); LAS bf16* Bm = (LAS bf16*)(lds + 18432); LAS bf16* Km = (LAS bf16*)(lds + 27648);
    LAS bf16* BmT = (LAS bf16*)(lds + 36864); LAS bf16* KmT = (LAS bf16*)(lds + 46080); LAS bf16* VT = (LAS bf16*)(lds + 55296);
    LAS bf16* AabT = (LAS bf16*)(lds + 64512); LAS bf16* AkbT = (LAS bf16*)(lds + 73728); LAS bf16* AbrT = (LAS bf16*)(lds + 82944); LAS bf16* AkrT = (LAS bf16*)(lds + 92160);
    LAS float* AD = (LAS float*)(lds + 101376); LAS bf16* TdA = (LAS bf16*)(lds + 105472); LAS float* GC = (LAS float*)(lds + 109568); LAS float* WT = (LAS float*)(lds + 109824);
    const LAS float* PRM = (const LAS float*)(lds + 140032);
    const int r = lane & 15, q = lane >> 4;
    {
        const int t = tid >> 3, jg = tid & 7;
        rwkv_chunk_load_prev(I, unit, P, tid);
        const v4u cr = I.cr, ck = I.ck, cv = I.cv, qr = I.qr, qk = I.qk, qv = I.qv, ce = I.ce, ca = I.ca;
        float rr[8], kx[8], vv[8], ee[8], aa[8], kk[8], km[8], bv[8], E[8];
        float ss = 0.f, bon = 0.f;
#pragma unroll
        for (int x = 0; x < 8; ++x) {
            const unsigned ur = cr[x >> 1], uk = ck[x >> 1], uv = cv[x >> 1], pr = qr[x >> 1], pk = qk[x >> 1], pv = qv[x >> 1], ue = ce[x >> 1], ua = ca[x >> 1];
            const float r0 = (x & 1) ? bf_hi(ur) : bf_lo(ur), k0 = (x & 1) ? bf_hi(uk) : bf_lo(uk), v0 = (x & 1) ? bf_hi(uv) : bf_lo(uv);
            const float r1 = (x & 1) ? bf_hi(pr) : bf_lo(pr), k1 = (x & 1) ? bf_hi(pk) : bf_lo(pk), v1 = (x & 1) ? bf_hi(pv) : bf_lo(pv);
            const LAS float* pj = PRM + 8 * jg + x;
            const float ep = ((x & 1) ? bf_hi(ue) : bf_lo(ue)) + pj[384], ap = ((x & 1) ? bf_hi(ua) : bf_lo(ua)) + pj[448];
            rr[x] = r0 + (r1 - r0) * pj[0]; kx[x] = k0 + (k1 - k0) * pj[64]; vv[x] = v0 + (v1 - v0) * pj[128];
            ee[x] = 0.60653066f * sigm(ep); aa[x] = sigm(ap);
            kk[x] = kx[x] * pj[192]; ss += kk[x] * kk[x];
            km[x] = kx[x] * (1.0f + (aa[x] - 1.0f) * pj[256]);
            bon += rr[x] * km[x] * pj[320];
            E[x] = ee[x];
        }
        ss += __shfl_xor(ss, 1); ss += __shfl_xor(ss, 2); ss += __shfl_xor(ss, 4);
        bon += __shfl_xor(bon, 1); bon += __shfl_xor(bon, 2); bon += __shfl_xor(bon, 4);
        if (jg == 0 && st) BON[(m0 + t) * 8 + h] = bon;
        const float inv = 1.0f / fmaxf(sqrtf(ss), 1e-12f);
#pragma unroll
        for (int x = 0; x < 8; ++x) { kk[x] *= inv; bv[x] = kk[x] * aa[x]; }
#pragma unroll
        for (int off = 8; off < 64; off <<= 1)
#pragma unroll
            for (int x = 0; x < 8; ++x) { const float tv = __shfl_up(E[x], off); if (lane >= off) E[x] += tv; }
        if ((lane >> 3) == 7) {
#pragma unroll
            for (int x = 0; x < 8; ++x) WT[wave * 64 + 8 * jg + x] = E[x];
        }
        __syncthreads();
        for (int w2 = 0; w2 < wave; ++w2)
#pragma unroll
            for (int x = 0; x < 8; ++x) E[x] += WT[w2 * 64 + 8 * jg + x];
        float av[8], rv[8], bt[8], kt[8];
#pragma unroll
        for (int x = 0; x < 8; ++x) { const float gi = __expf(-E[x]), ge = __expf(-(E[x] - ee[x])), gp = __expf(E[x]);
            av[x] = -kk[x] * ge; rv[x] = rr[x] * gi; bt[x] = bv[x] * gp; kt[x] = km[x] * gp;
            if (t == 63) { GC[8 * jg + x] = gi; if (st) GCg[(size_t)unit * 64 + 8 * jg + x] = gi; } }
#define PK8(a_) (v4u){cvt_pk_bf16(a_[0], a_[1]), cvt_pk_bf16(a_[2], a_[3]), cvt_pk_bf16(a_[4], a_[5]), cvt_pk_bf16(a_[6], a_[7])}
        *(LAS v4u*)(At + t * RW_PITCH + 8 * jg) = PK8(av); *(LAS v4u*)(Rt + t * RW_PITCH + 8 * jg) = PK8(rv);
        *(LAS v4u*)(Bm + t * RW_PITCH + 8 * jg) = PK8(bt); *(LAS v4u*)(Km + t * RW_PITCH + 8 * jg) = PK8(kt);
#undef PK8
#pragma unroll
        for (int x = 0; x < 8; ++x) { BmT[(8 * jg + x) * RW_PITCH + perm_pos(t)] = f2bf(bt[x]); KmT[(8 * jg + x) * RW_PITCH + t] = f2bf(kt[x]); VT[(8 * jg + x) * RW_PITCH + t] = f2bf(vv[x]); }
    }
    if (next_unit >= 0) rwkv_chunk_load(I, next_unit, P, EA, tid);
    __syncthreads();
    if (stop == 1) return;
    {
        const int mat = wave >> 1; const LAS bf16* Atile = mat < 2 ? At : Rt; const LAS bf16* Btile = (mat & 1) ? Km : Bm;
        LAS bf16* dst = mat == 0 ? AabT : (mat == 1 ? AkbT : (mat == 2 ? AbrT : AkrT));
        const bool strict = mat < 2, perm = (mat & 1) == 0;
#pragma unroll
        for (int tbi = 0; tbi < 2; ++tbi) { const int tb = 2 * (wave & 1) + tbi;
            const bf16x8 a0 = *(const LAS bf16x8*)(Atile + (16 * tb + r) * RW_PITCH + 8 * q), a1 = *(const LAS bf16x8*)(Atile + (16 * tb + r) * RW_PITCH + 32 + 8 * q);
#pragma unroll
            for (int sb = 0; sb < 4; ++sb) {
                f32x4 acc = (f32x4){0.f, 0.f, 0.f, 0.f};
                if (sb <= tb) { acc = MFMA16(a0, *(const LAS bf16x8*)(Btile + (16 * sb + r) * RW_PITCH + 8 * q), acc); acc = MFMA16(a1, *(const LAS bf16x8*)(Btile + (16 * sb + r) * RW_PITCH + 32 + 8 * q), acc); }
                const int sx = 16 * sb + r, pos = perm ? perm_pos(sx) : sx;
#pragma unroll
                for (int jj = 0; jj < 4; ++jj) { const int tx = 16 * tb + 4 * q + jj; const bool keep = (sb <= tb) && (strict ? sx < tx : sx <= tx); const float v = keep ? acc[jj] : 0.f;
                    dst[tx * RW_PITCH + pos] = f2bf(v);
                    if (mat == 0 && sb == tb) AD[tb * 256 + (4 * q + jj) * 16 + r] = v; }
            }
        }
    }
    __syncthreads();
    if (stop == 2) return;
    if (wave < 4) {
        const LAS float* ad = AD + wave * 256; float X[16];
#pragma unroll
        for (int sx = 15; sx >= 0; --sx) { float x = (sx == r) ? 1.f : 0.f;
#pragma unroll
            for (int k = sx + 1; k < 16; ++k) x += ad[k * 16 + sx] * X[k];
            X[sx] = x; }
        LAS bf16* td = TdA + wave * 512 + r * 32;
        if (q == 0) {
#pragma unroll
            for (int kg = 0; kg < 4; ++kg) { v4u o; o.x = cvt_pk_bf16(X[4 * kg], X[4 * kg + 1]); o.y = cvt_pk_bf16(X[4 * kg + 2], X[4 * kg + 3]); o.z = 0u; o.w = 0u; *(LAS v4u*)(td + 8 * kg) = o; }
        }
    }
    f32x4 z[4], qy[4], gs[4];
    const bool vpart = wave >= 4; const int cb = wave & 3;
    if (vpart) {
        const bf16x8 v0 = *(const LAS bf16x8*)(VT + (16 * cb + r) * RW_PITCH + 8 * q), v1 = *(const LAS bf16x8*)(VT + (16 * cb + r) * RW_PITCH + 32 + 8 * q);
#pragma unroll
        for (int tb = 0; tb < 4; ++tb) { const int ro = (16 * tb + r) * RW_PITCH + 8 * q;
            f32x4 acc = (f32x4){0.f, 0.f, 0.f, 0.f}; acc = MFMA16(*(const LAS bf16x8*)(AkbT + ro), v0, acc); acc = MFMA16(*(const LAS bf16x8*)(AkbT + ro + 32), v1, acc); z[tb] = acc;
            acc = (f32x4){0.f, 0.f, 0.f, 0.f}; acc = MFMA16(*(const LAS bf16x8*)(AkrT + ro), v0, acc); acc = MFMA16(*(const LAS bf16x8*)(AkrT + ro + 32), v1, acc); qy[tb] = acc;
            acc = (f32x4){0.f, 0.f, 0.f, 0.f}; acc = MFMA16(*(const LAS bf16x8*)(KmT + ro), v0, acc); acc = MFMA16(*(const LAS bf16x8*)(KmT + ro + 32), v1, acc); gs[tb] = acc; }
    } else {
#pragma unroll
        for (int tb = 0; tb < 4; ++tb)
#pragma unroll
            for (int jj = 0; jj < 4; ++jj) { const int tx = 16 * tb + 4 * q + jj; z[tb][jj] = bf1(At[tx * RW_PITCH + 16 * cb + r]); qy[tb][jj] = bf1(Rt[tx * RW_PITCH + 16 * cb + r]); gs[tb][jj] = 0.f; }
    }
    __syncthreads();
    if (stop == 3) return;
    const f32x4 zero4 = (f32x4){0.f, 0.f, 0.f, 0.f};
#pragma unroll
    for (int tb = 0; tb < 4; ++tb) {
        f32x4 rhs = z[tb];
        if (tb >= 1) rhs = MFMA16(*(const LAS bf16x8*)(AabT + (16 * tb + r) * RW_PITCH + 8 * q), pack8(z[0], tb >= 2 ? z[1] : zero4), rhs);
        if (tb >= 3) rhs = MFMA16(*(const LAS bf16x8*)(AabT + (16 * tb + r) * RW_PITCH + 32 + 8 * q), pack8(z[2], zero4), rhs);
        z[tb] = MFMA16(*(const LAS bf16x8*)(TdA + tb * 512 + r * 32 + 8 * q), pack8(rhs, zero4), zero4);
    }
    const bf16x8 zb0 = pack8(z[0], z[1]), zb1 = pack8(z[2], z[3]);
#pragma unroll
    for (int tb = 0; tb < 4; ++tb) { const int ro = (16 * tb + r) * RW_PITCH + 8 * q;
        qy[tb] = MFMA16(*(const LAS bf16x8*)(AbrT + ro), zb0, qy[tb]); qy[tb] = MFMA16(*(const LAS bf16x8*)(AbrT + ro + 32), zb1, qy[tb]);
        gs[tb] = MFMA16(*(const LAS bf16x8*)(BmT + ro), zb0, gs[tb]); gs[tb] = MFMA16(*(const LAS bf16x8*)(BmT + ro + 32), zb1, gs[tb]);
#pragma unroll
        for (int jj = 0; jj < 4; ++jj) gs[tb][jj] *= GC[16 * tb + 4 * q + jj]; }
    LAS bf16* QTs = At; LAS bf16* GTs = Rt; LAS bf16* YLs = Bm;
    if (vpart) {
#pragma unroll
        for (int tb = 0; tb < 4; ++tb) {
#pragma unroll
            for (int jj = 0; jj < 4; ++jj) YLs[(16 * tb + 4 * q + jj) * RW_PITCH + 16 * cb + r] = f2bf(qy[tb][jj]);
            v2u o; o.x = cvt_pk_bf16(gs[tb][0], gs[tb][1]); o.y = cvt_pk_bf16(gs[tb][2], gs[tb][3]);
            if (st) *(v2u*)(SLg + ((((size_t)unit * 4 + cb) * 4 + tb) * 64 + lane) * 2) = o; }
    } else {
        const int pj = perm_pos(16 * cb + r);
#pragma unroll
        for (int tb = 0; tb < 4; ++tb)
#pragma unroll
            for (int jj = 0; jj < 4; ++jj) { const int rw = (16 * tb + 4 * q + jj) * RW_PITCH + pj; QTs[rw] = f2bf(qy[tb][jj]); GTs[rw] = f2bf(gs[tb][jj]); }
    }
    __syncthreads();
    if (st) { const int row = tid >> 3, sg = 8 * (tid & 7); const size_t ro = (m0 + row) * 1024 + 64 * h + sg;
        *(v4u*)(EA + ro + 512) = *(const LAS v4u*)(QTs + row * RW_PITCH + sg); *(v4u*)(EA + ro) = *(const LAS v4u*)(GTs + row * RW_PITCH + sg); *(v4u*)(Y + ro) = *(const LAS v4u*)(YLs + row * RW_PITCH + sg); }
    __syncthreads();
}
struct SeqS { bf16x8 ga[2][2]; v2u sl[2]; f32x4 gc[2]; };
struct SeqY { bf16x8 qa[2][2]; bf16 yl[2][4]; };
#define SEQS_LOAD(S_, c_, HF_) do { const int cc_ = (c_) < 32 ? (c_) : 31; const int unit_ = (b * 32 + cc_) * 8 + h; const size_t mm_ = (size_t)b * SEQ + 64 * cc_; \
    _Pragma("unroll") for (int t2 = 0; t2 < 2; ++t2) { const int tb = 2 * (HF_) + t2; \
        const bf16* grow_ = EA + (mm_ + 16 * tb + r) * 1024 + 64 * h + 8 * q; S_.ga[t2][0] = *(const bf16x8*)grow_; S_.ga[t2][1] = *(const bf16x8*)(grow_ + 32); \
        S_.sl[t2] = *(const v2u*)(SLg + ((((size_t)unit_ * 4 + ib) * 4 + tb) * 64 + lane) * 2); \
        S_.gc[t2] = *(const f32x4*)(GCg + (size_t)unit_ * 64 + 16 * tb + 4 * q); } } while (0)
#define SEQS_COMP(S_, HF_) do { \
    _Pragma("unroll") for (int t2 = 0; t2 < 2; ++t2) { const int tb = 2 * (HF_) + t2; \
        f32x4 sv = bf4(S_.sl[t2]) + S_.gc[t2] * sT[tb]; \
        sv = MFMA16(S_.ga[t2][0], bh0, sv); sv = MFMA16(S_.ga[t2][1], bh1, sv); sv = MFMA16(S_.ga[t2][0], bl0, sv); sv = MFMA16(S_.ga[t2][1], bl1, sv); \
        sT[tb] = sv; } } while (0)
#define SEQS_SPLIT(c_) do { f32x4 hi[4], lo[4]; \
    _Pragma("unroll") for (int jb = 0; jb < 4; ++jb) _Pragma("unroll") for (int jj = 0; jj < 4; ++jj) { const float hv = bf1(f2bf(sT[jb][jj])); hi[jb][jj] = hv; lo[jb][jj] = sT[jb][jj] - hv; } \
    bh0 = pack8(hi[0], hi[1]); bh1 = pack8(hi[2], hi[3]); bl0 = pack8(lo[0], lo[1]); bl1 = pack8(lo[2], lo[3]); \
    LAS bf16x8* slot_ = (LAS bf16x8*)(lds + (c_) * 4096) + lane; slot_[0] = bh0; slot_[64] = bh1; slot_[128] = bl0; slot_[192] = bl1; \
    asm volatile("s_waitcnt lgkmcnt(0)" ::: "memory"); *prog = (unsigned)(c_) + 1u; } while (0)
#define SEQY_LOAD(S_, c_, HF_) do { const int cc_ = (c_) < 32 ? (c_) : 31; const size_t mm_ = (size_t)b * SEQ + 64 * cc_; \
    _Pragma("unroll") for (int t2 = 0; t2 < 2; ++t2) { const int tb = 2 * (HF_) + t2; \
        const bf16* qrow_ = EA + (mm_ + 16 * tb + r) * 1024 + 512 + 64 * h + 8 * q; S_.qa[t2][0] = *(const bf16x8*)qrow_; S_.qa[t2][1] = *(const bf16x8*)(qrow_ + 32); \
        _Pragma("unroll") for (int jj = 0; jj < 4; ++jj) S_.yl[t2][jj] = Y[(mm_ + 16 * tb + 4 * q + jj) * 1024 + 64 * h + 16 * ib + r]; } } while (0)
#define SEQY_WAIT(c_) do { unsigned sp_ = 0; while (*prog < (unsigned)(c_) + 1u) { __builtin_amdgcn_s_sleep(1); if (++sp_ > (1u << 24)) break; } \
    asm volatile("" ::: "memory"); \
    const LAS bf16x8* slot_ = (const LAS bf16x8*)(lds + (c_) * 4096) + lane; bh0 = slot_[0]; bh1 = slot_[64]; bl0 = slot_[128]; bl1 = slot_[192]; } while (0)
#define SEQY_COMP(S_, c_, HF_) do { const size_t m0 = (size_t)b * SEQ + 64 * (c_); \
    _Pragma("unroll") for (int t2 = 0; t2 < 2; ++t2) { const int tb = 2 * (HF_) + t2; \
        f32x4 y; _Pragma("unroll") for (int jj = 0; jj < 4; ++jj) y[jj] = bf1(S_.yl[t2][jj]); \
        y = MFMA16(S_.qa[t2][0], bh0, y); y = MFMA16(S_.qa[t2][1], bh1, y); y = MFMA16(S_.qa[t2][0], bl0, y); y = MFMA16(S_.qa[t2][1], bl1, y); \
        if (st) { _Pragma("unroll") for (int jj = 0; jj < 4; ++jj) Y[(m0 + 16 * tb + 4 * q + jj) * 1024 + 64 * h + 16 * ib + r] = f2bf(y[jj]); } } } while (0)
__device__ __forceinline__ void rwkv_seq_state(LAS unsigned char* lds, volatile LAS unsigned* prog, int job, const bf16* EA, const float* GCg, const unsigned* SLg, int lane) {
    const int ib = job & 3, h = (job >> 2) & 7, b = job >> 5; const int r = lane & 15, q = lane >> 4;
    f32x4 sT[4];
#pragma unroll
    for (int jb = 0; jb < 4; ++jb) sT[jb] = (f32x4){0.f, 0.f, 0.f, 0.f};
    bf16x8 bh0, bh1, bl0, bl1;
    SeqS B0, B1, B2, B3;
    SEQS_LOAD(B0, 0, 0); SEQS_LOAD(B1, 0, 1); SEQS_LOAD(B2, 1, 0);
    for (int c = 0; c < 32; c += 2) {
        SEQS_LOAD(B3, c + 1, 1); SEQS_SPLIT(c); SEQS_COMP(B0, 0);
        SEQS_LOAD(B0, c + 2, 0); SEQS_COMP(B1, 1);
        SEQS_LOAD(B1, c + 2, 1); SEQS_SPLIT(c + 1); SEQS_COMP(B2, 0);
        SEQS_LOAD(B2, c + 3, 0); SEQS_COMP(B3, 1);
    }
}
__device__ __forceinline__ void rwkv_seq_out(LAS unsigned char* lds, volatile LAS unsigned* prog, int job, const bf16* EA, bf16* Y, int lane, bool st) {
    const int ib = job & 3, h = (job >> 2) & 7, b = job >> 5; const int r = lane & 15, q = lane >> 4;
    bf16x8 bh0, bh1, bl0, bl1;
    SeqY B0, B1, B2, B3;
    SEQY_LOAD(B0, 0, 0); SEQY_LOAD(B1, 0, 1); SEQY_LOAD(B2, 1, 0);
    for (int c = 0; c < 32; c += 2) {
        SEQY_LOAD(B3, c + 1, 1); SEQY_WAIT(c); SEQY_COMP(B0, c, 0);
        SEQY_LOAD(B0, c + 2, 0); SEQY_COMP(B1, c, 1);
        SEQY_LOAD(B1, c + 2, 1); SEQY_WAIT(c + 1); SEQY_COMP(B2, c + 1, 0);
        SEQY_LOAD(B2, c + 3, 0); SEQY_COMP(B3, c + 1, 1);
    }
}
#undef SEQS_LOAD
#undef SEQS_COMP
#undef SEQS_SPLIT
#undef SEQY_LOAD
#undef SEQY_WAIT
#undef SEQY_COMP
__device__ __forceinline__ void ssd_chunk_group(LAS unsigned char* lds, int unit, const bf16* P, bf16* Y, bf16* CS, float* CD, const float* dt_bias, const float* a_log, const float* d_skip, int tid, int wave, int lane) {
    const int g = unit & 1, c = (unit >> 1) & 31, b = unit >> 6;
    LAS bf16* Cn = (LAS bf16*)(lds); LAS bf16* Bn = (LAS bf16*)(lds + 17408); LAS bf16* BT = (LAS bf16*)(lds + 34816); LAS bf16* RAWX = (LAS bf16*)(lds + 53248);
    LAS unsigned char* U = lds + 88640;
    LAS bf16* RAWBC = (LAS bf16*)U; LAS bf16* XT = (LAS bf16*)U; LAS bf16* XdT = (LAS bf16*)(U + 9216); LAS bf16* Xr = (LAS bf16*)(U + 18432); LAS bf16* Ms = (LAS bf16*)(U + 26624);
    LAS float* ACS4 = (LAS float*)(lds + 124480); const LAS float* CW = (const LAS float*)(lds + 133632);
    const int r = lane & 15, q = lane >> 4;
    const size_t m0 = (size_t)b * SEQ + 64 * c;
    {
        const int chb = lane < 16 ? 2816 + 128 * g + 8 * lane : (lane < 32 ? 3072 + 128 * g + 8 * (lane - 16) : 2304 + 256 * g + 8 * (lane - 32));
        const bf16* pbase = P + m0 * PP + chb;
        v4u rv[9];
#pragma unroll
        for (int i = 0; i < 9; ++i) { const int rr = wave + 8 * i; rv[i] = (v4u){0u, 0u, 0u, 0u}; if (rr < 67 && 64 * c + rr - 3 >= 0) rv[i] = *(const v4u*)(pbase + (ptrdiff_t)(rr - 3) * PP); }
        LAS bf16* dstb = lane < 32 ? RAWBC + 8 * lane : RAWX + 8 * (lane - 32);
#pragma unroll
        for (int i = 0; i < 9; ++i) { const int rr = wave + 8 * i; if (rr < 67) *(LAS v4u*)(dstb + rr * 264) = rv[i]; }
    }
    float dt[4], dd[4], aend[4];
#pragma unroll
    for (int hh = 0; hh < 4; ++hh) { const int h = 4 * g + hh;
        const float xdt = bf1(P[(m0 + lane) * PP + 3328 + h]) + dt_bias[h]; dt[hh] = xdt > 20.f ? xdt : log1pf(__expf(xdt));
        float acs = dt[hh] * (-__expf(a_log[h]));
#pragma unroll
        for (int o = 1; o < 64; o <<= 1) { const float t = __shfl_up(acs, o); if (lane >= o) acs += t; }
        aend[hh] = __shfl(acs, 63);
        if (wave == 0) ACS4[hh * 64 + lane] = acs;
        dd[hh] = dt[hh] * __expf(aend[hh] - acs); }
    __syncthreads();
#pragma unroll
    for (int i = 0; i < 4; ++i) { const int cgp = wave + 8 * i;
        const LAS float* cwl = CW + cgp * 40;
        float o8[8];
        { const f32x4 b0 = *(const LAS f32x4*)(cwl + 32), b1 = *(const LAS f32x4*)(cwl + 36);
#pragma unroll
          for (int e = 0; e < 4; ++e) { o8[e] = b0[e]; o8[4 + e] = b1[e]; } }
#pragma unroll
        for (int k = 0; k < 4; ++k) { const v4u iv = *(const LAS v4u*)(RAWBC + (lane + k) * 264 + 8 * cgp);
            const f32x4 w0v = *(const LAS f32x4*)(cwl + 8 * k), w1v = *(const LAS f32x4*)(cwl + 8 * k + 4);
            o8[0] += w0v[0] * bf_lo(iv[0]); o8[1] += w0v[1] * bf_hi(iv[0]); o8[2] += w0v[2] * bf_lo(iv[1]); o8[3] += w0v[3] * bf_hi(iv[1]);
            o8[4] += w1v[0] * bf_lo(iv[2]); o8[5] += w1v[1] * bf_hi(iv[2]); o8[6] += w1v[2] * bf_lo(iv[3]); o8[7] += w1v[3] * bf_hi(iv[3]); }
#pragma unroll
        for (int e = 0; e < 8; ++e) o8[e] = o8[e] * sigm(o8[e]);
        v4u o; o.x = cvt_pk_bf16(o8[0], o8[1]); o.y = cvt_pk_bf16(o8[2], o8[3]); o.z = cvt_pk_bf16(o8[4], o8[5]); o.w = cvt_pk_bf16(o8[6], o8[7]);
        if (cgp < 16) { const int n = 8 * cgp; *(LAS v4u*)(Bn + lane * 136 + n) = o;
#pragma unroll
            for (int e = 0; e < 8; ++e) BT[(n + e) * 72 + lane] = f2bf(o8[e]);
        } else { const int n = 8 * (cgp - 16); *(LAS v4u*)(Cn + lane * 136 + n) = o; }
    }
    __syncthreads();
    f32x4 sc[2];
    {
        const int lb = wave >> 1;
#pragma unroll
        for (int sbi = 0; sbi < 2; ++sbi) { const int sb = 2 * (wave & 1) + sbi; sc[sbi] = (f32x4){0.f, 0.f, 0.f, 0.f};
            if (sb <= lb) {
#pragma unroll
                for (int kk = 0; kk < 4; ++kk) sc[sbi] = MFMA16(*(const LAS bf16x8*)(Cn + (16 * lb + r) * 136 + 32 * kk + 8 * q), *(const LAS bf16x8*)(Bn + (16 * sb + r) * 136 + 32 * kk + 8 * q), sc[sbi]);
            } }
    }
#pragma unroll
    for (int hh = 0; hh < 4; ++hh) { const int h = 4 * g + hh; const int unit_h = (b * 32 + c) * 8 + h;
        {
            const int cgx = 8 * hh + wave; const LAS float* cwl = CW + (32 + cgx) * 40;
            float o8[8];
            { const f32x4 b0 = *(const LAS f32x4*)(cwl + 32), b1 = *(const LAS f32x4*)(cwl + 36);
#pragma unroll
              for (int e = 0; e < 4; ++e) { o8[e] = b0[e]; o8[4 + e] = b1[e]; } }
#pragma unroll
            for (int k = 0; k < 4; ++k) { const v4u iv = *(const LAS v4u*)(RAWX + (lane + k) * 264 + 8 * cgx);
                const f32x4 w0v = *(const LAS f32x4*)(cwl + 8 * k), w1v = *(const LAS f32x4*)(cwl + 8 * k + 4);
                o8[0] += w0v[0] * bf_lo(iv[0]); o8[1] += w0v[1] * bf_hi(iv[0]); o8[2] += w0v[2] * bf_lo(iv[1]); o8[3] += w0v[3] * bf_hi(iv[1]);
                o8[4] += w1v[0] * bf_lo(iv[2]); o8[5] += w1v[1] * bf_hi(iv[2]); o8[6] += w1v[2] * bf_lo(iv[3]); o8[7] += w1v[3] * bf_hi(iv[3]); }
#pragma unroll
            for (int e = 0; e < 8; ++e) o8[e] = o8[e] * sigm(o8[e]);
            v4u o; o.x = cvt_pk_bf16(o8[0], o8[1]); o.y = cvt_pk_bf16(o8[2], o8[3]); o.z = cvt_pk_bf16(o8[4], o8[5]); o.w = cvt_pk_bf16(o8[6], o8[7]);
#pragma unroll
            for (int e = 0; e < 8; ++e) { XT[(8 * wave + e) * 72 + lane] = f2bf(o8[e] * dt[hh]); XdT[(8 * wave + e) * 72 + lane] = f2bf(o8[e] * dd[hh]); }
            *(LAS v4u*)(Xr + lane * 64 + 8 * wave) = o;
        }
        {
            const int lb = wave >> 1; const LAS float* acsh = ACS4 + hh * 64;
#pragma unroll
            for (int sbi = 0; sbi < 2; ++sbi) { const int sb = 2 * (wave & 1) + sbi; const int sx = 16 * sb + r; const float as = acsh[sx];
#pragma unroll
                for (int j = 0; j < 4; ++j) { const int l = 16 * lb + 4 * q + j; const float v = (l >= sx && sb <= lb) ? sc[sbi][j] * __expf(acsh[l] - as) : 0.f; Ms[l * 72 + sx] = f2bf(v); } }
        }
        __syncthreads();
        {
            const int lb = wave >> 1, l = 16 * lb + r; const float dsk = d_skip[h];
            const bf16x8 m0v = *(const LAS bf16x8*)(Ms + l * 72 + 8 * q), m1v = *(const LAS bf16x8*)(Ms + l * 72 + 32 + 8 * q);
#pragma unroll
            for (int pbi = 0; pbi < 2; ++pbi) { const int pb = 2 * (wave & 1) + pbi;
                f32x4 acc = (f32x4){0.f, 0.f, 0.f, 0.f};
                acc = MFMA16(*(const LAS bf16x8*)(XT + (16 * pb + r) * 72 + 8 * q), m0v, acc); acc = MFMA16(*(const LAS bf16x8*)(XT + (16 * pb + r) * 72 + 32 + 8 * q), m1v, acc);
                const int p0 = 16 * pb + 4 * q; const f32x4 xv = bf4(*(const LAS v2u*)(Xr + l * 64 + p0));
                v2u o; o.x = cvt_pk_bf16(acc[0] + dsk * xv[0], acc[1] + dsk * xv[1]); o.y = cvt_pk_bf16(acc[2] + dsk * xv[2], acc[3] + dsk * xv[3]);
                *(v2u*)(Y + (m0 + l) * 1024 + 512 + 64 * h + p0) = o;
            }
            const int pb = wave & 3;
            const bf16x8 x0 = *(const LAS bf16x8*)(XdT + (16 * pb + r) * 72 + 8 * q), x1 = *(const LAS bf16x8*)(XdT + (16 * pb + r) * 72 + 32 + 8 * q);
            bf16* cs = CS + (size_t)unit_h * 8192 + (16 * pb + r) * 128;
#pragma unroll
            for (int i = 0; i < 4; ++i) { const int nb = 4 * (wave >> 2) + i;
                f32x4 acc = (f32x4){0.f, 0.f, 0.f, 0.f};
                acc = MFMA16(*(const LAS bf16x8*)(BT + (16 * nb + r) * 72 + 8 * q), x0, acc); acc = MFMA16(*(const LAS bf16x8*)(BT + (16 * nb + r) * 72 + 32 + 8 * q), x1, acc);
                v2u o; o.x = cvt_pk_bf16(acc[0], acc[1]); o.y = cvt_pk_bf16(acc[2], acc[3]);
                *(v2u*)(cs + 16 * nb + 4 * q) = o;
            }
            if (tid == 0) CD[unit_h] = __expf(aend[hh]);
        }
        __syncthreads();
    }
}
__device__ __forceinline__ void ssd_scan_item(int item, bf16* CS, const float* CD, bool dost) {
    const int bh = item >> 10, e8 = (item & 1023) * 8, b = bh >> 3, h = bh & 7;
    float st[8];
#pragma unroll
    for (int e = 0; e < 8; ++e) st[e] = 0.f;
    for (int cb = 0; cb < 2; ++cb) {
        v4u v[16]; float d[16];
#pragma unroll
        for (int k = 0; k < 16; ++k) { const int unit = (b * 32 + 16 * cb + k) * 8 + h; v[k] = *(const v4u*)(CS + (size_t)unit * 8192 + e8); d[k] = CD[unit]; }
#pragma unroll
        for (int k = 0; k < 16; ++k) { const int unit = (b * 32 + 16 * cb + k) * 8 + h;
            v4u o; o.x = cvt_pk_bf16(st[0], st[1]); o.y = cvt_pk_bf16(st[2], st[3]); o.z = cvt_pk_bf16(st[4], st[5]); o.w = cvt_pk_bf16(st[6], st[7]);
            if (dost) *(v4u*)(CS + (size_t)unit * 8192 + e8) = o;
#pragma unroll
            for (int e = 0; e < 4; ++e) { st[2 * e] = st[2 * e] * d[k] + bf_lo(v[k][e]); st[2 * e + 1] = st[2 * e + 1] * d[k] + bf_hi(v[k][e]); } }
    }
}
__device__ __forceinline__ void mix_out_unit(LAS unsigned char* lds, int unit, const bf16* P, const bf16* G, const float* BON, bf16* Y, const bf16* CS, const float* mu, const float* gn_g, const float* gn_b,
                                             const float* ssm_norm, const float* conv_w, const float* conv_b, const float* dt_bias, const float* a_log, int tid, int wave, int lane, bool st = true) {
    const int c = unit & 31, b = unit >> 5, h = wave, g = h >> 2;
    LAS bf16* Cn2 = (LAS bf16*)(lds); LAS float* ACS8 = (LAS float*)(lds + 34816); LAS float* SS8 = (LAS float*)(lds + 36864);
    const int r = lane & 15, q = lane >> 4;
    const size_t m0 = (size_t)b * SEQ + 64 * c; const bf16* prow = P + (m0 + lane) * PP;
    {
        const float xdt = bf1(prow[3328 + h]) + dt_bias[h]; const float dt = xdt > 20.f ? xdt : log1pf(__expf(xdt));
        float acs = dt * (-__expf(a_log[h]));
#pragma unroll
        for (int o = 1; o < 64; o <<= 1) { const float t = __shfl_up(acs, o); if (lane >= o) acs += t; }
        ACS8[h * 64 + lane] = acs;
    }
    {
        const int cl = lane & 31, chb = 3072 + 8 * cl, cw = chb - 2304;
        const bf16* pbase = P + (m0 + 8 * wave) * PP + chb;
        v4u win[11];
#pragma unroll
        for (int k = 0; k < 11; ++k) { win[k] = (v4u){0u, 0u, 0u, 0u}; if (64 * c + 8 * wave + k - 3 >= 0) win[k] = *(const v4u*)(pbase + (ptrdiff_t)(k - 3) * PP); }
        float cwv[4][8], cbv[8];
#pragma unroll
        for (int e = 0; e < 8; ++e) { cbv[e] = conv_b[cw + e];
#pragma unroll
            for (int k = 0; k < 4; ++k) cwv[k][e] = conv_w[k * 1024 + cw + e]; }
#pragma unroll
        for (int tl = 0; tl < 8; ++tl) { const int t = 8 * wave + tl;
            float o8[8];
#pragma unroll
            for (int e = 0; e < 8; ++e) o8[e] = cbv[e];
#pragma unroll
            for (int k = 0; k < 4; ++k) { const v4u iv = win[tl + k];
#pragma unroll
                for (int e = 0; e < 4; ++e) { o8[2 * e] += cwv[k][2 * e] * bf_lo(iv[e]); o8[2 * e + 1] += cwv[k][2 * e + 1] * bf_hi(iv[e]); } }
#pragma unroll
            for (int e = 0; e < 8; ++e) o8[e] = o8[e] * sigm(o8[e]);
            v4u o; o.x = cvt_pk_bf16(o8[0], o8[1]); o.y = cvt_pk_bf16(o8[2], o8[3]); o.z = cvt_pk_bf16(o8[4], o8[5]); o.w = cvt_pk_bf16(o8[6], o8[7]);
            if (lane < 32) *(LAS v4u*)(Cn2 + (cl >> 4) * 8704 + t * 136 + 8 * (cl & 15)) = o;
        }
    }
    __syncthreads();
    float ssl[4];
    {
        const bf16* cs = CS + (size_t)((b * 32 + c) * 8 + h) * 8192; const LAS bf16* Cg = Cn2 + g * 8704;
#pragma unroll
        for (int lb = 0; lb < 4; ++lb) ssl[lb] = 0.f;
#pragma unroll
        for (int pb = 0; pb < 4; ++pb) {
            bf16x8 bo[4];
#pragma unroll
            for (int kk = 0; kk < 4; ++kk) bo[kk] = *(const bf16x8*)(cs + (16 * pb + r) * 128 + 32 * kk + 8 * q);
            const int p0 = 16 * pb + 4 * q;
#pragma unroll
            for (int lb = 0; lb < 4; ++lb) { const int l = 16 * lb + r;
                bf16* yp = Y + (m0 + l) * 1024 + 512 + 64 * h + p0;
                const v2u yv = *(const v2u*)yp, zv = *(const v2u*)(P + (m0 + l) * PP + 1792 + 64 * h + p0);
                f32x4 acc = (f32x4){0.f, 0.f, 0.f, 0.f};
#pragma unroll
                for (int kk = 0; kk < 4; ++kk) acc = MFMA16(bo[kk], *(const LAS bf16x8*)(Cg + l * 136 + 32 * kk + 8 * q), acc);
                const float ea = __expf(ACS8[h * 64 + l]); const f32x4 y4 = bf4(yv) + ea * acc, z4 = bf4(zv);
                f32x4 u4;
#pragma unroll
                for (int j = 0; j < 4; ++j) { u4[j] = y4[j] * z4[j] * sigm(z4[j]); ssl[lb] += u4[j] * u4[j]; }
                v2u o; o.x = cvt_pk_bf16(u4[0], u4[1]); o.y = cvt_pk_bf16(u4[2], u4[3]);
                if (st) *(v2u*)yp = o;
            }
            asm volatile("" ::: "memory");
        }
#pragma unroll
        for (int lb = 0; lb < 4; ++lb) { float t = ssl[lb]; t += __shfl_xor(t, 16); t += __shfl_xor(t, 32); if (q == 0) SS8[h * 64 + 16 * lb + r] = t; }
    }
    __syncthreads();
    {
#pragma unroll
        for (int lb = 0; lb < 4; ++lb) { const int l = 16 * lb + r; float t = 0.f;
#pragma unroll
            for (int hh = 0; hh < 8; ++hh) t += SS8[hh * 64 + l];
            const float rs = __builtin_amdgcn_rsqf(t * (1.f / 512.f) + 1e-5f);
#pragma unroll
            for (int pb = 0; pb < 4; ++pb) { const int p0 = 16 * pb + 4 * q; bf16* yp = Y + (m0 + l) * 1024 + 512 + 64 * h + p0;
                const f32x4 u4 = bf4(*(const v2u*)yp) * rs * *(const f32x4*)(ssm_norm + 64 * h + p0);
                v2u o; o.x = cvt_pk_bf16(u4[0], u4[1]); o.y = cvt_pk_bf16(u4[2], u4[3]); if (st) *(v2u*)yp = o; }
        }
    }
    {
        const int c8 = 8 * lane, hh = lane >> 3;
        float gg[8], gb[8], muv[8];
#pragma unroll
        for (int e = 0; e < 8; ++e) { gg[e] = gn_g[c8 + e]; gb[e] = gn_b[c8 + e]; muv[e] = mu[1024 + c8 + e]; }
#pragma unroll
        for (int bt = 0; bt < 2; ++bt) {
            v4u yv[4], gv[4], vc[4], vp[4]; float bon[4];
#pragma unroll
            for (int k = 0; k < 4; ++k) { const size_t m = m0 + 8 * wave + 4 * bt + k; const int t = (int)(m & (SEQ - 1)); const bf16* pr = P + m * PP;
                yv[k] = *(const v4u*)(Y + m * 1024 + c8); gv[k] = *(const v4u*)(G + m * 512 + c8); vc[k] = *(const v4u*)(pr + 1024 + c8);
                vp[k] = (v4u){0u, 0u, 0u, 0u}; if (t) vp[k] = *(const v4u*)(pr - PP + 1024 + c8); bon[k] = BON[m * 8 + hh]; }
#pragma unroll
            for (int k = 0; k < 4; ++k) { const size_t m = m0 + 8 * wave + 4 * bt + k;
                float y[8], sm = 0.f;
#pragma unroll
                for (int e = 0; e < 4; ++e) { y[2 * e] = bf_lo(yv[k][e]); y[2 * e + 1] = bf_hi(yv[k][e]); sm += y[2 * e] + y[2 * e + 1]; }
                sm += __shfl_xor(sm, 1); sm += __shfl_xor(sm, 2); sm += __shfl_xor(sm, 4);
                const float mean = sm * (1.f / 64.f); float qv_ = 0.f;
#pragma unroll
                for (int e = 0; e < 8; ++e) { y[e] -= mean; qv_ += y[e] * y[e]; }
                qv_ += __shfl_xor(qv_, 1); qv_ += __shfl_xor(qv_, 2); qv_ += __shfl_xor(qv_, 4);
                const float rstd = __builtin_amdgcn_rsqf(qv_ * (1.f / 64.f) + 64e-5f);
                float o[8];
#pragma unroll
                for (int e = 0; e < 4; ++e) {
                    const float v0 = bf_lo(vc[k][e]), v1 = bf_hi(vc[k][e]), p0 = bf_lo(vp[k][e]), p1 = bf_hi(vp[k][e]);
                    const float va = v0 + (p0 - v0) * muv[2 * e], vb = v1 + (p1 - v1) * muv[2 * e + 1];
                    o[2 * e] = (y[2 * e] * rstd * gg[2 * e] + gb[2 * e] + bon[k] * va) * bf_lo(gv[k][e]);
                    o[2 * e + 1] = (y[2 * e + 1] * rstd * gg[2 * e + 1] + gb[2 * e + 1] + bon[k] * vb) * bf_hi(gv[k][e]);
                }
                v4u w; w.x = cvt_pk_bf16(o[0], o[1]); w.y = cvt_pk_bf16(o[2], o[3]); w.z = cvt_pk_bf16(o[4], o[5]); w.w = cvt_pk_bf16(o[6], o[7]);
                if (st) *(v4u*)(Y + m * 1024 + c8) = w;
            }
        }
    }
    __syncthreads();
}
#define XB_TMO      128
#define XB_XCNT(j)  (256  + 64 * (j))
#define XB_XSUB(j)  (1280 + 64 * (j))
#define XB_XGEN(j)  (2304 + 64 * (j))
#define XB_TOP      3328
#define XB_TOPGEN   3392
#define XCD_BAR_WORDS 3456
#define XB_SPIN_CAP (1u << 18)

__device__ __forceinline__ unsigned xb_ld(unsigned* p)              { return __hip_atomic_load(p, __ATOMIC_RELAXED, __HIP_MEMORY_SCOPE_AGENT); }
__device__ __forceinline__ unsigned xb_add(unsigned* p, unsigned v) { return __hip_atomic_fetch_add(p, v, __ATOMIC_RELAXED, __HIP_MEMORY_SCOPE_AGENT); }
__device__ __forceinline__ unsigned xb_xcc_id() { return (unsigned)__builtin_amdgcn_s_getreg((3 << 11) | 20) & 0xFu; }
#define XB_SPIN(cond, bar) do { unsigned _sp = 0; while (cond) { __builtin_amdgcn_s_sleep(1); \
    if ((++_sp & 255u) == 0u) { if (xb_ld(&(bar)[XB_TMO])) break; if (_sp > XB_SPIN_CAP) { atomicAdd(&(bar)[XB_TMO], 1u); break; } } } } while (0)

struct XcdBarrier {
    unsigned* bar; unsigned x;
    volatile LAS unsigned* st;
};

__device__ __forceinline__ XcdBarrier xcd_barrier_post(unsigned* bar, volatile LAS unsigned* st) {
    XcdBarrier b; b.bar = bar; b.x = xb_xcc_id(); b.st = st;
    if (threadIdx.x == 0) (void)xb_add(&bar[XB_XCNT(b.x)], 1u);
    return b;
}
__device__ __forceinline__ void xcd_barrier_complete(unsigned* bar, unsigned x, unsigned& nloc, unsigned& nx) {
    const unsigned G = gridDim.x * gridDim.y * gridDim.z;
    unsigned sum, cnt, mine, sp = 0u;
    for (;;) {
        sum = 0u; cnt = 0u; mine = 0u;
#pragma unroll
        for (unsigned j = 0; j < 16; ++j) { const unsigned c = xb_ld(&bar[XB_XCNT(j)]); sum += c; cnt += (c > 0u) ? 1u : 0u; mine = (j == x) ? c : mine; }
        if (sum == G) break;
        __builtin_amdgcn_s_sleep(1);
        if ((++sp & 255u) == 0u) { if (xb_ld(&bar[XB_TMO])) break; if (sp > XB_SPIN_CAP) { atomicAdd(&bar[XB_TMO], 1u); break; } }
    }
    nloc = mine > 0u ? mine : 1u; nx = cnt > 0u ? cnt : 1u;
}

__device__ __forceinline__ void xcd_barrier(const XcdBarrier& b) {
    asm volatile("s_waitcnt vmcnt(0)" ::: "memory");
    __syncthreads();
    if (threadIdx.x == 0) {
        unsigned* bar = b.bar;
        __builtin_amdgcn_s_waitcnt(0);
        unsigned nloc = b.st[0], nx = b.st[1];
        if (nloc == 0u) { xcd_barrier_complete(bar, b.x, nloc, nx); b.st[0] = nloc; b.st[1] = nx; }
        const unsigned old = xb_add(&bar[XB_XSUB(b.x)], 1u);
        const unsigned gen = old / nloc;
        if (old + 1u == (gen + 1u) * nloc) {
            __builtin_amdgcn_fence(__ATOMIC_RELEASE, "agent");
            asm volatile("s_waitcnt vmcnt(0)" ::: "memory");
            const unsigned og = xb_add(&bar[XB_TOP], 1u);
            const unsigned tg = og / nx;
            if (og + 1u == (tg + 1u) * nx) xb_add(&bar[XB_TOPGEN], 1u);
            else XB_SPIN(xb_ld(&bar[XB_TOPGEN]) == tg, bar);
            __builtin_amdgcn_fence(__ATOMIC_ACQUIRE, "agent");
            xb_add(&bar[XB_XGEN(b.x)], 1u);
            asm volatile("s_waitcnt vmcnt(0)" ::: "memory");
        } else {
            XB_SPIN(xb_ld(&bar[XB_XGEN(b.x)]) == gen, bar);
            __builtin_amdgcn_fence(__ATOMIC_ACQUIRE, "agent");
            asm volatile("s_waitcnt vmcnt(0)" ::: "memory");
        }
    }
    __syncthreads();
}

struct Args { const float* in[30]; float* out; unsigned char* ws; int ph_lo, ph_hi, dry, pad; };
__global__ void __launch_bounds__(NTHREADS, 2) fwd_kernel(Args args) {
    extern __shared__ __attribute__((aligned(16))) unsigned char lds_raw[];
    LAS unsigned char* lds = (LAS unsigned char*)lds_raw;
    const int tid = threadIdx.x, lane = tid & 63, wave = __builtin_amdgcn_readfirstlane(tid >> 6);
    const int G = gridDim.x, bx = blockIdx.x; const int vcu = (G % 8 == 0) ? (bx % 8) * (G / 8) + bx / 8 : bx;
    const int gw = vcu * NWAVES + wave, NGW = G * NWAVES;
    unsigned char* ws = args.ws;
    const float* const* in = args.in;
    bf16* W1GU = (bf16*)(ws + WS_W1GU); bf16* W1D = (bf16*)(ws + WS_W1D); bf16* WIN = (bf16*)(ws + WS_WIN); bf16* WOUT = (bf16*)(ws + WS_WOUT);
    bf16* W2GU = (bf16*)((unsigned char*)args.out + 32 * MiB);     bf16* W2D = (bf16*)(ws + WS_W2D); bf16* WL = (bf16*)(ws + WS_WL);
    bf16* XG = (bf16*)(ws + WS_XG); bf16* PB = (bf16*)(ws + WS_P); bf16* YB = (bf16*)(ws + WS_Y); bf16* GB = (bf16*)(ws + WS_G); bf16* LIN = (bf16*)(ws + WS_LIN);
    bf16* EAB = (bf16*)args.out;
    float* PART = (float*)(ws + WS_PART); float* BON = (float*)(ws + WS_BONUS); float* GCG = (float*)(ws + WS_GC); unsigned* SLG = (unsigned*)(ws + WS_LIN); bf16* CSB = (bf16*)(ws + WS_CS); float* CDB = (float*)(ws + WS_CD);
    const int lo = args.ph_lo, hi = args.ph_hi;
    cg::grid_group grid = cg::this_grid();
    volatile LAS unsigned* xbst = (volatile LAS unsigned*)(lds + 147440);
    if (tid < 2) xbst[tid] = 0u;
    __syncthreads();
    XcdBarrier xbar; xbar.bar = (unsigned*)ws; xbar.x = 0; xbar.st = nullptr;
    if (hi - lo > 1) xbar = xcd_barrier_post((unsigned*)ws, xbst);
#ifndef PH_MASK
#define PH_MASK 0xfff
#endif
#ifndef REPG
#define REPG 1
#endif
#ifndef REP0
#define REP0 1
#endif
#define IN(k) (((PH_MASK >> (k)) & 1) && lo <= (k) && (k) < hi)
#define SEAM(k) do { if (IN(k) && IN((k) + 1)) { if (args.pad != 0) grid.sync(); else xcd_barrier(xbar); } } while (0)
    if (IN(0)) { p0_prologue(lds, in, ws, vcu, G, tid, wave, lane); SEAM(0); }
    if (IN(1)) {
        pg8::Gemm g{XG, W1GU, M, NGU, D}; pg8::StaticOrder S; S.init(M, NGU, G, bx);
        pg8::EpiSwiGLU E{PB, FF, nullptr};
        pg8::gemm_phase<pg8::EpiSwiGLU, pg8::StaticOrder, true, true>(lds, g, S, E);
        if (G == 256 ? bx >= 128 : true) { const int tb_ = G == 256 ? bx - 128 : bx, ntb = G == 256 ? 128 : G; p1_tail_copies(in, ws, tb_ * NWAVES + wave, ntb * NWAVES, tb_ * NTHREADS + tid, ntb * NTHREADS, lane); }
        SEAM(1);
    }
    if (IN(2)) {
        pg8::Gemm g{PB, W1D, M, D, FF}; pg8::StaticOrder S; S.init(M, D, G, bx);
        pg8::EpiResidB<false> E{in[0], XG, nullptr, PART, 0.5f, nullptr, nullptr};
        pg8::gemm_phase<pg8::EpiResidB<false>, pg8::StaticOrder, true, true>(lds, g, S, E);
        SEAM(2);
    }
    if (IN(3)) {
        pg8::Gemm g{XG, WIN, M, NINP, D}; pg8::StaticOrder S; S.init(M, NINP, G, bx);
        pg8::EpiScaleBf16 E{PB, PP, NIN, PART};
        pg8::gemm_phase<pg8::EpiScaleBf16, pg8::StaticOrder, true, true>(lds, g, S, E);
        if (G == 256 ? bx >= 128 : true) {
            const int tb_ = G == 256 ? bx - 128 : bx, ntw = (G == 256 ? 128 : G) * NWAVES;
            for (int it = tb_ * NWAVES + wave; it < 2 * TR_I_GU; it += 2 * ntw) {
                int ra = it; const int upa = ra >= TR_I_GU; ra -= upa * TR_I_GU; const TrItem a = tr_make(in[26 + upa], FF, ra / 44, ra % 44, W2GU, D, 0, 0, 1, upa, lane, in[25]);
                const bool hasb = it + ntw < 2 * TR_I_GU; int rb = hasb ? it + ntw : it; const int upb = rb >= TR_I_GU; rb -= upb * TR_I_GU; const TrItem b = tr_make(in[26 + upb], FF, rb / 44, rb % 44, W2GU, D, 0, 0, 1, upb, lane, in[25]);
                f32x4 va[8], vb[8]; tr_load(a, va); tr_load(b, vb); tr_store(a, va); if (hasb) tr_store(b, vb);
            }
        }
        SEAM(3);
    }
    if (IN(4)) { p4_lora_in(PB, in[7], LIN, vcu * NTHREADS + tid, G * NTHREADS); SEAM(4); }
    if (IN(5)) {
        int kl = 128; asm volatile("" : "+s"(kl));
        { pg8::Gemm g{LIN, WL, M, 1024, kl, KLORA}; pg8::StaticOrder S; S.init(M, 1024, G, bx);
          pg8::EpiLora E{EAB, GB};
          pg8::gemm_phase<pg8::EpiLora, pg8::StaticOrder, true, true>(lds, g, S, E); }
        { pg8::Gemm g{LIN + 128, WL + (size_t)1024 * KLORA + 128, M, 512, kl, KLORA}; pg8::StaticOrder S; S.init(M, 512, G, (bx + 128) % G);
          pg8::EpiLoraG E2{GB};
          pg8::gemm_phase<pg8::EpiLoraG, pg8::StaticOrder, true, true>(lds, g, S, E2); }
        SEAM(5);
    }
    const int dry = args.dry;
    if (IN(6)) {
        {
            const int h6 = vcu & 7, g6 = h6 >> 2; LAS float* CW = (LAS float*)(lds + 133632); LAS float* PRMw = (LAS float*)(lds + 140032);
            for (int idx = tid; idx < 1600; idx += NTHREADS) { const int cgp = idx / 40, rem = idx % 40, k = rem >> 3, e = rem & 7;
                const int chb = cgp < 8 ? 2304 + 64 * h6 + 8 * cgp : (cgp < 24 ? 2816 + 128 * g6 + 8 * (cgp - 8) : 3072 + 128 * g6 + 8 * (cgp - 24));
                CW[idx] = k < 4 ? in[18][k * 1024 + chb - 2304 + e] : in[19][chb - 2304 + e]; }
            { const int a = tid >> 6, j = tid & 63; const float* src = a < 3 ? in[7] + 512 * a : (a == 3 ? in[13] : (a == 4 ? in[14] : (a == 5 ? in[15] : (a == 6 ? in[8] : in[10]))));
              PRMw[tid] = src[64 * h6 + j]; }
            __syncthreads();
        }
        if (dry == 0 || (dry & 1)) { RwIn rin; rwkv_chunk_load(rin, vcu, PB, EAB, tid);
            for (int u = vcu; u < 2048; u += G) { rwkv_chunk_unit(lds, u, rin, u + G < 2048 ? u + G : -1, PB, EAB, YB, BON, GCG, SLG, tid, wave, lane, dry == 0, dry >> 4); } }
        if (dry == 0 || (dry & 2)) {
            {
                __syncthreads();
                const int g6 = vcu & 1; LAS float* CW = (LAS float*)(lds + 133632);
                for (int idx = tid; idx < 2560; idx += NTHREADS) { const int cgp = idx / 40, rem = idx % 40, k = rem >> 3, e = rem & 7;
                    const int chb = cgp < 16 ? 2816 + 128 * g6 + 8 * cgp : (cgp < 32 ? 3072 + 128 * g6 + 8 * (cgp - 16) : 2304 + 256 * g6 + 8 * (cgp - 32));
                    CW[idx] = k < 4 ? in[18][k * 1024 + chb - 2304 + e] : in[19][chb - 2304 + e]; }
                __syncthreads();
            }
            for (int u = vcu; u < 512; u += G) ssd_chunk_group(lds, u, PB, YB, CSB, CDB, in[20], in[21], in[22], tid, wave, lane);
        }
        SEAM(6);
    }
    if (IN(7)) {
        volatile LAS unsigned* prog = (volatile LAS unsigned*)(lds + 131072);
        if (tid == 0) *prog = 0u;
        __syncthreads();
        if (wave == 0) { if ((dry == 0 || (dry & 1)) && vcu < 256) rwkv_seq_state(lds, prog, vcu, EAB, GCG, SLG, lane); }
        else if (wave == 1) { if ((dry == 0 || (dry & 1)) && vcu < 256) rwkv_seq_out(lds, prog, vcu, EAB, YB, lane, dry == 0); }
        else if (dry == 0 || (dry & 2)) { for (int it = (vcu * 6 + wave - 2) * 64 + lane; it < 65536; it += G * 6 * 64) ssd_scan_item(it, CSB, CDB, dry == 0); }
        SEAM(7);
    }
    if (IN(8)) {
        if (dry == 0 || (dry & 1)) for (int u = vcu; u < 256; u += G) mix_out_unit(lds, u, PB, GB, BON, YB, CSB, in[7], in[16], in[17], in[23], in[18], in[19], in[20], in[21], tid, wave, lane, dry == 0);
        SEAM(8);
    }
    if (IN(9)) {
        pg8::Gemm g{YB, WOUT, M, D, D}; pg8::StaticOrder S; S.init(M, D, G, bx);
        pg8::EpiResidB<true> E{XG, XG, nullptr, PART, 1.0f, nullptr, nullptr};
        pg8::gemm_phase<pg8::EpiResidB<true>, pg8::StaticOrder, true, true>(lds, g, S, E);
        SEAM(9);
    }
    if (IN(10)) {
        pg8::Gemm g{XG, W2GU, M, NGU, D}; pg8::StaticOrder S; S.init(M, NGU, G, bx);
        pg8::EpiSwiGLU E{PB, FF, PART};
        pg8::gemm_phase<pg8::EpiSwiGLU, pg8::StaticOrder, true, true>(lds, g, S, E);
        SEAM(10);
    }
    if (IN(11)) {
        pg8::Gemm g{PB, W2D, M, D, FF}; pg8::StaticOrder S; S.init(M, D, G, bx);
        pg8::EpiResidNormFinal E{XG, args.out, in[29], (float*)(ws + 65536), (unsigned*)(ws + 16384), 0.5f};
        pg8::gemm_phase<pg8::EpiResidNormFinal, pg8::StaticOrder, false, true>(lds, g, S, E);
    }
#undef IN
#undef SEAM
}

extern "C" void kernel_launch(void* const* d_in, const int* in_sizes, int n_in, void* d_out, int out_size, void* d_ws, size_t ws_size, hipStream_t stream) {
    static int grid = 0;
    if (grid == 0) {
        if (n_in != 30 || out_size != M * D || ws_size < WS_END) { fprintf(stderr, "kernel_launch: unexpected shapes (n_in %d out %d ws %zu)\n", n_in, out_size, ws_size); grid = -1; return; }
        int dev = 0, cus = 0, per_cu = 0;
        hipGetDevice(&dev); hipDeviceGetAttribute(&cus, hipDeviceAttributeMultiprocessorCount, dev);
        if (hipFuncSetAttribute((const void*)fwd_kernel, hipFuncAttributeMaxDynamicSharedMemorySize, LDS_BYTES) != hipSuccess) { fprintf(stderr, "kernel_launch: hipFuncSetAttribute failed\n"); grid = -1; return; }
        hipOccupancyMaxActiveBlocksPerMultiprocessor(&per_cu, (const void*)fwd_kernel, NTHREADS, LDS_BYTES);
        (void)hipGetLastError();
        if (per_cu < 1) per_cu = 1;
        grid = cus * 1;
        if (grid != 256) fprintf(stderr, "kernel_launch: note: grid %d\n", grid);
    }
    if (grid < 0) return;
    Args a{};
    for (int i = 0; i < 30; ++i) a.in[i] = (const float*)d_in[i];
    a.out = (float*)d_out; a.ws = (unsigned char*)d_ws;
    if (hipMemsetAsync(d_ws, 0, 32768, stream) != hipSuccess) { fprintf(stderr, "kernel_launch: memset of the control words failed\n"); return; }
#if MK_N_LAUNCHES == 1
    a.ph_lo = 0; a.ph_hi = NPHASE;
    void* kargs[] = {&a};
    hipError_t e = hipLaunchCooperativeKernel((const void*)fwd_kernel, dim3(grid), dim3(NTHREADS), kargs, LDS_BYTES, stream);
    if (e != hipSuccess) fprintf(stderr, "cooperative launch failed: %s (grid %d)\n", hipGetErrorString(e), grid);
#else
    #ifndef REP_PHASE_MASK
#define REP_PHASE_MASK 0
#endif
#ifndef PROBE_PHASE
#define PROBE_PHASE -1
#define PROBE_SEL 0
#endif
    for (int p = 0; p < NPHASE; ++p) { a.ph_lo = p; a.ph_hi = p + 1; const int nrep = ((REP_PHASE_MASK >> p) & 1) ? 2 : 1;
        if (p == PROBE_PHASE) { a.dry = PROBE_SEL; hipLaunchKernelGGL(fwd_kernel, dim3(grid), dim3(NTHREADS), LDS_BYTES, stream, a); a.dry = 0; }
        for (int rr = 0; rr < nrep; ++rr) hipLaunchKernelGGL(fwd_kernel, dim3(grid), dim3(NTHREADS), LDS_BYTES, stream, a); }
#endif
}
```

```cpp
#include <hip/hip_runtime.h>
#include <hip/hip_cooperative_groups.h>
#include <cstdio>
#include <cstdint>
namespace cg = cooperative_groups;
#define MK_N_LAUNCHES 1
namespace pg8 {
#define PG8_LAS __attribute__((address_space(3)))
typedef unsigned short bf16_t;
typedef short bf16x8 __attribute__((ext_vector_type(8)));
typedef float f32x4 __attribute__((ext_vector_type(4)));
typedef unsigned u32x4 __attribute__((ext_vector_type(4)));
constexpr int BM = 256, BK = 64, HALF = 128, HTB = HALF * BK * 2  , STAGE_BYTES = 8 * HTB, NXCD = 8, WGM = 4;

__host__ __device__ __forceinline__ int lds_byte(int r, int c) { const int st = (r >> 4) * 2 + (c >> 5), rr = r & 15, cc = c & 31, ob = rr * 64 + cc * 2; return st * 1024 + (ob ^ (((ob >> 9) & 1) << 5)); }
__host__ __device__ __forceinline__ void stage_rc(int b, int& R, int& C) { const int st = b / 1024, sb = b % 1024, swz = sb ^ (((sb >> 9) & 1) << 5); R = (st >> 1) * 16 + swz / 64; C = (st & 1) * 32 + (swz % 64) / 2; }
__host__ __device__ __forceinline__ int perm32(int rho) { const int n = rho >> 4, i = rho & 15; return 8 * (i >> 2) + 4 * n + (i & 3); }

struct Unit { int pm, pn; };
struct Gemm { const bf16_t* A; const bf16_t* Bt; int M, N, K; int ld; };

struct StaticOrder {
    int nM, nN, nwg, G, c;
    __host__ __device__ void init(int M, int N, int G_, int c_) { nM = M / BM; nN = N / BM; nwg = nM * nN; G = G_; c = c_; }
    __host__ __device__ bool next(int i, Unit& u) const {
        const long L = (long)i * G + c; if (L >= nwg) return false;
        int wgid = (int)L; { const int q = nwg / NXCD, r = nwg % NXCD, xcd = wgid % NXCD, off = wgid / NXCD; wgid = (xcd < r ? xcd * (q + 1) : r * (q + 1) + (xcd - r) * q) + off; }
        const int nig = WGM * nN, gid = wgid / nig, fm = gid * WGM, gsz = (nM - fm) < WGM ? (nM - fm) : WGM;
        u.pm = fm + ((wgid % nig) % gsz); u.pn = (wgid % nig) / gsz; return true;
    }
    __device__ __forceinline__ void a_ready(const Unit&) const {}
    __device__ __forceinline__ void done(const Unit&) const {}
};
typedef float f32x2c_ __attribute__((ext_vector_type(2)));
typedef __bf16 bf16x2c_ __attribute__((ext_vector_type(2)));
__device__ __forceinline__ unsigned cvt_pk_bf16(float lo, float hi) { const f32x2c_ v = {lo, hi}; const bf16x2c_ b = __builtin_convertvector(v, bf16x2c_); return __builtin_bit_cast(unsigned, b); }
typedef unsigned u32x2 __attribute__((ext_vector_type(2)));
__device__ __forceinline__ float sigmoidf_(float x) { return __builtin_amdgcn_rcpf(1.0f + __expf(-x)); }
__device__ __forceinline__ float row_rscale(const float* part, int row) {
    const f32x4* p = (const f32x4*)(part + (size_t)row * 16);
    const f32x4 a = p[0], b = p[1], c = p[2], d = p[3];
    const f32x4 s = (a + b) + (c + d);
    return __builtin_amdgcn_rsqf(((s[0] + s[1]) + (s[2] + s[3])) * (1.0f / 1024.0f) + 1e-6f);
}
struct EpiSwiGLU {
    static constexpr bool PERM = true, AFTER_DRAIN = false;
    bf16_t* O; int ldc; const float* part;
    __device__ __forceinline__ void operator()(const f32x4 (&acc)[2][2][4][2], const Unit& u, int wr, int wc, int fr, int fq) const {
        const int row0 = u.pm * BM + wr * 64 + fr, col0 = u.pn * HALF + wc * 32 + 8 * fq;
#pragma unroll
        for (int ai = 0; ai < 2; ++ai)
#pragma unroll
            for (int m = 0; m < 4; ++m) {
                const int row = row0 + ai * HALF + m * 16;
                const float rs = part ? row_rscale(part, row) : 1.0f;
                float h[8];
#pragma unroll
                for (int n = 0; n < 2; ++n)
#pragma unroll
                    for (int j = 0; j < 4; ++j) { const float g = acc[ai][0][m][n][j] * rs, up = acc[ai][1][m][n][j] * rs; h[4 * n + j] = g * sigmoidf_(g) * up; }
                u32x4 w; w.x = cvt_pk_bf16(h[0], h[1]); w.y = cvt_pk_bf16(h[2], h[3]); w.z = cvt_pk_bf16(h[4], h[5]); w.w = cvt_pk_bf16(h[6], h[7]);
                *(u32x4*)(O + (size_t)row * ldc + col0) = w;
            }
    }
};
struct EpiScaleBf16 {
    static constexpr bool PERM = true, AFTER_DRAIN = false;
    bf16_t* O; int ldc; int ncols; const float* part;
    __device__ __forceinline__ void operator()(const f32x4 (&acc)[2][2][4][2], const Unit& u, int wr, int wc, int fr, int fq) const {
        const int row0 = u.pm * BM + wr * 64 + fr, col0 = u.pn * BM + wc * 32 + 8 * fq;
#pragma unroll
        for (int ai = 0; ai < 2; ++ai)
#pragma unroll
            for (int m = 0; m < 4; ++m) {
                const int row = row0 + ai * HALF + m * 16; const float rs = row_rscale(part, row);
#pragma unroll
                for (int bj = 0; bj < 2; ++bj) { const int col = col0 + bj * HALF;
                    if (col < ncols) { const f32x4 v0 = acc[ai][bj][m][0] * rs, v1 = acc[ai][bj][m][1] * rs;
                        u32x4 w; w.x = cvt_pk_bf16(v0[0], v0[1]); w.y = cvt_pk_bf16(v0[2], v0[3]); w.z = cvt_pk_bf16(v1[0], v1[1]); w.w = cvt_pk_bf16(v1[2], v1[3]);
                        *(u32x4*)(O + (size_t)row * ldc + col) = w; } }
            }
    }
};
struct EpiLora {
    static constexpr bool PERM = true, AFTER_DRAIN = false;
    bf16_t* EA; bf16_t* G;
    __device__ __forceinline__ void operator()(const f32x4 (&acc)[2][2][4][2], const Unit& u, int wr, int wc, int fr, int fq) const {
        const int row0 = u.pm * BM + wr * 64 + fr, colt = (u.pn & 3) * BM + wc * 32 + 8 * fq;
        bf16_t* base = u.pn < 4 ? EA : G; const int ldc = u.pn < 4 ? 1024 : 512;
#pragma unroll
        for (int ai = 0; ai < 2; ++ai)
#pragma unroll
            for (int m = 0; m < 4; ++m) {
                bf16_t* rowp = base + (size_t)(row0 + ai * HALF + m * 16) * ldc + colt;
#pragma unroll
                for (int bj = 0; bj < 2; ++bj) { const f32x4 v0 = acc[ai][bj][m][0], v1 = acc[ai][bj][m][1];
                    u32x4 w; w.x = cvt_pk_bf16(v0[0], v0[1]); w.y = cvt_pk_bf16(v0[2], v0[3]); w.z = cvt_pk_bf16(v1[0], v1[1]); w.w = cvt_pk_bf16(v1[2], v1[3]);
                    *(u32x4*)(rowp + bj * HALF) = w; }
            }
    }
};

struct EpiLoraG {
    static constexpr bool PERM = true, AFTER_DRAIN = false;
    bf16_t* G;
    __device__ __forceinline__ void operator()(const f32x4 (&acc)[2][2][4][2], const Unit& u, int wr, int wc, int fr, int fq) const {
        const int row0 = u.pm * BM + wr * 64 + fr, colt = u.pn * BM + wc * 32 + 8 * fq;
#pragma unroll
        for (int ai = 0; ai < 2; ++ai)
#pragma unroll
            for (int m = 0; m < 4; ++m) {
                bf16_t* rowp = G + (size_t)(row0 + ai * HALF + m * 16) * 512 + colt;
#pragma unroll
                for (int bj = 0; bj < 2; ++bj) { const f32x4 v0 = acc[ai][bj][m][0], v1 = acc[ai][bj][m][1];
                    u32x4 w; w.x = cvt_pk_bf16(v0[0], v0[1]); w.y = cvt_pk_bf16(v0[2], v0[3]); w.z = cvt_pk_bf16(v1[0], v1[1]); w.w = cvt_pk_bf16(v1[2], v1[3]);
                    *(u32x4*)(rowp + bj * HALF) = w; }
            }
    }
};
__device__ __forceinline__ f32x4 bf4_(u32x2 u) { return (f32x4){__builtin_bit_cast(float, u.x << 16), __builtin_bit_cast(float, u.x & 0xffff0000u), __builtin_bit_cast(float, u.y << 16), __builtin_bit_cast(float, u.y & 0xffff0000u)}; }
template <bool BASE_BF16> struct EpiResidB {
    static constexpr bool PERM = false, AFTER_DRAIN = false;
    const void* base; bf16_t* xo; bf16_t* xo2; float* part; float scale;
    const float* unrs; const float* ungain;
    __device__ __forceinline__ void operator()(const f32x4 (&acc)[2][2][4][2], const Unit& u, int wr, int wc, int fr, int fq) const {
#pragma unroll
        for (int ai = 0; ai < 2; ++ai)
#pragma unroll
            for (int m = 0; m < 4; ++m) {
                const int row = u.pm * BM + ai * HALF + wr * 64 + m * 16 + fr; float ss = 0.f;
                const float irs = unrs ? __builtin_amdgcn_rcpf(unrs[row]) : 1.0f;
#pragma unroll
                for (int bj = 0; bj < 2; ++bj)
#pragma unroll
                    for (int n = 0; n < 2; ++n) {
                        const int col = u.pn * BM + bj * HALF + wc * 32 + n * 16 + 4 * fq; const size_t off = (size_t)row * 1024 + col;
                        f32x4 bs = BASE_BF16 ? bf4_(*(const u32x2*)((const bf16_t*)base + off)) : *(const f32x4*)((const float*)base + off);
                        if (unrs) { const f32x4 gi = *(const f32x4*)(ungain + col); bs = bs * irs * (f32x4){__builtin_amdgcn_rcpf(gi[0]), __builtin_amdgcn_rcpf(gi[1]), __builtin_amdgcn_rcpf(gi[2]), __builtin_amdgcn_rcpf(gi[3])}; }
                        const f32x4 v = bs + acc[ai][bj][m][n] * scale;
                        ss += (v[0] * v[0] + v[1] * v[1]) + (v[2] * v[2] + v[3] * v[3]);
                        u32x2 o; o.x = cvt_pk_bf16(v[0], v[1]); o.y = cvt_pk_bf16(v[2], v[3]); *(u32x2*)(xo + off) = o; if (xo2) *(u32x2*)(xo2 + off) = o;
                    }
                ss += __shfl_xor(ss, 16); ss += __shfl_xor(ss, 32);
                if (fq == 0) part[(size_t)row * 16 + u.pn * 4 + wc] = ss;
            }
    }
};
struct EpiResidNormFinal {
    static constexpr bool PERM = false, AFTER_DRAIN = true;
    const bf16_t* base; float* out; const float* gain; float* xbuf; unsigned* cnt; float scale;
    __device__ __forceinline__ void fused(f32x4 (&acc)[2][2][4][2], const Unit& u, int wr, int wc, int fr, int fq, PG8_LAS unsigned char* lds, int wid, int lane) const {
        PG8_LAS float* Pw = (PG8_LAS float*)lds;
        PG8_LAS float* Sr = (PG8_LAS float*)(lds + 4096);
#pragma unroll
        for (int ai = 0; ai < 2; ++ai)
#pragma unroll
            for (int m = 0; m < 4; ++m) {
                const int rl = ai * HALF + wr * 64 + m * 16 + fr; const size_t rowoff = (size_t)(u.pm * BM + rl) * 1024; float ss = 0.f;
#pragma unroll
                for (int bj = 0; bj < 2; ++bj)
#pragma unroll
                    for (int n = 0; n < 2; ++n) { const int col = u.pn * BM + bj * HALF + wc * 32 + n * 16 + 4 * fq;
                        const f32x4 v = bf4_(*(const u32x2*)(base + rowoff + col)) + acc[ai][bj][m][n] * scale; acc[ai][bj][m][n] = v;
                        ss += (v[0] * v[0] + v[1] * v[1]) + (v[2] * v[2] + v[3] * v[3]); }
                ss += __shfl_xor(ss, 16); ss += __shfl_xor(ss, 32);
                if (fq == 0) Pw[rl * 4 + wc] = ss;
                asm volatile("" : "+v"(acc[ai][0][m][0]), "+v"(acc[ai][0][m][1]), "+v"(acc[ai][1][m][0]), "+v"(acc[ai][1][m][1]));
                if (m & 1) asm volatile("" ::: "memory");
            }
        asm volatile("s_waitcnt lgkmcnt(0)" ::: "memory"); __builtin_amdgcn_s_barrier(); asm volatile("" ::: "memory");
        const int row = wid * 32 + (lane & 31);
        if (lane < 32) { const f32x4 pp = *(const PG8_LAS f32x4*)(Pw + row * 4); const float t = (pp[0] + pp[1]) + (pp[2] + pp[3]);
            __hip_atomic_store(xbuf + (size_t)(u.pm * BM + row) * 4 + u.pn, t, __ATOMIC_RELAXED, __HIP_MEMORY_SCOPE_AGENT); }
        asm volatile("s_waitcnt vmcnt(0)" ::: "memory");
        if (lane == 0) __hip_atomic_fetch_add(cnt + 64 * u.pm, 1u, __ATOMIC_RELAXED, __HIP_MEMORY_SCOPE_AGENT);
        if (wid == 0) {
            unsigned sp = 0;
            while ((unsigned)__builtin_amdgcn_readfirstlane(__hip_atomic_load(cnt + 64 * u.pm, __ATOMIC_RELAXED, __HIP_MEMORY_SCOPE_AGENT)) < 32u) { __builtin_amdgcn_s_sleep(2); if (++sp > (1u << 22)) break; }
            __builtin_amdgcn_fence(__ATOMIC_ACQUIRE, "agent");
        }
        asm volatile("s_waitcnt vmcnt(0) lgkmcnt(0)" ::: "memory"); __builtin_amdgcn_s_barrier(); asm volatile("" ::: "memory");
        if (lane < 32) { const float* sl = xbuf + (size_t)(u.pm * BM + row) * 4; float t = 0.f;
#pragma unroll
            for (int k = 0; k < 4; ++k) t += __hip_atomic_load(sl + k, __ATOMIC_RELAXED, __HIP_MEMORY_SCOPE_AGENT);
            Sr[row] = __builtin_amdgcn_rsqf(t * (1.0f / 1024.0f) + 1e-6f); }
        asm volatile("s_waitcnt vmcnt(0) lgkmcnt(0)" ::: "memory"); __builtin_amdgcn_s_barrier(); asm volatile("" ::: "memory");
#pragma unroll
        for (int ai = 0; ai < 2; ++ai)
#pragma unroll
            for (int m = 0; m < 4; ++m) {
                const int rl = ai * HALF + wr * 64 + m * 16 + fr; const size_t rowoff = (size_t)(u.pm * BM + rl) * 1024; const float rs = Sr[rl];
#pragma unroll
                for (int bj = 0; bj < 2; ++bj)
#pragma unroll
                    for (int n = 0; n < 2; ++n) { const int col = u.pn * BM + bj * HALF + wc * 32 + n * 16 + 4 * fq;
                        *(f32x4*)(out + rowoff + col) = acc[ai][bj][m][n] * rs * *(const f32x4*)(gain + col); }
            }
    }
};

template <class Epi, class Sched, bool ALIGN_EPI = false, bool SP2 = false>
__device__ __forceinline__ void gemm_phase(PG8_LAS unsigned char* lds, const Gemm g, const Sched& S, const Epi& E) {
    const int tid = threadIdx.x, wid = __builtin_amdgcn_readfirstlane(tid >> 6), lane = tid & 63, wr = wid >> 2, wc = wid & 3, fr = lane & 15, fq = lane >> 4;
    const int K = g.K, nt = K / BK, LD = g.ld ? g.ld : g.K;
    unsigned voffA[2], voffB[2];
#pragma unroll
    for (int i = 0; i < 2; ++i) { int R, C; stage_rc(tid * 16 + i * 8192, R, C); const int Rb = Epi::PERM ? ((R & ~31) + perm32(R & 31)) : R;
        voffA[i] = (unsigned)(R * LD + C) * 2u; voffB[i] = (unsigned)(Rb * LD + C) * 2u; }
    const size_t kstep = (size_t)(BK * 2);
    const size_t hstep = (size_t)HALF * LD * 2;
    const size_t tstep = 2 * hstep;
    const unsigned ldsw = (unsigned)wid * 1024u;
    const int aoff = lds_byte(wr * 64 + fr, fq * 8), boff = lds_byte(wc * 32 + fr, fq * 8);
#define PG8_SA(b, h) (((b) * 2 + (h)) * HTB)
#define PG8_SB(b, h) ((4 + (b) * 2 + (h)) * HTB)
#define PG8_STAGE(bufoff, gbase, voff) do { _Pragma("unroll") for (int _i = 0; _i < 2; ++_i) \
        __builtin_amdgcn_global_load_lds((const unsigned*)((const char*)(gbase) + (voff)[_i]), (PG8_LAS unsigned*)(lds + (bufoff) + ldsw + _i * 8192), 16, 0, 0); } while (0)
#define PG8_LDA(dst, b, h) do { _Pragma("unroll") for (int m = 0; m < 4; ++m) _Pragma("unroll") for (int k = 0; k < 2; ++k) dst[m][k] = *(const PG8_LAS bf16x8*)(lds + PG8_SA(b, h) + aoff + m * 2048 + k * 1024); } while (0)
#define PG8_LDB(dst, b, h) do { _Pragma("unroll") for (int n = 0; n < 2; ++n) _Pragma("unroll") for (int k = 0; k < 2; ++k) dst[n][k] = *(const PG8_LAS bf16x8*)(lds + PG8_SB(b, h) + boff + n * 2048 + k * 1024); } while (0)
#define PG8_MMA(ai, bj, At, Bt) do { __builtin_amdgcn_s_setprio(1); _Pragma("unroll") for (int m = 0; m < 4; ++m) _Pragma("unroll") for (int n = 0; n < 2; ++n) _Pragma("unroll") for (int k = 0; k < 2; ++k) \
        acc[ai][bj][m][n] = __builtin_amdgcn_mfma_f32_16x16x32_bf16(Bt[n][k], At[m][k], acc[ai][bj][m][n], 0, 0, 0); __builtin_amdgcn_s_setprio(0); } while (0)
#define PG8_WAIT_V(n) asm volatile("s_waitcnt vmcnt(" #n ")" ::: "memory")
#define PG8_WAIT_L(n) asm volatile("s_waitcnt lgkmcnt(" #n ")" ::: "memory")
#define PG8_BAR __builtin_amdgcn_s_barrier()
#define PG8_SCHED __builtin_amdgcn_sched_barrier(0)
    Unit cur, nxt; int ui = 0;
    if (!S.next(0, cur)) return;
    f32x4 acc[2][2][4][2];
#pragma unroll
    for (int a = 0; a < 2; ++a)
#pragma unroll
        for (int b = 0; b < 2; ++b)
#pragma unroll
            for (int m = 0; m < 4; ++m)
#pragma unroll
                for (int n = 0; n < 2; ++n) acc[a][b][m][n] = (f32x4){0.f, 0.f, 0.f, 0.f};
    bf16x8 At[4][2], B0[2][2], B1[2][2];
    const char* cA = (const char*)g.A + (size_t)cur.pm * tstep; const char* cB = (const char*)g.Bt + (size_t)cur.pn * tstep;
    S.a_ready(cur);
    if constexpr (SP2) {
        PG8_STAGE(PG8_SB(0, 0), cB, voffB); PG8_STAGE(PG8_SB(0, 1), cB + hstep, voffB); PG8_STAGE(PG8_SA(0, 0), cA, voffA); PG8_STAGE(PG8_SA(0, 1), cA + hstep, voffA);
        if (wr == 1) PG8_BAR;
        PG8_WAIT_V(2); PG8_BAR;
        PG8_STAGE(PG8_SB(1, 0), cB + kstep, voffB); PG8_STAGE(PG8_SA(1, 0), cA + kstep, voffA); PG8_STAGE(PG8_SB(1, 1), cB + hstep + kstep, voffB);
        PG8_WAIT_V(6); PG8_BAR;
    } else {
        PG8_STAGE(PG8_SB(0, 0), cB, voffB); PG8_STAGE(PG8_SA(0, 0), cA, voffA); PG8_STAGE(PG8_SB(0, 1), cB + hstep, voffB); PG8_STAGE(PG8_SA(0, 1), cA + hstep, voffA);
        if (wr == 1) PG8_BAR;
        PG8_WAIT_V(4); PG8_BAR;
        PG8_STAGE(PG8_SB(1, 0), cB + kstep, voffB); PG8_STAGE(PG8_SA(1, 0), cA + kstep, voffA); PG8_STAGE(PG8_SB(1, 1), cB + hstep + kstep, voffB);
        PG8_WAIT_V(6); PG8_BAR;
    }
    for (;;) {
        const bool has_next = S.next(ui + 1, nxt);
        const char* nA = has_next ? (const char*)g.A + (size_t)nxt.pm * tstep : cA; const char* nB = has_next ? (const char*)g.Bt + (size_t)nxt.pn * tstep : cB;
        for (int t = 0; t < nt; t += 2) {
            const bool last = (t == nt - 2);
            const char* a1 = cA + (size_t)(t + 1) * kstep;
            const char* a2 = last ? nA : cA + (size_t)(t + 2) * kstep; const char* b2 = last ? nB : cB + (size_t)(t + 2) * kstep;
            const char* a3 = a2 + kstep; const char* b3 = b2 + kstep;
            if (last && has_next) S.a_ready(nxt);
            if constexpr (SP2) {
            PG8_LDB(B0, 0, 0); PG8_LDB(B1, 0, 1); PG8_SCHED; PG8_LDA(At, 0, 0); PG8_STAGE(PG8_SA(1, 1), a1 + hstep, voffA);
            PG8_WAIT_V(8); PG8_WAIT_L(0); PG8_BAR; PG8_MMA(0, 0, At, B0); PG8_MMA(0, 1, At, B1); PG8_BAR; PG8_SCHED;
            PG8_LDA(At, 0, 1); PG8_STAGE(PG8_SB(0, 0), b2, voffB); PG8_STAGE(PG8_SB(0, 1), b2 + hstep, voffB); PG8_STAGE(PG8_SA(0, 0), a2, voffA);
            PG8_WAIT_V(8); PG8_WAIT_L(0); PG8_BAR; PG8_MMA(1, 0, At, B0); PG8_MMA(1, 1, At, B1); PG8_BAR; PG8_SCHED;
            PG8_LDB(B0, 1, 0); PG8_LDB(B1, 1, 1); PG8_SCHED; PG8_LDA(At, 1, 0); PG8_STAGE(PG8_SA(0, 1), a2 + hstep, voffA);
            PG8_WAIT_V(8); PG8_WAIT_L(0); PG8_BAR; PG8_MMA(0, 0, At, B0); PG8_MMA(0, 1, At, B1); PG8_BAR; PG8_SCHED;
            PG8_LDA(At, 1, 1); PG8_STAGE(PG8_SB(1, 0), b3, voffB); PG8_STAGE(PG8_SB(1, 1), b3 + hstep, voffB); PG8_STAGE(PG8_SA(1, 0), a3, voffA);
            PG8_WAIT_V(8); PG8_WAIT_L(0); PG8_BAR; PG8_MMA(1, 0, At, B0); PG8_MMA(1, 1, At, B1); PG8_BAR; PG8_SCHED;
            } else {
            PG8_LDB(B0, 0, 0); PG8_SCHED; PG8_LDA(At, 0, 0); PG8_STAGE(PG8_SA(1, 1), a1 + hstep, voffA);
            PG8_WAIT_L(8); PG8_BAR; PG8_WAIT_L(0); PG8_MMA(0, 0, At, B0); PG8_BAR; PG8_SCHED;
            PG8_LDB(B1, 0, 1); PG8_STAGE(PG8_SB(0, 0), b2, voffB);
            PG8_BAR; PG8_WAIT_L(0); PG8_MMA(0, 1, At, B1); PG8_BAR;
            PG8_LDA(At, 0, 1); PG8_STAGE(PG8_SA(0, 0), a2, voffA);
            PG8_BAR; PG8_WAIT_L(0); PG8_MMA(1, 0, At, B0); PG8_BAR; PG8_SCHED;
            PG8_STAGE(PG8_SB(0, 1), b2 + hstep, voffB);
            PG8_WAIT_V(6); PG8_BAR; PG8_MMA(1, 1, At, B1); PG8_BAR;
            PG8_LDB(B0, 1, 0); PG8_SCHED; PG8_LDA(At, 1, 0); PG8_STAGE(PG8_SA(0, 1), a2 + hstep, voffA);
            PG8_WAIT_L(8); PG8_BAR; PG8_WAIT_L(0); PG8_MMA(0, 0, At, B0); PG8_BAR; PG8_SCHED;
            PG8_LDB(B1, 1, 1); PG8_STAGE(PG8_SB(1, 0), b3, voffB);
            PG8_BAR; PG8_WAIT_L(0); PG8_MMA(0, 1, At, B1); PG8_BAR;
            PG8_LDA(At, 1, 1); PG8_STAGE(PG8_SA(1, 0), a3, voffA);
            PG8_BAR; PG8_WAIT_L(0); PG8_MMA(1, 0, At, B0); PG8_BAR; PG8_SCHED;
            PG8_STAGE(PG8_SB(1, 1), b3 + hstep, voffB);
            PG8_WAIT_V(6); PG8_BAR; PG8_MMA(1, 1, At, B1); PG8_BAR;
            }
        }
        if constexpr (ALIGN_EPI) { if (wr == 0) PG8_BAR; }
        if constexpr (!Epi::AFTER_DRAIN) { E(acc, cur, wr, wc, fr, fq); S.done(cur); }
        if (!has_next) break;
#pragma unroll
        for (int a = 0; a < 2; ++a)
#pragma unroll
            for (int b = 0; b < 2; ++b)
#pragma unroll
                for (int m = 0; m < 4; ++m)
#pragma unroll
                    for (int n = 0; n < 2; ++n) acc[a][b][m][n] = (f32x4){0.f, 0.f, 0.f, 0.f};
        cur = nxt; cA = nA; cB = nB; ++ui;
        if constexpr (ALIGN_EPI) { if (wr == 1) PG8_BAR; }
    }
    PG8_WAIT_V(0);
    if constexpr (!ALIGN_EPI) { if (wr == 0) PG8_BAR; }
    PG8_BAR;
    if constexpr (Epi::AFTER_DRAIN) { E.fused(acc, cur, wr, wc, fr, fq, lds, wid, lane); S.done(cur); }
#undef PG8_SA
#undef PG8_SB
#undef PG8_STAGE
#undef PG8_LDA
#undef PG8_LDB
#undef PG8_MMA
#undef PG8_WAIT_V
#undef PG8_WAIT_L
#undef PG8_BAR
#undef PG8_SCHED
}
}
#ifndef MK_N_LAUNCHES
#define MK_N_LAUNCHES 1
#endif
constexpr int NWAVES = 8, NTHREADS = 512;
constexpr int M = 16384, SEQ = 2048, D = 1024, FF = 2816, NGU = 2 * FF, NIN = 3336, NINP = 3584, PP = 3336, NLORA = 1536, KLORA = 256;
constexpr int NPHASE = 12;
constexpr size_t MiB = 1u << 20;
constexpr size_t WS_PART = 1 * MiB, WS_BONUS = 2 * MiB, WS_GC = 3 * MiB, WS_W1GU = 4 * MiB, WS_W1D = 15 * MiB, WS_WIN = 21 * MiB, WS_WOUT = 36 * MiB, WS_W2D = 38 * MiB, WS_WL = 44 * MiB;
constexpr size_t WS_CS = 4 * MiB;
constexpr size_t WS_CD = 3 * MiB + 512 * 1024;
constexpr size_t WS_XG = 48 * MiB;
constexpr size_t WS_P = 80 * MiB;
constexpr size_t WS_Y = 185 * MiB;
constexpr size_t WS_G = 217 * MiB;
constexpr size_t WS_LIN = 233 * MiB;
constexpr size_t WS_END = 249 * MiB;
constexpr int LDS_BYTES = 147456;

#define LAS __attribute__((address_space(3)))
typedef unsigned short bf16;
typedef unsigned v4u __attribute__((ext_vector_type(4)));
typedef unsigned v2u __attribute__((ext_vector_type(2)));
typedef float f32x4 __attribute__((ext_vector_type(4)));
typedef short bf16x8 __attribute__((ext_vector_type(8)));
#define LDS_WAIT() asm volatile("s_waitcnt lgkmcnt(0)" ::: "memory")
using pg8::cvt_pk_bf16;
__device__ __forceinline__ float bf_lo(unsigned u) { return __builtin_bit_cast(float, u << 16); }
__device__ __forceinline__ float bf_hi(unsigned u) { return __builtin_bit_cast(float, u & 0xffff0000u); }
__device__ __forceinline__ float bf1(bf16 s) { return __builtin_bit_cast(float, (unsigned)s << 16); }
__device__ __forceinline__ bf16 f2bf(float f) { return (bf16)(cvt_pk_bf16(f, 0.f) & 0xffffu); }
__device__ __forceinline__ f32x4 bf4(v2u u) { return (f32x4){bf_lo(u.x), bf_hi(u.x), bf_lo(u.y), bf_hi(u.y)}; }
__device__ __forceinline__ float sigm(float x) { return __builtin_amdgcn_rcpf(1.0f + __expf(-x)); }
__device__ __forceinline__ float wave_sum(float v) {
#pragma unroll
    for (int o = 1; o < 64; o <<= 1) v += __shfl_xor(v, o);
    return v;
}
template <int CTRL> __device__ __forceinline__ float dppf(float x) { return __builtin_bit_cast(float, __builtin_amdgcn_update_dpp(0, __builtin_bit_cast(int, x), CTRL, 0xf, 0xf, true)); }
__device__ __forceinline__ float allred16(float x) { x += dppf<0xB1>(x); x += dppf<0x4E>(x); x += dppf<0x124>(x); x += dppf<0x128>(x); return x; }

struct TrItem { const float* W; bf16* dst; const float* gk; int N, dpitch; };
__device__ __forceinline__ void tr_load(const TrItem& it, f32x4 (&v)[8]) {
#pragma unroll
    for (int i = 0; i < 8; ++i) { v[i] = it.N ? *(const f32x4*)(it.W + (size_t)i * it.N) : (f32x4){0.f, 0.f, 0.f, 0.f}; if (it.gk) v[i] = v[i] * it.gk[i]; }
}
__device__ __forceinline__ void tr_store(const TrItem& it, const f32x4 (&v)[8]) {
#pragma unroll
    for (int j = 0; j < 4; ++j) { v4u o; o.x = cvt_pk_bf16(v[0][j], v[1][j]); o.y = cvt_pk_bf16(v[2][j], v[3][j]); o.z = cvt_pk_bf16(v[4][j], v[5][j]); o.w = cvt_pk_bf16(v[6][j], v[7][j]);
        *(v4u*)(it.dst + (size_t)j * it.dpitch) = o; }
}
__device__ __forceinline__ TrItem tr_make(const float* W, int N, int kb, int nb, bf16* WT, int dpitch, int roff, int dk0, int mode, int up, int lane, const float* gain = nullptr) {
    const int ng = lane & 15, kg = lane >> 4, n = 64 * nb + 4 * ng, k = 32 * kb + 8 * kg;
    TrItem t; t.N = (n < N) ? N : 0; t.W = W + (size_t)k * N + n; t.dpitch = dpitch; t.gk = gain ? gain + k : nullptr;
    const int drow = mode ? (256 * (n >> 7) + 128 * up + (n & 127)) : (n + roff);
    t.dst = WT + (size_t)drow * dpitch + dk0 + k; return t;
}
constexpr int TR_I_GU = 44 * 32, TR_I_DN = 16 * 88, TR_I_IN = 56 * 32, TR_I_OUT = 16 * 32;
constexpr int TR_P0_ITEMS = 4 * TR_I_GU + TR_I_IN + TR_I_OUT + 64;
__device__ __forceinline__ TrItem p0_decode(int r, const float* const* in, unsigned char* ws, int lane) {
    bf16* W1GU = (bf16*)(ws + WS_W1GU); bf16* W1D = (bf16*)(ws + WS_W1D); bf16* WIN = (bf16*)(ws + WS_WIN); bf16* WOUT = (bf16*)(ws + WS_WOUT); bf16* W2D = (bf16*)(ws + WS_W2D); bf16* WL = (bf16*)(ws + WS_WL);
    if (r < 2 * TR_I_GU) { const int up = r >= TR_I_GU; r -= up * TR_I_GU; return tr_make(in[2 + up], FF, r / 44, r % 44, W1GU, D, 0, 0, 1, up, lane); } r -= 2 * TR_I_GU;
    if (r < TR_I_DN) return tr_make(in[4], D, r / 16, r % 16, W1D, FF, 0, 0, 0, 0, lane); r -= TR_I_DN;
    if (r < TR_I_IN) return tr_make(in[6], NIN, r / 56, r % 56, WIN, D, 0, 0, 0, 0, lane, in[5]); r -= TR_I_IN;
    if (r < TR_I_OUT) return tr_make(in[24], D, r / 16, r % 16, WOUT, D, 0, 0, 0, 0, lane); r -= TR_I_OUT;
    if (r < TR_I_DN) return tr_make(in[28], D, r / 16, r % 16, W2D, FF, 0, 0, 0, 0, lane); r -= TR_I_DN;
    if (r < 16) return tr_make(in[9], 512, r / 8, r % 8, WL, KLORA, 0, 0, 0, 0, lane); r -= 16;
    if (r < 16) return tr_make(in[11], 512, r / 8, r % 8, WL, KLORA, 512, 64, 0, 0, lane); r -= 16;
    return tr_make(in[12], 512, r / 8, r % 8, WL, KLORA, 1024, 128, 0, 0, lane);
}
__device__ __forceinline__ void p1_tail_copies(const float* const* in, unsigned char* ws, int tw, int NTW, int tthr, int NTT, int lane) {
    bf16* WL = (bf16*)(ws + WS_WL);
    for (int it = 2 * TR_I_GU + tw; it < TR_P0_ITEMS; it += 2 * NTW) {
        const TrItem a = p0_decode(it, in, ws, lane); const bool hasb = it + NTW < TR_P0_ITEMS; const TrItem b = p0_decode(hasb ? it + NTW : it, in, ws, lane);
        f32x4 va[8], vb[8]; tr_load(a, va); tr_load(b, vb); tr_store(a, va); if (hasb) tr_store(b, vb);
    }
    for (int id = tthr; id < NLORA * 32; id += NTT) { const int row = id >> 5, col = 8 * (id & 31);
        const bool nz = (row < 512) ? (col < 64) : (row < 1024 ? (col >= 64 && col < 128) : (col >= 128));
        if (!nz) *(v4u*)(WL + (size_t)row * KLORA + col) = (v4u){0u, 0u, 0u, 0u}; }
}
__device__ __forceinline__ void p0_prologue(LAS unsigned char* lds, const float* const* in, unsigned char* ws, int vcu, int G, int tid, int wave, int lane) {
    const int gw = vcu * NWAVES + wave, NGW = G * NWAVES;
    bf16* WL = (bf16*)(ws + WS_WL);
    for (int it = gw; it < 2 * TR_I_GU; it += 2 * NGW) {
        const TrItem a = p0_decode(it, in, ws, lane); const bool hasb = it + NGW < 2 * TR_I_GU; const TrItem b = p0_decode(hasb ? it + NGW : it, in, ws, lane);
        f32x4 va[8], vb[8]; tr_load(a, va); tr_load(b, vb); tr_store(a, va); if (hasb) tr_store(b, vb);
    }
    const float* x = in[0]; const float* g1 = in[1]; bf16* XG = (bf16*)(ws + WS_XG);
    f32x4 gv[4];
#pragma unroll
    for (int j = 0; j < 4; ++j) gv[j] = ((const f32x4*)g1)[64 * j + lane];
    for (int m = gw; m < M; m += 2 * NGW) {
        const int m2 = m + NGW;
        const f32x4* xa = (const f32x4*)(x + (size_t)m * D) + lane; const f32x4* xb = (const f32x4*)(x + (size_t)m2 * D) + lane; f32x4 va[4], vb[4]; float sa = 0.f, sb = 0.f;
#pragma unroll
        for (int j = 0; j < 4; ++j) { va[j] = xa[64 * j]; vb[j] = xb[64 * j]; }
#pragma unroll
        for (int j = 0; j < 4; ++j) { sa += (va[j].x * va[j].x + va[j].y * va[j].y) + (va[j].z * va[j].z + va[j].w * va[j].w); sb += (vb[j].x * vb[j].x + vb[j].y * vb[j].y) + (vb[j].z * vb[j].z + vb[j].w * vb[j].w); }
        const float ra = __builtin_amdgcn_rsqf(wave_sum(sa) * (1.f / D) + 1e-6f), rb = __builtin_amdgcn_rsqf(wave_sum(sb) * (1.f / D) + 1e-6f);
        v2u* oa = (v2u*)(XG + (size_t)m * D) + lane; v2u* ob = (v2u*)(XG + (size_t)m2 * D) + lane;
#pragma unroll
        for (int j = 0; j < 4; ++j) { const f32x4 wa = va[j] * ra * gv[j], wb = vb[j] * rb * gv[j]; v2u o; o.x = cvt_pk_bf16(wa.x, wa.y); o.y = cvt_pk_bf16(wa.z, wa.w); oa[64 * j] = o;
            v2u o2; o2.x = cvt_pk_bf16(wb.x, wb.y); o2.y = cvt_pk_bf16(wb.z, wb.w); ob[64 * j] = o2; }
    }
}
__device__ __forceinline__ void p4_lora_in(const bf16* P, const float* mu, bf16* LIN, int gtid, int NT) {
    v4u cur[4], prv[4];
#pragma unroll
    for (int k = 0; k < 4; ++k) { const int idx = gtid + k * NT; const int m = idx >> 5, cgp = idx & 31, t = m & (SEQ - 1);
        const bf16* pc = P + (size_t)m * PP + 1536 + 8 * cgp; cur[k] = *(const v4u*)pc; prv[k] = (v4u){0u, 0u, 0u, 0u}; if (t) prv[k] = *(const v4u*)(pc - PP); }
    const int cgp = gtid & 31;
    const f32x4 m0 = *(const f32x4*)(mu + 1536 + 8 * cgp), m1 = *(const f32x4*)(mu + 1540 + 8 * cgp);
#pragma unroll
    for (int k = 0; k < 4; ++k) { const int idx = gtid + k * NT; const int m = idx >> 5;
        float xv[8];
#pragma unroll
        for (int e = 0; e < 4; ++e) { const unsigned cu = cur[k][e], pu = prv[k][e]; const float c0 = bf_lo(cu), c1 = bf_hi(cu), p0 = bf_lo(pu), p1 = bf_hi(pu);
            const float mA = (e < 2) ? m0[2 * e] : m1[2 * e - 4], mB = (e < 2) ? m0[2 * e + 1] : m1[2 * e - 3];
            xv[2 * e] = c0 + (p0 - c0) * mA; xv[2 * e + 1] = c1 + (p1 - c1) * mB; }
        if (cgp < 8) {
#pragma unroll
            for (int e = 0; e < 8; ++e) xv[e] = 2.f * sigm(2.f * xv[e]) - 1.f;
        } else if (cgp >= 16) {
#pragma unroll
            for (int e = 0; e < 8; ++e) xv[e] = sigm(xv[e]);
        }
        v4u o; o.x = cvt_pk_bf16(xv[0], xv[1]); o.y = cvt_pk_bf16(xv[2], xv[3]); o.z = cvt_pk_bf16(xv[4], xv[5]); o.w = cvt_pk_bf16(xv[6], xv[7]);
        *(v4u*)(LIN + (size_t)m * KLORA + 8 * cgp) = o;
    }
}
__device__ __forceinline__ int perm_pos(int s) { return (s & 32) + (((s & 15) >> 2) << 3) + (((s >> 4) & 1) << 2) + (s & 3); }
__device__ __forceinline__ bf16x8 pack8(const f32x4 a, const f32x4 b) { v4u u; u.x = cvt_pk_bf16(a[0], a[1]); u.y = cvt_pk_bf16(a[2], a[3]); u.z = cvt_pk_bf16(b[0], b[1]); u.w = cvt_pk_bf16(b[2], b[3]); return __builtin_bit_cast(bf16x8, u); }
#define MFMA16(a, b, c) __builtin_amdgcn_mfma_f32_16x16x32_bf16((a), (b), (c), 0, 0, 0)
constexpr int RW_PITCH = 72;
struct RwIn { v4u cr, ck, cv, qr, qk, qv, ce, ca; };
__device__ __forceinline__ void rwkv_chunk_load(RwIn& I, int unit, const bf16* P, const bf16* EA, int tid) {
    const int h = unit & 7, c = (unit >> 3) & 31, b = unit >> 8; const size_t m0 = (size_t)b * SEQ + 64 * c;
    const int t = tid >> 3, jg = tid & 7, ch = 64 * h + 8 * jg;
    const bf16* pc = P + (m0 + t) * PP + ch;
    I.cr = *(const v4u*)pc; I.ck = *(const v4u*)(pc + 512); I.cv = *(const v4u*)(pc + 1024);
    I.ce = *(const v4u*)(EA + (m0 + t) * 1024 + ch); I.ca = *(const v4u*)(EA + (m0 + t) * 1024 + 512 + ch);
}
__device__ __forceinline__ void rwkv_chunk_load_prev(RwIn& I, int unit, const bf16* P, int tid) {
    const int h = unit & 7, c = (unit >> 3) & 31, b = unit >> 8; const size_t m0 = (size_t)b * SEQ + 64 * c;
    const int t = tid >> 3, jg = tid & 7, ch = 64 * h + 8 * jg;
    const bf16* pc = P + (m0 + t) * PP + ch;
    I.qr = (v4u){0u, 0u, 0u, 0u}; I.qk = I.qr; I.qv = I.qr;
    if (64 * c + t > 0) { I.qr = *(const v4u*)(pc - PP); I.qk = *(const v4u*)(pc - PP + 512); I.qv = *(const v4u*)(pc - PP + 1024); }
}
__device__ __forceinline__ void rwkv_chunk_unit(LAS unsigned char* lds, int unit, RwIn& I, int next_unit, const bf16* P, bf16* EA, bf16* Y, float* BON, float* GCg, unsigned* SLg,
                                                int tid, int wave, int lane, bool st = true, int stop = 0) {
    const int h = unit & 7, c = (unit >> 3) & 31, b = unit >> 8;
    const size_t m0 = (size_t)b * SEQ + 64 * c;
    LAS bf16* At = (LAS bf16*)(lds); LAS bf16* Rt = (LAS bf16*)(lds + 9216); LAS bf16* Bm = (LAS bf16*)(lds + 18432); LAS bf16* Km = (LAS bf16*)(lds + 27648);
    LAS bf16* BmT = (LAS bf16*)(lds + 36864); LAS bf16* KmT = (LAS bf16*)(lds + 46080); LAS bf16* VT = (LAS bf16*)(lds + 55296);
    LAS bf16* AabT = (LAS bf16*)(lds + 64512); LAS bf16* AkbT = (LAS bf16*)(lds + 73728); LAS bf16* AbrT = (LAS bf16*)(lds + 82944); LAS bf16* AkrT = (LAS bf16*)(lds + 92160);
    LAS float* AD = (LAS float*)(lds + 101376); LAS bf16* TdA = (LAS bf16*)(lds + 105472); LAS float* GC = (LAS float*)(lds + 109568); LAS float* WT = (LAS float*)(lds + 109824);
    const LAS float* PRM = (const LAS float*)(lds + 143872);
    const int r = lane & 15, q = lane >> 4;
    {
        const int t = tid >> 3, jg = tid & 7;
        rwkv_chunk_load_prev(I, unit, P, tid);
        const v4u cr = I.cr, ck = I.ck, cv = I.cv, qr = I.qr, qk = I.qk, qv = I.qv, ce = I.ce, ca = I.ca;
        float rr[8], kx[8], vv[8], ee[8], aa[8], kk[8], km[8], bv[8], E[8];
        float ss = 0.f, bon = 0.f;
#pragma unroll
        for (int x = 0; x < 8; ++x) {
            const unsigned ur = cr[x >> 1], uk = ck[x >> 1], uv = cv[x >> 1], pr = qr[x >> 1], pk = qk[x >> 1], pv = qv[x >> 1], ue = ce[x >> 1], ua = ca[x >> 1];
            const float r0 = (x & 1) ? bf_hi(ur) : bf_lo(ur), k0 = (x & 1) ? bf_hi(uk) : bf_lo(uk), v0 = (x & 1) ? bf_hi(uv) : bf_lo(uv);
            const float r1 = (x & 1) ? bf_hi(pr) : bf_lo(pr), k1 = (x & 1) ? bf_hi(pk) : bf_lo(pk), v1 = (x & 1) ? bf_hi(pv) : bf_lo(pv);
            const LAS float* pj = PRM + 8 * jg + x;
            const float ep = ((x & 1) ? bf_hi(ue) : bf_lo(ue)) + pj[384], ap = ((x & 1) ? bf_hi(ua) : bf_lo(ua)) + pj[448];
            rr[x] = r0 + (r1 - r0) * pj[0]; kx[x] = k0 + (k1 - k0) * pj[64]; vv[x] = v0 + (v1 - v0) * pj[128];
            ee[x] = 0.60653066f * sigm(ep); aa[x] = sigm(ap);
            kk[x] = kx[x] * pj[192]; ss += kk[x] * kk[x];
            km[x] = kx[x] * (1.0f + (aa[x] - 1.0f) * pj[256]);
            bon += rr[x] * km[x] * pj[320];
            E[x] = ee[x];
        }
        ss += __shfl_xor(ss, 1); ss += __shfl_xor(ss, 2); ss += __shfl_xor(ss, 4);
        bon += __shfl_xor(bon, 1); bon += __shfl_xor(bon, 2); bon += __shfl_xor(bon, 4);
        if (jg == 0 && st) BON[(m0 + t) * 8 + h] = bon;
        const float inv = 1.0f / fmaxf(sqrtf(ss), 1e-12f);
#pragma unroll
        for (int x = 0; x < 8; ++x) { kk[x] *= inv; bv[x] = kk[x] * aa[x]; }
#pragma unroll
        for (int off = 8; off < 64; off <<= 1)
#pragma unroll
            for (int x = 0; x < 8; ++x) { const float tv = __shfl_up(E[x], off); if (lane >= off) E[x] += tv; }
        if ((lane >> 3) == 7) {
#pragma unroll
            for (int x = 0; x < 8; ++x) WT[wave * 64 + 8 * jg + x] = E[x];
        }
        __syncthreads();
        for (int w2 = 0; w2 < wave; ++w2)
#pragma unroll
            for (int x = 0; x < 8; ++x) E[x] += WT[w2 * 64 + 8 * jg + x];
        float av[8], rv[8], bt[8], kt[8];
#pragma unroll
        for (int x = 0; x < 8; ++x) { const float gi = __expf(-E[x]), ge = __expf(-(E[x] - ee[x])), gp = __expf(E[x]);
            av[x] = -kk[x] * ge; rv[x] = rr[x] * gi; bt[x] = bv[x] * gp; kt[x] = km[x] * gp;
            if (t == 63) { GC[8 * jg + x] = gi; if (st) GCg[(size_t)unit * 64 + 8 * jg + x] = gi; } }
#define PK8(a_) (v4u){cvt_pk_bf16(a_[0], a_[1]), cvt_pk_bf16(a_[2], a_[3]), cvt_pk_bf16(a_[4], a_[5]), cvt_pk_bf16(a_[6], a_[7])}
        *(LAS v4u*)(At + t * RW_PITCH + 8 * jg) = PK8(av); *(LAS v4u*)(Rt + t * RW_PITCH + 8 * jg) = PK8(rv);
        *(LAS v4u*)(Bm + t * RW_PITCH + 8 * jg) = PK8(bt); *(LAS v4u*)(Km + t * RW_PITCH + 8 * jg) = PK8(kt);
#undef PK8
#pragma unroll
        for (int x = 0; x < 8; ++x) { BmT[(8 * jg + x) * RW_PITCH + perm_pos(t)] = f2bf(bt[x]); KmT[(8 * jg + x) * RW_PITCH + t] = f2bf(kt[x]); VT[(8 * jg + x) * RW_PITCH + t] = f2bf(vv[x]); }
    }
    if (next_unit >= 0) rwkv_chunk_load(I, next_unit, P, EA, tid);
    __syncthreads();
    if (stop == 1) return;
    {
        const int mat = wave >> 1; const LAS bf16* Atile = mat < 2 ? At : Rt; const LAS bf16* Btile = (mat & 1) ? Km : Bm;
        LAS bf16* dst = mat == 0 ? AabT : (mat == 1 ? AkbT : (mat == 2 ? AbrT : AkrT));
        const bool strict = mat < 2, perm = (mat & 1) == 0;
#pragma unroll
        for (int tbi = 0; tbi < 2; ++tbi) { const int tb = 2 * (wave & 1) + tbi;
            const bf16x8 a0 = *(const LAS bf16x8*)(Atile + (16 * tb + r) * RW_PITCH + 8 * q), a1 = *(const LAS bf16x8*)(Atile + (16 * tb + r) * RW_PITCH + 32 + 8 * q);
#pragma unroll
            for (int sb = 0; sb < 4; ++sb) {
                f32x4 acc = (f32x4){0.f, 0.f, 0.f, 0.f};
                if (sb <= tb) { acc = MFMA16(a0, *(const LAS bf16x8*)(Btile + (16 * sb + r) * RW_PITCH + 8 * q), acc); acc = MFMA16(a1, *(const LAS bf16x8*)(Btile + (16 * sb + r) * RW_PITCH + 32 + 8 * q), acc); }
                const int sx = 16 * sb + r, pos = perm ? perm_pos(sx) : sx;
#pragma unroll
                for (int jj = 0; jj < 4; ++jj) { const int tx = 16 * tb + 4 * q + jj; const bool keep = (sb <= tb) && (strict ? sx < tx : sx <= tx); const float v = keep ? acc[jj] : 0.f;
                    dst[tx * RW_PITCH + pos] = f2bf(v);
                    if (mat == 0 && sb == tb) AD[tb * 256 + (4 * q + jj) * 16 + r] = v; }
            }
        }
    }
    __syncthreads();
    if (stop == 2) return;
    if (wave < 4) {
        const LAS float* ad = AD + wave * 256; float X[16];
#pragma unroll
        for (int sx = 15; sx >= 0; --sx) { float x = (sx == r) ? 1.f : 0.f;
#pragma unroll
            for (int k = sx + 1; k < 16; ++k) x += ad[k * 16 + sx] * X[k];
            X[sx] = x; }
        LAS bf16* td = TdA + wave * 512 + r * 32;
        if (q == 0) {
#pragma unroll
            for (int kg = 0; kg < 4; ++kg) { v4u o; o.x = cvt_pk_bf16(X[4 * kg], X[4 * kg + 1]); o.y = cvt_pk_bf16(X[4 * kg + 2], X[4 * kg + 3]); o.z = 0u; o.w = 0u; *(LAS v4u*)(td + 8 * kg) = o; }
        }
    }
    f32x4 z[4], qy[4], gs[4];
    const bool vpart = wave >= 4; const int cb = wave & 3;
    if (vpart) {
        const bf16x8 v0 = *(const LAS bf16x8*)(VT + (16 * cb + r) * RW_PITCH + 8 * q), v1 = *(const LAS bf16x8*)(VT + (16 * cb + r) * RW_PITCH + 32 + 8 * q);
#pragma unroll
        for (int tb = 0; tb < 4; ++tb) { const int ro = (16 * tb + r) * RW_PITCH + 8 * q;
            f32x4 acc = (f32x4){0.f, 0.f, 0.f, 0.f}; acc = MFMA16(*(const LAS bf16x8*)(AkbT + ro), v0, acc); acc = MFMA16(*(const LAS bf16x8*)(AkbT + ro + 32), v1, acc); z[tb] = acc;
            acc = (f32x4){0.f, 0.f, 0.f, 0.f}; acc = MFMA16(*(const LAS bf16x8*)(AkrT + ro), v0, acc); acc = MFMA16(*(const LAS bf16x8*)(AkrT + ro + 32), v1, acc); qy[tb] = acc;
            acc = (f32x4){0.f, 0.f, 0.f, 0.f}; acc = MFMA16(*(const LAS bf16x8*)(KmT + ro), v0, acc); acc = MFMA16(*(const LAS bf16x8*)(KmT + ro + 32), v1, acc); gs[tb] = acc; }
    } else {
#pragma unroll
        for (int tb = 0; tb < 4; ++tb)
#pragma unroll
            for (int jj = 0; jj < 4; ++jj) { const int tx = 16 * tb + 4 * q + jj; z[tb][jj] = bf1(At[tx * RW_PITCH + 16 * cb + r]); qy[tb][jj] = bf1(Rt[tx * RW_PITCH + 16 * cb + r]); gs[tb][jj] = 0.f; }
    }
    __syncthreads();
    if (stop == 3) return;
    const f32x4 zero4 = (f32x4){0.f, 0.f, 0.f, 0.f};
#pragma unroll
    for (int tb = 0; tb < 4; ++tb) {
        f32x4 rhs = z[tb];
        if (tb >= 1) rhs = MFMA16(*(const LAS bf16x8*)(AabT + (16 * tb + r) * RW_PITCH + 8 * q), pack8(z[0], tb >= 2 ? z[1] : zero4), rhs);
        if (tb >= 3) rhs = MFMA16(*(const LAS bf16x8*)(AabT + (16 * tb + r) * RW_PITCH + 32 + 8 * q), pack8(z[2], zero4), rhs);
        z[tb] = MFMA16(*(const LAS bf16x8*)(TdA + tb * 512 + r * 32 + 8 * q), pack8(rhs, zero4), zero4);
    }
    const bf16x8 zb0 = pack8(z[0], z[1]), zb1 = pack8(z[2], z[3]);
#pragma unroll
    for (int tb = 0; tb < 4; ++tb) { const int ro = (16 * tb + r) * RW_PITCH + 8 * q;
        qy[tb] = MFMA16(*(const LAS bf16x8*)(AbrT + ro), zb0, qy[tb]); qy[tb] = MFMA16(*(const LAS bf16x8*)(AbrT + ro + 32), zb1, qy[tb]);
        gs[tb] = MFMA16(*(const LAS bf16x8*)(BmT + ro), zb0, gs[tb]); gs[tb] = MFMA16(*(const LAS bf16x8*)(BmT + ro + 32), zb1, gs[tb]);
#pragma unroll
        for (int jj = 0; jj < 4; ++jj) gs[tb][jj] *= GC[16 * tb + 4 * q + jj]; }
    LAS bf16* QTs = At; LAS bf16* GTs = Rt; LAS bf16* YLs = Bm;
    if (vpart) {
#pragma unroll
        for (int tb = 0; tb < 4; ++tb) {
#pragma unroll
            for (int jj = 0; jj < 4; ++jj) YLs[(16 * tb + 4 * q + jj) * RW_PITCH + 16 * cb + r] = f2bf(qy[tb][jj]);
            v2u o; o.x = cvt_pk_bf16(gs[tb][0], gs[tb][1]); o.y = cvt_pk_bf16(gs[tb][2], gs[tb][3]);
            if (st) *(v2u*)(SLg + ((((size_t)unit * 4 + cb) * 4 + tb) * 64 + lane) * 2) = o; }
    } else {
        const int pj = perm_pos(16 * cb + r);
#pragma unroll
        for (int tb = 0; tb < 4; ++tb)
#pragma unroll
            for (int jj = 0; jj < 4; ++jj) { const int rw = (16 * tb + 4 * q + jj) * RW_PITCH + pj; QTs[rw] = f2bf(qy[tb][jj]); GTs[rw] = f2bf(gs[tb][jj]); }
    }
    __syncthreads();
    if (st) { const int row = tid >> 3, sg = 8 * (tid & 7); const size_t ro = (m0 + row) * 1024 + 64 * h + sg;
        *(v4u*)(EA + ro + 512) = *(const LAS v4u*)(QTs + row * RW_PITCH + sg); *(v4u*)(EA + ro) = *(const LAS v4u*)(GTs + row * RW_PITCH + sg); *(v4u*)(Y + ro) = *(const LAS v4u*)(YLs + row * RW_PITCH + sg); }
    __syncthreads();
}
struct SeqS { bf16x8 ga[2][2]; v2u sl[2]; f32x4 gc[2]; };
struct SeqY { bf16x8 qa[2][2]; bf16 yl[2][4]; };
#define SEQS_LOAD(S_, c_, HF_) do { const int cc_ = (c_) < 32 ? (c_) : 31; const int unit_ = (b * 32 + cc_) * 8 + h; const size_t mm_ = (size_t)b * SEQ + 64 * cc_; \
    _Pragma("unroll") for (int t2 = 0; t2 < 2; ++t2) { const int tb = 2 * (HF_) + t2; \
        const bf16* grow_ = EA + (mm_ + 16 * tb + r) * 1024 + 64 * h + 8 * q; S_.ga[t2][0] = *(const bf16x8*)grow_; S_.ga[t2][1] = *(const bf16x8*)(grow_ + 32); \
        S_.sl[t2] = *(const v2u*)(SLg + ((((size_t)unit_ * 4 + ib) * 4 + tb) * 64 + lane) * 2); \
        S_.gc[t2] = *(const f32x4*)(GCg + (size_t)unit_ * 64 + 16 * tb + 4 * q); } } while (0)
#define SEQS_COMP(S_, HF_) do { \
    _Pragma("unroll") for (int t2 = 0; t2 < 2; ++t2) { const int tb = 2 * (HF_) + t2; \
        f32x4 sv = bf4(S_.sl[t2]) + S_.gc[t2] * sT[tb]; \
        sv = MFMA16(S_.ga[t2][0], bh0, sv); sv = MFMA16(S_.ga[t2][1], bh1, sv); sv = MFMA16(S_.ga[t2][0], bl0, sv); sv = MFMA16(S_.ga[t2][1], bl1, sv); \
        sT[tb] = sv; } } while (0)
#define SEQS_SPLIT(c_) do { f32x4 hi[4], lo[4]; \
    _Pragma("unroll") for (int jb = 0; jb < 4; ++jb) _Pragma("unroll") for (int jj = 0; jj < 4; ++jj) { const float hv = bf1(f2bf(sT[jb][jj])); hi[jb][jj] = hv; lo[jb][jj] = sT[jb][jj] - hv; } \
    bh0 = pack8(hi[0], hi[1]); bh1 = pack8(hi[2], hi[3]); bl0 = pack8(lo[0], lo[1]); bl1 = pack8(lo[2], lo[3]); \
    LAS bf16x8* slot_ = (LAS bf16x8*)(lds + (c_) * 4096) + lane; slot_[0] = bh0; slot_[64] = bh1; slot_[128] = bl0; slot_[192] = bl1; \
    asm volatile("s_waitcnt lgkmcnt(0)" ::: "memory"); *prog = (unsigned)(c_) + 1u; } while (0)
#define SEQY_LOAD(S_, c_, HF_) do { const int cc_ = (c_) < 32 ? (c_) : 31; const size_t mm_ = (size_t)b * SEQ + 64 * cc_; \
    _Pragma("unroll") for (int t2 = 0; t2 < 2; ++t2) { const int tb = 2 * (HF_) + t2; \
        const bf16* qrow_ = EA + (mm_ + 16 * tb + r) * 1024 + 512 + 64 * h + 8 * q; S_.qa[t2][0] = *(const bf16x8*)qrow_; S_.qa[t2][1] = *(const bf16x8*)(qrow_ + 32); \
        _Pragma("unroll") for (int jj = 0; jj < 4; ++jj) S_.yl[t2][jj] = Y[(mm_ + 16 * tb + 4 * q + jj) * 1024 + 64 * h + 16 * ib + r]; } } while (0)
#define SEQY_WAIT(c_) do { unsigned sp_ = 0; while (*prog < (unsigned)(c_) + 1u) { __builtin_amdgcn_s_sleep(1); if (++sp_ > (1u << 24)) break; } \
    asm volatile("" ::: "memory"); \
    const LAS bf16x8* slot_ = (const LAS bf16x8*)(lds + (c_) * 4096) + lane; bh0 = slot_[0]; bh1 = slot_[64]; bl0 = slot_[128]; bl1 = slot_[192]; } while (0)
#define SEQY_COMP(S_, c_, HF_) do { const size_t m0 = (size_t)b * SEQ + 64 * (c_); \
    _Pragma("unroll") for (int t2 = 0; t2 < 2; ++t2) { const int tb = 2 * (HF_) + t2; \
        f32x4 y; _Pragma("unroll") for (int jj = 0; jj < 4; ++jj) y[jj] = bf1(S_.yl[t2][jj]); \
        y = MFMA16(S_.qa[t2][0], bh0, y); y = MFMA16(S_.qa[t2][1], bh1, y); y = MFMA16(S_.qa[t2][0], bl0, y); y = MFMA16(S_.qa[t2][1], bl1, y); \
        if (st) { _Pragma("unroll") for (int jj = 0; jj < 4; ++jj) Y[(m0 + 16 * tb + 4 * q + jj) * 1024 + 64 * h + 16 * ib + r] = f2bf(y[jj]); } } } while (0)
__device__ __forceinline__ void rwkv_seq_state(LAS unsigned char* lds, volatile LAS unsigned* prog, int job, const bf16* EA, const float* GCg, const unsigned* SLg, int lane) {
    const int ib = job & 3, h = (job >> 2) & 7, b = job >> 5; const int r = lane & 15, q = lane >> 4;
    f32x4 sT[4];
#pragma unroll
    for (int jb = 0; jb < 4; ++jb) sT[jb] = (f32x4){0.f, 0.f, 0.f, 0.f};
    bf16x8 bh0, bh1, bl0, bl1;
    SeqS B0, B1, B2, B3;
    SEQS_LOAD(B0, 0, 0); SEQS_LOAD(B1, 0, 1); SEQS_LOAD(B2, 1, 0);
    for (int c = 0; c < 32; c += 2) {
        SEQS_LOAD(B3, c + 1, 1); SEQS_SPLIT(c); SEQS_COMP(B0, 0);
        SEQS_LOAD(B0, c + 2, 0); SEQS_COMP(B1, 1);
        SEQS_LOAD(B1, c + 2, 1); SEQS_SPLIT(c + 1); SEQS_COMP(B2, 0);
        SEQS_LOAD(B2, c + 3, 0); SEQS_COMP(B3, 1);
    }
}
__device__ __forceinline__ void rwkv_seq_out(LAS unsigned char* lds, volatile LAS unsigned* prog, int job, const bf16* EA, bf16* Y, int lane, bool st) {
    const int ib = job & 3, h = (job >> 2) & 7, b = job >> 5; const int r = lane & 15, q = lane >> 4;
    bf16x8 bh0, bh1, bl0, bl1;
    SeqY B0, B1, B2, B3;
    SEQY_LOAD(B0, 0, 0); SEQY_LOAD(B1, 0, 1); SEQY_LOAD(B2, 1, 0);
    for (int c = 0; c < 32; c += 2) {
        SEQY_LOAD(B3, c + 1, 1); SEQY_WAIT(c); SEQY_COMP(B0, c, 0);
        SEQY_LOAD(B0, c + 2, 0); SEQY_COMP(B1, c, 1);
        SEQY_LOAD(B1, c + 2, 1); SEQY_WAIT(c + 1); SEQY_COMP(B2, c + 1, 0);
        SEQY_LOAD(B2, c + 3, 0); SEQY_COMP(B3, c + 1, 1);
    }
}
#undef SEQS_LOAD
#undef SEQS_COMP
#undef SEQS_SPLIT
#undef SEQY_LOAD
#undef SEQY_WAIT
#undef SEQY_COMP
__device__ __forceinline__ void ssd_chunk_group(LAS unsigned char* lds, int unit, const bf16* P, bf16* Y, bf16* CS, float* CD, const float* dt_bias, const float* a_log, const float* d_skip, int tid, int wave, int lane) {
    const int g = unit & 1, c = (unit >> 1) & 31, b = unit >> 6;
    LAS bf16* Cn = (LAS bf16*)(lds); LAS bf16* Bn = (LAS bf16*)(lds + 17408); LAS bf16* BT = (LAS bf16*)(lds + 34816); LAS bf16* RAWX = (LAS bf16*)(lds + 53248);
    LAS unsigned char* U = lds + 88640;
    LAS bf16* RAWBC = (LAS bf16*)U; LAS bf16* XT = (LAS bf16*)U; LAS bf16* XdT = (LAS bf16*)(U + 9216); LAS bf16* Xr = (LAS bf16*)(U + 18432); LAS bf16* Ms = (LAS bf16*)(U + 26624);
    LAS float* ACS4 = (LAS float*)(lds + 124480); const LAS float* CW = (const LAS float*)(lds + 133632);
    const int r = lane & 15, q = lane >> 4;
    const size_t m0 = (size_t)b * SEQ + 64 * c;
    {
        const int chb = lane < 16 ? 2816 + 128 * g + 8 * lane : (lane < 32 ? 3072 + 128 * g + 8 * (lane - 16) : 2304 + 256 * g + 8 * (lane - 32));
        const bf16* pbase = P + m0 * PP + chb;
        v4u rv[9];
#pragma unroll
        for (int i = 0; i < 9; ++i) { const int rr = wave + 8 * i; rv[i] = (v4u){0u, 0u, 0u, 0u}; if (rr < 67 && 64 * c + rr - 3 >= 0) rv[i] = *(const v4u*)(pbase + (ptrdiff_t)(rr - 3) * PP); }
        LAS bf16* dstb = lane < 32 ? RAWBC + 8 * lane : RAWX + 8 * (lane - 32);
#pragma unroll
        for (int i = 0; i < 9; ++i) { const int rr = wave + 8 * i; if (rr < 67) *(LAS v4u*)(dstb + rr * 264) = rv[i]; }
    }
    float dt[4], dd[4], aend[4];
#pragma unroll
    for (int hh = 0; hh < 4; ++hh) { const int h = 4 * g + hh;
        const float xdt = bf1(P[(m0 + lane) * PP + 3328 + h]) + dt_bias[h]; dt[hh] = xdt > 20.f ? xdt : log1pf(__expf(xdt));
        float acs = dt[hh] * (-__expf(a_log[h]));
#pragma unroll
        for (int o = 1; o < 64; o <<= 1) { const float t = __shfl_up(acs, o); if (lane >= o) acs += t; }
        aend[hh] = __shfl(acs, 63);
        if (wave == 0) ACS4[hh * 64 + lane] = acs;
        dd[hh] = dt[hh] * __expf(aend[hh] - acs); }
    __syncthreads();
#pragma unroll
    for (int i = 0; i < 4; ++i) { const int cgp = wave + 8 * i;
        const LAS float* cwl = CW + cgp * 40;
        float o8[8];
        { const f32x4 b0 = *(const LAS f32x4*)(cwl + 32), b1 = *(const LAS f32x4*)(cwl + 36);
#pragma unroll
          for (int e = 0; e < 4; ++e) { o8[e] = b0[e]; o8[4 + e] = b1[e]; } }
#pragma unroll
        for (int k = 0; k < 4; ++k) { const v4u iv = *(const LAS v4u*)(RAWBC + (lane + k) * 264 + 8 * cgp);
            const f32x4 w0v = *(const LAS f32x4*)(cwl + 8 * k), w1v = *(const LAS f32x4*)(cwl + 8 * k + 4);
            o8[0] += w0v[0] * bf_lo(iv[0]); o8[1] += w0v[1] * bf_hi(iv[0]); o8[2] += w0v[2] * bf_lo(iv[1]); o8[3] += w0v[3] * bf_hi(iv[1]);
            o8[4] += w1v[0] * bf_lo(iv[2]); o8[5] += w1v[1] * bf_hi(iv[2]); o8[6] += w1v[2] * bf_lo(iv[3]); o8[7] += w1v[3] * bf_hi(iv[3]); }
#pragma unroll
        for (int e = 0; e < 8; ++e) o8[e] = o8[e] * sigm(o8[e]);
        v4u o; o.x = cvt_pk_bf16(o8[0], o8[1]); o.y = cvt_pk_bf16(o8[2], o8[3]); o.z = cvt_pk_bf16(o8[4], o8[5]); o.w = cvt_pk_bf16(o8[6], o8[7]);
        if (cgp < 16) { const int n = 8 * cgp; *(LAS v4u*)(Bn + lane * 136 + n) = o;
#pragma unroll
            for (int e = 0; e < 8; ++e) BT[(n + e) * 72 + lane] = f2bf(o8[e]);
        } else { const int n = 8 * (cgp - 16); *(LAS v4u*)(Cn + lane * 136 + n) = o; }
    }
    __syncthreads();
    f32x4 sc[2];
    {
        const int lb = wave >> 1;
#pragma unroll
        for (int sbi = 0; sbi < 2; ++sbi) { const int sb = 2 * (wave & 1) + sbi; sc[sbi] = (f32x4){0.f, 0.f, 0.f, 0.f};
            if (sb <= lb) {
#pragma unroll
                for (int kk = 0; kk < 4; ++kk) sc[sbi] = MFMA16(*(const LAS bf16x8*)(Cn + (16 * lb + r) * 136 + 32 * kk + 8 * q), *(const LAS bf16x8*)(Bn + (16 * sb + r) * 136 + 32 * kk + 8 * q), sc[sbi]);
            } }
    }
#pragma unroll
    for (int hh = 0; hh < 4; ++hh) { const int h = 4 * g + hh; const int unit_h = (b * 32 + c) * 8 + h;
        {
            const int cgx = 8 * hh + wave; const LAS float* cwl = CW + (32 + cgx) * 40;
            float o8[8];
            { const f32x4 b0 = *(const LAS f32x4*)(cwl + 32), b1 = *(const LAS f32x4*)(cwl + 36);
#pragma unroll
              for (int e = 0; e < 4; ++e) { o8[e] = b0[e]; o8[4 + e] = b1[e]; } }
#pragma unroll
            for (int k = 0; k < 4; ++k) { const v4u iv = *(const LAS v4u*)(RAWX + (lane + k) * 264 + 8 * cgx);
                const f32x4 w0v = *(const LAS f32x4*)(cwl + 8 * k), w1v = *(const LAS f32x4*)(cwl + 8 * k + 4);
                o8[0] += w0v[0] * bf_lo(iv[0]); o8[1] += w0v[1] * bf_hi(iv[0]); o8[2] += w0v[2] * bf_lo(iv[1]); o8[3] += w0v[3] * bf_hi(iv[1]);
                o8[4] += w1v[0] * bf_lo(iv[2]); o8[5] += w1v[1] * bf_hi(iv[2]); o8[6] += w1v[2] * bf_lo(iv[3]); o8[7] += w1v[3] * bf_hi(iv[3]); }
#pragma unroll
            for (int e = 0; e < 8; ++e) o8[e] = o8[e] * sigm(o8[e]);
            v4u o; o.x = cvt_pk_bf16(o8[0], o8[1]); o.y = cvt_pk_bf16(o8[2], o8[3]); o.z = cvt_pk_bf16(o8[4], o8[5]); o.w = cvt_pk_bf16(o8[6], o8[7]);
#pragma unroll
            for (int e = 0; e < 8; ++e) { XT[(8 * wave + e) * 72 + lane] = f2bf(o8[e] * dt[hh]); XdT[(8 * wave + e) * 72 + lane] = f2bf(o8[e] * dd[hh]); }
            *(LAS v4u*)(Xr + lane * 64 + 8 * wave) = o;
        }
        {
            const int lb = wave >> 1; const LAS float* acsh = ACS4 + hh * 64;
#pragma unroll
            for (int sbi = 0; sbi < 2; ++sbi) { const int sb = 2 * (wave & 1) + sbi; const int sx = 16 * sb + r; const float as = acsh[sx];
#pragma unroll
                for (int j = 0; j < 4; ++j) { const int l = 16 * lb + 4 * q + j; const float v = (l >= sx && sb <= lb) ? sc[sbi][j] * __expf(acsh[l] - as) : 0.f; Ms[l * 72 + sx] = f2bf(v); } }
        }
        __syncthreads();
        {
            const int lb = wave >> 1, l = 16 * lb + r; const float dsk = d_skip[h];
            const bf16x8 m0v = *(const LAS bf16x8*)(Ms + l * 72 + 8 * q), m1v = *(const LAS bf16x8*)(Ms + l * 72 + 32 + 8 * q);
#pragma unroll
            for (int pbi = 0; pbi < 2; ++pbi) { const int pb = 2 * (wave & 1) + pbi;
                f32x4 acc = (f32x4){0.f, 0.f, 0.f, 0.f};
                acc = MFMA16(*(const LAS bf16x8*)(XT + (16 * pb + r) * 72 + 8 * q), m0v, acc); acc = MFMA16(*(const LAS bf16x8*)(XT + (16 * pb + r) * 72 + 32 + 8 * q), m1v, acc);
                const int p0 = 16 * pb + 4 * q; const f32x4 xv = bf4(*(const LAS v2u*)(Xr + l * 64 + p0));
                v2u o; o.x = cvt_pk_bf16(acc[0] + dsk * xv[0], acc[1] + dsk * xv[1]); o.y = cvt_pk_bf16(acc[2] + dsk * xv[2], acc[3] + dsk * xv[3]);
                *(v2u*)(Y + (m0 + l) * 1024 + 512 + 64 * h + p0) = o;
            }
            const int pb = wave & 3;
            const bf16x8 x0 = *(const LAS bf16x8*)(XdT + (16 * pb + r) * 72 + 8 * q), x1 = *(const LAS bf16x8*)(XdT + (16 * pb + r) * 72 + 32 + 8 * q);
            bf16* cs = CS + (size_t)unit_h * 8192 + (16 * pb + r) * 128;
#pragma unroll
            for (int i = 0; i < 4; ++i) { const int nb = 4 * (wave >> 2) + i;
                f32x4 acc = (f32x4){0.f, 0.f, 0.f, 0.f};
                acc = MFMA16(*(const LAS bf16x8*)(BT + (16 * nb + r) * 72 + 8 * q), x0, acc); acc = MFMA16(*(const LAS bf16x8*)(BT + (16 * nb + r) * 72 + 32 + 8 * q), x1, acc);
                v2u o; o.x = cvt_pk_bf16(acc[0], acc[1]); o.y = cvt_pk_bf16(acc[2], acc[3]);
                *(v2u*)(cs + 16 * nb + 4 * q) = o;
            }
            if (tid == 0) CD[unit_h] = __expf(aend[hh]);
        }
        __syncthreads();
    }
}
__device__ __forceinline__ void ssd_scan_item(int item, bf16* CS, const float* CD, bool dost) {
    const int bh = item >> 10, e8 = (item & 1023) * 8, b = bh >> 3, h = bh & 7;
    float st[8];
#pragma unroll
    for (int e = 0; e < 8; ++e) st[e] = 0.f;
    for (int cb = 0; cb < 2; ++cb) {
        v4u v[16]; float d[16];
#pragma unroll
        for (int k = 0; k < 16; ++k) { const int unit = (b * 32 + 16 * cb + k) * 8 + h; v[k] = *(const v4u*)(CS + (size_t)unit * 8192 + e8); d[k] = CD[unit]; }
#pragma unroll
        for (int k = 0; k < 16; ++k) { const int unit = (b * 32 + 16 * cb + k) * 8 + h;
            v4u o; o.x = cvt_pk_bf16(st[0], st[1]); o.y = cvt_pk_bf16(st[2], st[3]); o.z = cvt_pk_bf16(st[4], st[5]); o.w = cvt_pk_bf16(st[6], st[7]);
            if (dost) *(v4u*)(CS + (size_t)unit * 8192 + e8) = o;
#pragma unroll
            for (int e = 0; e < 4; ++e) { st[2 * e] = st[2 * e] * d[k] + bf_lo(v[k][e]); st[2 * e + 1] = st[2 * e + 1] * d[k] + bf_hi(v[k][e]); } }
    }
}
__device__ __forceinline__ void mix_out_unit(LAS unsigned char* lds, int unit, const bf16* P, const bf16* G, const float* BON, bf16* Y, const bf16* CS, const float* mu, const float* gn_g, const float* gn_b,
                                             const float* ssm_norm, const float* conv_w, const float* conv_b, const float* dt_bias, const float* a_log, int tid, int wave, int lane, bool st = true) {
    const int c = unit & 31, b = unit >> 5, h = wave, g = h >> 2;
    LAS bf16* Cn2 = (LAS bf16*)(lds); LAS float* ACS8 = (LAS float*)(lds + 34816); LAS float* SS8 = (LAS float*)(lds + 36864);
    const int r = lane & 15, q = lane >> 4;
    const size_t m0 = (size_t)b * SEQ + 64 * c; const bf16* prow = P + (m0 + lane) * PP;
    {
        const float xdt = bf1(prow[3328 + h]) + dt_bias[h]; const float dt = xdt > 20.f ? xdt : log1pf(__expf(xdt));
        float acs = dt * (-__expf(a_log[h]));
#pragma unroll
        for (int o = 1; o < 64; o <<= 1) { const float t = __shfl_up(acs, o); if (lane >= o) acs += t; }
        ACS8[h * 64 + lane] = acs;
    }
    {
        const int cl = lane & 31, chb = 3072 + 8 * cl, cw = chb - 2304;
        const bf16* pbase = P + (m0 + 8 * wave) * PP + chb;
        v4u win[11];
#pragma unroll
        for (int k = 0; k < 11; ++k) { win[k] = (v4u){0u, 0u, 0u, 0u}; if (64 * c + 8 * wave + k - 3 >= 0) win[k] = *(const v4u*)(pbase + (ptrdiff_t)(k - 3) * PP); }
        float cwv[4][8], cbv[8];
#pragma unroll
        for (int e = 0; e < 8; ++e) { cbv[e] = conv_b[cw + e];
#pragma unroll
            for (int k = 0; k < 4; ++k) cwv[k][e] = conv_w[k * 1024 + cw + e]; }
#pragma unroll
        for (int tl = 0; tl < 8; ++tl) { const int t = 8 * wave + tl;
            float o8[8];
#pragma unroll
            for (int e = 0; e < 8; ++e) o8[e] = cbv[e];
#pragma unroll
            for (int k = 0; k < 4; ++k) { const v4u iv = win[tl + k];
#pragma unroll
                for (int e = 0; e < 4; ++e) { o8[2 * e] += cwv[k][2 * e] * bf_lo(iv[e]); o8[2 * e + 1] += cwv[k][2 * e + 1] * bf_hi(iv[e]); } }
#pragma unroll
            for (int e = 0; e < 8; ++e) o8[e] = o8[e] * sigm(o8[e]);
            v4u o; o.x = cvt_pk_bf16(o8[0], o8[1]); o.y = cvt_pk_bf16(o8[2], o8[3]); o.z = cvt_pk_bf16(o8[4], o8[5]); o.w = cvt_pk_bf16(o8[6], o8[7]);
            if (lane < 32) *(LAS v4u*)(Cn2 + (cl >> 4) * 8704 + t * 136 + 8 * (cl & 15)) = o;
        }
    }
    __syncthreads();
    float ssl[4];
    {
        const bf16* cs = CS + (size_t)((b * 32 + c) * 8 + h) * 8192; const LAS bf16* Cg = Cn2 + g * 8704;
#pragma unroll
        for (int lb = 0; lb < 4; ++lb) ssl[lb] = 0.f;
#pragma unroll
        for (int pb = 0; pb < 4; ++pb) {
            bf16x8 bo[4];
#pragma unroll
            for (int kk = 0; kk < 4; ++kk) bo[kk] = *(const bf16x8*)(cs + (16 * pb + r) * 128 + 32 * kk + 8 * q);
            const int p0 = 16 * pb + 4 * q;
#pragma unroll
            for (int lb = 0; lb < 4; ++lb) { const int l = 16 * lb + r;
                bf16* yp = Y + (m0 + l) * 1024 + 512 + 64 * h + p0;
                const v2u yv = *(const v2u*)yp, zv = *(const v2u*)(P + (m0 + l) * PP + 1792 + 64 * h + p0);
                f32x4 acc = (f32x4){0.f, 0.f, 0.f, 0.f};
#pragma unroll
                for (int kk = 0; kk < 4; ++kk) acc = MFMA16(bo[kk], *(const LAS bf16x8*)(Cg + l * 136 + 32 * kk + 8 * q), acc);
                const float ea = __expf(ACS8[h * 64 + l]); const f32x4 y4 = bf4(yv) + ea * acc, z4 = bf4(zv);
                f32x4 u4;
#pragma unroll
                for (int j = 0; j < 4; ++j) { u4[j] = y4[j] * z4[j] * sigm(z4[j]); ssl[lb] += u4[j] * u4[j]; }
                v2u o; o.x = cvt_pk_bf16(u4[0], u4[1]); o.y = cvt_pk_bf16(u4[2], u4[3]);
                if (st) *(v2u*)yp = o;
            }
            asm volatile("" ::: "memory");
        }
#pragma unroll
        for (int lb = 0; lb < 4; ++lb) { float t = ssl[lb]; t += __shfl_xor(t, 16); t += __shfl_xor(t, 32); if (q == 0) SS8[h * 64 + 16 * lb + r] = t; }
    }
    __syncthreads();
    {
#pragma unroll
        for (int lb = 0; lb < 4; ++lb) { const int l = 16 * lb + r; float t = 0.f;
#pragma unroll
            for (int hh = 0; hh < 8; ++hh) t += SS8[hh * 64 + l];
            const float rs = __builtin_amdgcn_rsqf(t * (1.f / 512.f) + 1e-5f);
#pragma unroll
            for (int pb = 0; pb < 4; ++pb) { const int p0 = 16 * pb + 4 * q; bf16* yp = Y + (m0 + l) * 1024 + 512 + 64 * h + p0;
                const f32x4 u4 = bf4(*(const v2u*)yp) * rs * *(const f32x4*)(ssm_norm + 64 * h + p0);
                v2u o; o.x = cvt_pk_bf16(u4[0], u4[1]); o.y = cvt_pk_bf16(u4[2], u4[3]); if (st) *(v2u*)yp = o; }
        }
    }
    {
        const int c8 = 8 * lane, hh = lane >> 3;
        float gg[8], gb[8], muv[8];
#pragma unroll
        for (int e = 0; e < 8; ++e) { gg[e] = gn_g[c8 + e]; gb[e] = gn_b[c8 + e]; muv[e] = mu[1024 + c8 + e]; }
#pragma unroll
        for (int bt = 0; bt < 2; ++bt) {
            v4u yv[4], gv[4], vc[4], vp[4]; float bon[4];
#pragma unroll
            for (int k = 0; k < 4; ++k) { const size_t m = m0 + 8 * wave + 4 * bt + k; const int t = (int)(m & (SEQ - 1)); const bf16* pr = P + m * PP;
                yv[k] = *(const v4u*)(Y + m * 1024 + c8); gv[k] = *(const v4u*)(G + m * 512 + c8); vc[k] = *(const v4u*)(pr + 1024 + c8);
                vp[k] = (v4u){0u, 0u, 0u, 0u}; if (t) vp[k] = *(const v4u*)(pr - PP + 1024 + c8); bon[k] = BON[m * 8 + hh]; }
#pragma unroll
            for (int k = 0; k < 4; ++k) { const size_t m = m0 + 8 * wave + 4 * bt + k;
                float y[8], sm = 0.f;
#pragma unroll
                for (int e = 0; e < 4; ++e) { y[2 * e] = bf_lo(yv[k][e]); y[2 * e + 1] = bf_hi(yv[k][e]); sm += y[2 * e] + y[2 * e + 1]; }
                sm += __shfl_xor(sm, 1); sm += __shfl_xor(sm, 2); sm += __shfl_xor(sm, 4);
                const float mean = sm * (1.f / 64.f); float qv_ = 0.f;
#pragma unroll
                for (int e = 0; e < 8; ++e) { y[e] -= mean; qv_ += y[e] * y[e]; }
                qv_ += __shfl_xor(qv_, 1); qv_ += __shfl_xor(qv_, 2); qv_ += __shfl_xor(qv_, 4);
                const float rstd = __builtin_amdgcn_rsqf(qv_ * (1.f / 64.f) + 64e-5f);
                float o[8];
#pragma unroll
                for (int e = 0; e < 4; ++e) {
                    const float v0 = bf_lo(vc[k][e]), v1 = bf_hi(vc[k][e]), p0 = bf_lo(vp[k][e]), p1 = bf_hi(vp[k][e]);
                    const float va = v0 + (p0 - v0) * muv[2 * e], vb = v1 + (p1 - v1) * muv[2 * e + 1];
                    o[2 * e] = (y[2 * e] * rstd * gg[2 * e] + gb[2 * e] + bon[k] * va) * bf_lo(gv[k][e]);
                    o[2 * e + 1] = (y[2 * e + 1] * rstd * gg[2 * e + 1] + gb[2 * e + 1] + bon[k] * vb) * bf_hi(gv[k][e]);
                }
                v4u w; w.x = cvt_pk_bf16(o[0], o[1]); w.y = cvt_pk_bf16(o[2], o[3]); w.z = cvt_pk_bf16(o[4], o[5]); w.w = cvt_pk_bf16(o[6], o[7]);
                if (st) *(v4u*)(Y + m * 1024 + c8) = w;
            }
        }
    }
    __syncthreads();
}
#define XB_TMO      128
#define XB_XCNT(j)  (256  + 64 * (j))
#define XB_XSUB(j)  (1280 + 64 * (j))
#define XB_XGEN(j)  (2304 + 64 * (j))
#define XB_TOP      3328
#define XB_TOPGEN   3392
#define XCD_BAR_WORDS 3456
#define XB_SPIN_CAP (1u << 18)

__device__ __forceinline__ unsigned xb_ld(unsigned* p)              { return __hip_atomic_load(p, __ATOMIC_RELAXED, __HIP_MEMORY_SCOPE_AGENT); }
__device__ __forceinline__ unsigned xb_add(unsigned* p, unsigned v) { return __hip_atomic_fetch_add(p, v, __ATOMIC_RELAXED, __HIP_MEMORY_SCOPE_AGENT); }
__device__ __forceinline__ unsigned xb_xcc_id() { return (unsigned)__builtin_amdgcn_s_getreg((3 << 11) | 20) & 0xFu; }
#define XB_SPIN(cond, bar) do { unsigned _sp = 0; while (cond) { __builtin_amdgcn_s_sleep(1); \
    if ((++_sp & 255u) == 0u) { if (xb_ld(&(bar)[XB_TMO])) break; if (_sp > XB_SPIN_CAP) { atomicAdd(&(bar)[XB_TMO], 1u); break; } } } } while (0)

struct XcdBarrier {
    unsigned* bar; unsigned x;
    volatile LAS unsigned* st;
};

__device__ __forceinline__ XcdBarrier xcd_barrier_post(unsigned* bar, volatile LAS unsigned* st) {
    XcdBarrier b; b.bar = bar; b.x = xb_xcc_id(); b.st = st;
    if (threadIdx.x == 0) (void)xb_add(&bar[XB_XCNT(b.x)], 1u);
    return b;
}
__device__ __forceinline__ void xcd_barrier_complete(unsigned* bar, unsigned x, unsigned& nloc, unsigned& nx) {
    const unsigned G = gridDim.x * gridDim.y * gridDim.z;
    unsigned sum, cnt, mine, sp = 0u;
    for (;;) {
        sum = 0u; cnt = 0u; mine = 0u;
#pragma unroll
        for (unsigned j = 0; j < 16; ++j) { const unsigned c = xb_ld(&bar[XB_XCNT(j)]); sum += c; cnt += (c > 0u) ? 1u : 0u; mine = (j == x) ? c : mine; }
        if (sum == G) break;
        __builtin_amdgcn_s_sleep(1);
        if ((++sp & 255u) == 0u) { if (xb_ld(&bar[XB_TMO])) break; if (sp > XB_SPIN_CAP) { atomicAdd(&bar[XB_TMO], 1u); break; } }
    }
    nloc = mine > 0u ? mine : 1u; nx = cnt > 0u ? cnt : 1u;
}

__device__ __forceinline__ void xcd_barrier(const XcdBarrier& b) {
    asm volatile("s_waitcnt vmcnt(0)" ::: "memory");
    __syncthreads();
    if (threadIdx.x == 0) {
        unsigned* bar = b.bar;
        __builtin_amdgcn_s_waitcnt(0);
        unsigned nloc = b.st[0], nx = b.st[1];
        if (nloc == 0u) { xcd_barrier_complete(bar, b.x, nloc, nx); b.st[0] = nloc; b.st[1] = nx; }
        const unsigned old = xb_add(&bar[XB_XSUB(b.x)], 1u);
        const unsigned gen = old / nloc;
        if (old + 1u == (gen + 1u) * nloc) {
            __builtin_amdgcn_fence(__ATOMIC_RELEASE, "agent");
            asm volatile("s_waitcnt vmcnt(0)" ::: "memory");
            const unsigned og = xb_add(&bar[XB_TOP], 1u);
            const unsigned tg = og / nx;
            if (og + 1u == (tg + 1u) * nx) xb_add(&bar[XB_TOPGEN], 1u);
            else XB_SPIN(xb_ld(&bar[XB_TOPGEN]) == tg, bar);
            __builtin_amdgcn_fence(__ATOMIC_ACQUIRE, "agent");
            xb_add(&bar[XB_XGEN(b.x)], 1u);
            asm volatile("s_waitcnt vmcnt(0)" ::: "memory");
        } else {
            XB_SPIN(xb_ld(&bar[XB_XGEN(b.x)]) == gen, bar);
            __builtin_amdgcn_fence(__ATOMIC_ACQUIRE, "agent");
            asm volatile("s_waitcnt vmcnt(0)" ::: "memory");
        }
    }
    __syncthreads();
}

struct Args { const float* in[30]; float* out; unsigned char* ws; int ph_lo, ph_hi, dry, pad; };
__global__ void __launch_bounds__(NTHREADS, 2) fwd_kernel(Args args) {
    extern __shared__ __attribute__((aligned(16))) unsigned char lds_raw[];
    LAS unsigned char* lds = (LAS unsigned char*)lds_raw;
    const int tid = threadIdx.x, lane = tid & 63, wave = __builtin_amdgcn_readfirstlane(tid >> 6);
    const int G = gridDim.x, bx = blockIdx.x; const int vcu = (G % 8 == 0) ? (bx % 8) * (G / 8) + bx / 8 : bx;
    const int gw = vcu * NWAVES + wave, NGW = G * NWAVES;
    unsigned char* ws = args.ws;
    const float* const* in = args.in;
    bf16* W1GU = (bf16*)(ws + WS_W1GU); bf16* W1D = (bf16*)(ws + WS_W1D); bf16* WIN = (bf16*)(ws + WS_WIN); bf16* WOUT = (bf16*)(ws + WS_WOUT);
    bf16* W2GU = (bf16*)((unsigned char*)args.out + 32 * MiB);     bf16* W2D = (bf16*)(ws + WS_W2D); bf16* WL = (bf16*)(ws + WS_WL);
    bf16* XG = (bf16*)(ws + WS_XG); bf16* PB = (bf16*)(ws + WS_P); bf16* YB = (bf16*)(ws + WS_Y); bf16* GB = (bf16*)(ws + WS_G); bf16* LIN = (bf16*)(ws + WS_LIN);
    bf16* EAB = (bf16*)args.out;
    float* PART = (float*)(ws + WS_PART); float* BON = (float*)(ws + WS_BONUS); float* GCG = (float*)(ws + WS_GC); unsigned* SLG = (unsigned*)(ws + WS_LIN); bf16* CSB = (bf16*)(ws + WS_CS); float* CDB = (float*)(ws + WS_CD);
    const int lo = args.ph_lo, hi = args.ph_hi;
    cg::grid_group grid = cg::this_grid();
    volatile LAS unsigned* xbst = (volatile LAS unsigned*)(lds + 147440);
    if (tid < 2) xbst[tid] = 0u;
    __syncthreads();
    XcdBarrier xbar; xbar.bar = (unsigned*)ws; xbar.x = 0; xbar.st = nullptr;
    if (hi - lo > 1) xbar = xcd_barrier_post((unsigned*)ws, xbst);
#ifndef PH_MASK
#define PH_MASK 0xfff
#endif
#ifndef REPG
#define REPG 1
#endif
#ifndef REP0
#define REP0 1
#endif
#define IN(k) (((PH_MASK >> (k)) & 1) && lo <= (k) && (k) < hi)
#define SEAM(k) do { if (IN(k) && IN((k) + 1)) { if (args.pad != 0) grid.sync(); else xcd_barrier(xbar); } } while (0)
#define STAGE_P6_TABLES() do {   \
        const int h6 = vcu & 7, g6 = vcu & 1; LAS float* CWs = (LAS float*)(lds + 133632); LAS float* PRMw = (LAS float*)(lds + 143872); \
        for (int idx = tid; idx < 2560; idx += NTHREADS) { const int cgp = idx / 40, rem = idx % 40, k = rem >> 3, e = rem & 7; \
            const int chb = cgp < 16 ? 2816 + 128 * g6 + 8 * cgp : (cgp < 32 ? 3072 + 128 * g6 + 8 * (cgp - 16) : 2304 + 256 * g6 + 8 * (cgp - 32)); \
            CWs[idx] = k < 4 ? in[18][k * 1024 + chb - 2304 + e] : in[19][chb - 2304 + e]; } \
        { const int a = tid >> 6, j = tid & 63; const float* src = a < 3 ? in[7] + 512 * a : (a == 3 ? in[13] : (a == 4 ? in[14] : (a == 5 ? in[15] : (a == 6 ? in[8] : in[10])))); \
          PRMw[tid] = src[64 * h6 + j]; } } while (0)
    if (IN(0)) { p0_prologue(lds, in, ws, vcu, G, tid, wave, lane); SEAM(0); }
    if (IN(1)) {
        pg8::Gemm g{XG, W1GU, M, NGU, D}; pg8::StaticOrder S; S.init(M, NGU, G, bx);
        pg8::EpiSwiGLU E{PB, FF, nullptr};
        pg8::gemm_phase<pg8::EpiSwiGLU, pg8::StaticOrder, true, true>(lds, g, S, E);
        if (G == 256 ? bx >= 128 : true) { const int tb_ = G == 256 ? bx - 128 : bx, ntb = G == 256 ? 128 : G; p1_tail_copies(in, ws, tb_ * NWAVES + wave, ntb * NWAVES, tb_ * NTHREADS + tid, ntb * NTHREADS, lane); }
        SEAM(1);
    }
    if (IN(2)) {
        pg8::Gemm g{PB, W1D, M, D, FF}; pg8::StaticOrder S; S.init(M, D, G, bx);
        pg8::EpiResidB<false> E{in[0], XG, nullptr, PART, 0.5f, nullptr, nullptr};
        pg8::gemm_phase<pg8::EpiResidB<false>, pg8::StaticOrder, true, true>(lds, g, S, E);
        SEAM(2);
    }
    if (IN(3)) {
        pg8::Gemm g{XG, WIN, M, NINP, D}; pg8::StaticOrder S; S.init(M, NINP, G, bx);
        pg8::EpiScaleBf16 E{PB, PP, NIN, PART};
        pg8::gemm_phase<pg8::EpiScaleBf16, pg8::StaticOrder, true, true>(lds, g, S, E);
        if (G == 256 ? bx >= 128 : true) {
            const int tb_ = G == 256 ? bx - 128 : bx, ntw = (G == 256 ? 128 : G) * NWAVES;
            for (int it = tb_ * NWAVES + wave; it < 2 * TR_I_GU; it += 2 * ntw) {
                int ra = it; const int upa = ra >= TR_I_GU; ra -= upa * TR_I_GU; const TrItem a = tr_make(in[26 + upa], FF, ra / 44, ra % 44, W2GU, D, 0, 0, 1, upa, lane, in[25]);
                const bool hasb = it + ntw < 2 * TR_I_GU; int rb = hasb ? it + ntw : it; const int upb = rb >= TR_I_GU; rb -= upb * TR_I_GU; const TrItem b = tr_make(in[26 + upb], FF, rb / 44, rb % 44, W2GU, D, 0, 0, 1, upb, lane, in[25]);
                f32x4 va[8], vb[8]; tr_load(a, va); tr_load(b, vb); tr_store(a, va); if (hasb) tr_store(b, vb);
            }
        }
        SEAM(3);
    }
    if (IN(4)) { p4_lora_in(PB, in[7], LIN, vcu * NTHREADS + tid, G * NTHREADS); SEAM(4); }
    if (IN(5)) {
        int kl = 128; asm volatile("" : "+s"(kl));
        { pg8::Gemm g{LIN, WL, M, 1024, kl, KLORA}; pg8::StaticOrder S; S.init(M, 1024, G, bx);
          pg8::EpiLora E{EAB, GB};
          pg8::gemm_phase<pg8::EpiLora, pg8::StaticOrder, true, true>(lds, g, S, E); }
        { pg8::Gemm g{LIN + 128, WL + (size_t)1024 * KLORA + 128, M, 512, kl, KLORA}; pg8::StaticOrder S; S.init(M, 512, G, (bx + 128) % G);
          pg8::EpiLoraG E2{GB};
          pg8::gemm_phase<pg8::EpiLoraG, pg8::StaticOrder, true, true>(lds, g, S, E2); }
        if (IN(6)) STAGE_P6_TABLES();
        SEAM(5);
    }
    const int dry = args.dry;
    if (IN(6)) {
        if (!IN(5)) { STAGE_P6_TABLES(); __syncthreads(); }
        if (dry == 0 || (dry & 1)) { RwIn rin; rwkv_chunk_load(rin, vcu, PB, EAB, tid);
            for (int u = vcu; u < 2048; u += G) { rwkv_chunk_unit(lds, u, rin, u + G < 2048 ? u + G : -1, PB, EAB, YB, BON, GCG, SLG, tid, wave, lane, dry == 0, dry >> 4); } }
        if (dry == 0 || (dry & 2)) {
            for (int u = vcu; u < 512; u += G) ssd_chunk_group(lds, u, PB, YB, CSB, CDB, in[20], in[21], in[22], tid, wave, lane);
        }
        SEAM(6);
    }
    if (IN(7)) {
        volatile LAS unsigned* prog = (volatile LAS unsigned*)(lds + 131072);
        if (tid == 0) *prog = 0u;
        __syncthreads();
        if (wave == 0) { if ((dry == 0 || (dry & 1)) && vcu < 256) rwkv_seq_state(lds, prog, vcu, EAB, GCG, SLG, lane); }
        else if (wave == 1) { if ((dry == 0 || (dry & 1)) && vcu < 256) rwkv_seq_out(lds, prog, vcu, EAB, YB, lane, dry == 0); }
        else if (dry == 0 || (dry & 2)) { for (int it = (vcu * 6 + wave - 2) * 64 + lane; it < 65536; it += G * 6 * 64) ssd_scan_item(it, CSB, CDB, dry == 0); }
        SEAM(7);
    }
    if (IN(8)) {
        if (dry == 0 || (dry & 1)) for (int u = vcu; u < 256; u += G) mix_out_unit(lds, u, PB, GB, BON, YB, CSB, in[7], in[16], in[17], in[23], in[18], in[19], in[20], in[21], tid, wave, lane, dry == 0);
        SEAM(8);
    }
    if (IN(9)) {
        pg8::Gemm g{YB, WOUT, M, D, D}; pg8::StaticOrder S; S.init(M, D, G, bx);
        pg8::EpiResidB<true> E{XG, XG, nullptr, PART, 1.0f, nullptr, nullptr};
        pg8::gemm_phase<pg8::EpiResidB<true>, pg8::StaticOrder, true, true>(lds, g, S, E);
        SEAM(9);
    }
    if (IN(10)) {
        pg8::Gemm g{XG, W2GU, M, NGU, D}; pg8::StaticOrder S; S.init(M, NGU, G, bx);
        pg8::EpiSwiGLU E{PB, FF, PART};
        pg8::gemm_phase<pg8::EpiSwiGLU, pg8::StaticOrder, true, true>(lds, g, S, E);
        SEAM(10);
    }
    if (IN(11)) {
        pg8::Gemm g{PB, W2D, M, D, FF}; pg8::StaticOrder S; S.init(M, D, G, bx);
        pg8::EpiResidNormFinal E{XG, args.out, in[29], (float*)(ws + 65536), (unsigned*)(ws + 16384), 0.5f};
        pg8::gemm_phase<pg8::EpiResidNormFinal, pg8::StaticOrder, false, true>(lds, g, S, E);
    }
#undef IN
#undef SEAM
}

extern "C" void kernel_launch(void* const* d_in, const int* in_sizes, int n_in, void* d_out, int out_size, void* d_ws, size_t ws_size, hipStream_t stream) {
    static int grid = 0;
    if (grid == 0) {
        if (n_in != 30 || out_size != M * D || ws_size < WS_END) { fprintf(stderr, "kernel_launch: unexpected shapes (n_in %d out %d ws %zu)\n", n_in, out_size, ws_size); grid = -1; return; }
        int dev = 0, cus = 0, per_cu = 0;
        hipGetDevice(&dev); hipDeviceGetAttribute(&cus, hipDeviceAttributeMultiprocessorCount, dev);
        if (hipFuncSetAttribute((const void*)fwd_kernel, hipFuncAttributeMaxDynamicSharedMemorySize, LDS_BYTES) != hipSuccess) { fprintf(stderr, "kernel_launch: hipFuncSetAttribute failed\n"); grid = -1; return; }
        hipOccupancyMaxActiveBlocksPerMultiprocessor(&per_cu, (const void*)fwd_kernel, NTHREADS, LDS_BYTES);
        (void)hipGetLastError();
        if (per_cu < 1) per_cu = 1;
        grid = cus * 1;
        if (grid != 256) fprintf(stderr, "kernel_launch: note: grid %d\n", grid);
    }
    if (grid < 0) return;
    Args a{};
    for (int i = 0; i < 30; ++i) a.in[i] = (const float*)d_in[i];
    a.out = (float*)d_out; a.ws = (unsigned char*)d_ws;
    if (hipMemsetAsync(d_ws, 0, 32768, stream) != hipSuccess) { fprintf(stderr, "kernel_launch: memset of the control words failed\n"); return; }
#if MK_N_LAUNCHES == 1
    a.ph_lo = 0; a.ph_hi = NPHASE;
    void* kargs[] = {&a};
    hipError_t e = hipLaunchCooperativeKernel((const void*)fwd_kernel, dim3(grid), dim3(NTHREADS), kargs, LDS_BYTES, stream);
    if (e != hipSuccess) fprintf(stderr, "cooperative launch failed: %s (grid %d)\n", hipGetErrorString(e), grid);
#else
    #ifndef REP_PHASE_MASK
#define REP_PHASE_MASK 0
#endif
#ifndef PROBE_PHASE
#define PROBE_PHASE -1
#define PROBE_SEL 0
#endif
    for (int p = 0; p < NPHASE; ++p) { a.ph_lo = p; a.ph_hi = p + 1; const int nrep = ((REP_PHASE_MASK >> p) & 1) ? 2 : 1;
        if (p == PROBE_PHASE) { a.dry = PROBE_SEL; hipLaunchKernelGGL(fwd_kernel, dim3(grid), dim3(NTHREADS), LDS_BYTES, stream, a); a.dry = 0; }
        for (int rr = 0; rr < nrep; ++rr) hipLaunchKernelGGL(fwd_kernel, dim3(grid), dim3(NTHREADS), LDS_BYTES, stream, a); }
#endif
}
```

```cpp
#include <hip/hip_runtime.h>
#include <hip/hip_cooperative_groups.h>
#include <cstdio>
#include <cstdint>
namespace cg = cooperative_groups;
#define MK_N_LAUNCHES 1
namespace pg8 {
#define PG8_LAS __attribute__((address_space(3)))
typedef unsigned short bf16_t;
typedef short bf16x8 __attribute__((ext_vector_type(8)));
typedef float f32x4 __attribute__((ext_vector_type(4)));
typedef unsigned u32x4 __attribute__((ext_vector_type(4)));
constexpr int BM = 256, BK = 64, HALF = 128, HTB = HALF * BK * 2  , STAGE_BYTES = 8 * HTB, NXCD = 8, WGM = 4;

__host__ __device__ __forceinline__ int lds_byte(int r, int c) { const int st = (r >> 4) * 2 + (c >> 5), rr = r & 15, cc = c & 31, ob = rr * 64 + cc * 2; return st * 1024 + (ob ^ (((ob >> 9) & 1) << 5)); }
__host__ __device__ __forceinline__ void stage_rc(int b, int& R, int& C) { const int st = b / 1024, sb = b % 1024, swz = sb ^ (((sb >> 9) & 1) << 5); R = (st >> 1) * 16 + swz / 64; C = (st & 1) * 32 + (swz % 64) / 2; }
__host__ __device__ __forceinline__ int perm32(int rho) { const int n = rho >> 4, i = rho & 15; return 8 * (i >> 2) + 4 * n + (i & 3); }

struct Unit { int pm, pn; };
struct Gemm { const bf16_t* A; const bf16_t* Bt; int M, N, K; int ld; };

struct StaticOrder {
    int nM, nN, nwg, G, c;
    __host__ __device__ void init(int M, int N, int G_, int c_) { nM = M / BM; nN = N / BM; nwg = nM * nN; G = G_; c = c_; }
    __host__ __device__ bool next(int i, Unit& u) const {
        const long L = (long)i * G + c; if (L >= nwg) return false;
        int wgid = (int)L; { const int q = nwg / NXCD, r = nwg % NXCD, xcd = wgid % NXCD, off = wgid / NXCD; wgid = (xcd < r ? xcd * (q + 1) : r * (q + 1) + (xcd - r) * q) + off; }
        const int nig = WGM * nN, gid = wgid / nig, fm = gid * WGM, gsz = (nM - fm) < WGM ? (nM - fm) : WGM;
        u.pm = fm + ((wgid % nig) % gsz); u.pn = (wgid % nig) / gsz; return true;
    }
    __device__ __forceinline__ void a_ready(const Unit&) const {}
    __device__ __forceinline__ void done(const Unit&) const {}
};
typedef float f32x2c_ __attribute__((ext_vector_type(2)));
typedef __bf16 bf16x2c_ __attribute__((ext_vector_type(2)));
__device__ __forceinline__ unsigned cvt_pk_bf16(float lo, float hi) { const f32x2c_ v = {lo, hi}; const bf16x2c_ b = __builtin_convertvector(v, bf16x2c_); return __builtin_bit_cast(unsigned, b); }
typedef unsigned u32x2 __attribute__((ext_vector_type(2)));
__device__ __forceinline__ float sigmoidf_(float x) { return __builtin_amdgcn_rcpf(1.0f + __expf(-x)); }
__device__ __forceinline__ float row_rscale(const float* part, int row) {
    const f32x4* p = (const f32x4*)(part + (size_t)row * 16);
    const f32x4 a = p[0], b = p[1], c = p[2], d = p[3];
    const f32x4 s = (a + b) + (c + d);
    return __builtin_amdgcn_rsqf(((s[0] + s[1]) + (s[2] + s[3])) * (1.0f / 1024.0f) + 1e-6f);
}
struct EpiSwiGLU {
    static constexpr bool PERM = true, AFTER_DRAIN = false;
    bf16_t* O; int ldc; const float* part;
    __device__ __forceinline__ void operator()(const f32x4 (&acc)[2][2][4][2], const Unit& u, int wr, int wc, int fr, int fq) const {
        const int row0 = u.pm * BM + wr * 64 + fr, col0 = u.pn * HALF + wc * 32 + 8 * fq;
#pragma unroll
        for (int ai = 0; ai < 2; ++ai)
#pragma unroll
            for (int m = 0; m < 4; ++m) {
                const int row = row0 + ai * HALF + m * 16;
                const float rs = part ? row_rscale(part, row) : 1.0f;
                float h[8];
#pragma unroll
                for (int n = 0; n < 2; ++n)
#pragma unroll
                    for (int j = 0; j < 4; ++j) { const float g = acc[ai][0][m][n][j] * rs, up = acc[ai][1][m][n][j] * rs; h[4 * n + j] = g * sigmoidf_(g) * up; }
                u32x4 w; w.x = cvt_pk_bf16(h[0], h[1]); w.y = cvt_pk_bf16(h[2], h[3]); w.z = cvt_pk_bf16(h[4], h[5]); w.w = cvt_pk_bf16(h[6], h[7]);
                *(u32x4*)(O + (size_t)row * ldc + col0) = w;
            }
    }
};
struct EpiScaleBf16 {
    static constexpr bool PERM = true, AFTER_DRAIN = false;
    bf16_t* O; int ldc; int ncols; const float* part;
    __device__ __forceinline__ void operator()(const f32x4 (&acc)[2][2][4][2], const Unit& u, int wr, int wc, int fr, int fq) const {
        const int row0 = u.pm * BM + wr * 64 + fr, col0 = u.pn * BM + wc * 32 + 8 * fq;
#pragma unroll
        for (int ai = 0; ai < 2; ++ai)
#pragma unroll
            for (int m = 0; m < 4; ++m) {
                const int row = row0 + ai * HALF + m * 16; const float rs = row_rscale(part, row);
#pragma unroll
                for (int bj = 0; bj < 2; ++bj) { const int col = col0 + bj * HALF;
                    if (col < ncols) { const f32x4 v0 = acc[ai][bj][m][0] * rs, v1 = acc[ai][bj][m][1] * rs;
                        u32x4 w; w.x = cvt_pk_bf16(v0[0], v0[1]); w.y = cvt_pk_bf16(v0[2], v0[3]); w.z = cvt_pk_bf16(v1[0], v1[1]); w.w = cvt_pk_bf16(v1[2], v1[3]);
                        *(u32x4*)(O + (size_t)row * ldc + col) = w; } }
            }
    }
};
struct EpiLora {
    static constexpr bool PERM = true, AFTER_DRAIN = false;
    bf16_t* EA; bf16_t* G;
    __device__ __forceinline__ void operator()(const f32x4 (&acc)[2][2][4][2], const Unit& u, int wr, int wc, int fr, int fq) const {
        const int row0 = u.pm * BM + wr * 64 + fr, colt = (u.pn & 3) * BM + wc * 32 + 8 * fq;
        bf16_t* base = u.pn < 4 ? EA : G; const int ldc = u.pn < 4 ? 1024 : 512;
#pragma unroll
        for (int ai = 0; ai < 2; ++ai)
#pragma unroll
            for (int m = 0; m < 4; ++m) {
                bf16_t* rowp = base + (size_t)(row0 + ai * HALF + m * 16) * ldc + colt;
#pragma unroll
                for (int bj = 0; bj < 2; ++bj) { const f32x4 v0 = acc[ai][bj][m][0], v1 = acc[ai][bj][m][1];
                    u32x4 w; w.x = cvt_pk_bf16(v0[0], v0[1]); w.y = cvt_pk_bf16(v0[2], v0[3]); w.z = cvt_pk_bf16(v1[0], v1[1]); w.w = cvt_pk_bf16(v1[2], v1[3]);
                    *(u32x4*)(rowp + bj * HALF) = w; }
            }
    }
};

struct EpiLoraG {
    static constexpr bool PERM = true, AFTER_DRAIN = false;
    bf16_t* G;
    __device__ __forceinline__ void operator()(const f32x4 (&acc)[2][2][4][2], const Unit& u, int wr, int wc, int fr, int fq) const {
        const int row0 = u.pm * BM + wr * 64 + fr, colt = u.pn * BM + wc * 32 + 8 * fq;
#pragma unroll
        for (int ai = 0; ai < 2; ++ai)
#pragma unroll
            for (int m = 0; m < 4; ++m) {
                bf16_t* rowp = G + (size_t)(row0 + ai * HALF + m * 16) * 512 + colt;
#pragma unroll
                for (int bj = 0; bj < 2; ++bj) { const f32x4 v0 = acc[ai][bj][m][0], v1 = acc[ai][bj][m][1];
                    u32x4 w; w.x = cvt_pk_bf16(v0[0], v0[1]); w.y = cvt_pk_bf16(v0[2], v0[3]); w.z = cvt_pk_bf16(v1[0], v1[1]); w.w = cvt_pk_bf16(v1[2], v1[3]);
                    *(u32x4*)(rowp + bj * HALF) = w; }
            }
    }
};
__device__ __forceinline__ f32x4 bf4_(u32x2 u) { return (f32x4){__builtin_bit_cast(float, u.x << 16), __builtin_bit_cast(float, u.x & 0xffff0000u), __builtin_bit_cast(float, u.y << 16), __builtin_bit_cast(float, u.y & 0xffff0000u)}; }
template <bool BASE_BF16> struct EpiResidB {
    static constexpr bool PERM = false, AFTER_DRAIN = false;
    const void* base; bf16_t* xo; bf16_t* xo2; float* part; float scale;
    const float* unrs; const float* ungain;
    __device__ __forceinline__ void operator()(const f32x4 (&acc)[2][2][4][2], const Unit& u, int wr, int wc, int fr, int fq) const {
#pragma unroll
        for (int ai = 0; ai < 2; ++ai)
#pragma unroll
            for (int m = 0; m < 4; ++m) {
                const int row = u.pm * BM + ai * HALF + wr * 64 + m * 16 + fr; float ss = 0.f;
                const float irs = unrs ? __builtin_amdgcn_rcpf(unrs[row]) : 1.0f;
#pragma unroll
                for (int bj = 0; bj < 2; ++bj)
#pragma unroll
                    for (int n = 0; n < 2; ++n) {
                        const int col = u.pn * BM + bj * HALF + wc * 32 + n * 16 + 4 * fq; const size_t off = (size_t)row * 1024 + col;
                        f32x4 bs = BASE_BF16 ? bf4_(*(const u32x2*)((const bf16_t*)base + off)) : *(const f32x4*)((const float*)base + off);
                        if (unrs) { const f32x4 gi = *(const f32x4*)(ungain + col); bs = bs * irs * (f32x4){__builtin_amdgcn_rcpf(gi[0]), __builtin_amdgcn_rcpf(gi[1]), __builtin_amdgcn_rcpf(gi[2]), __builtin_amdgcn_rcpf(gi[3])}; }
                        const f32x4 v = bs + acc[ai][bj][m][n] * scale;
                        ss += (v[0] * v[0] + v[1] * v[1]) + (v[2] * v[2] + v[3] * v[3]);
                        u32x2 o; o.x = cvt_pk_bf16(v[0], v[1]); o.y = cvt_pk_bf16(v[2], v[3]); *(u32x2*)(xo + off) = o; if (xo2) *(u32x2*)(xo2 + off) = o;
                    }
                ss += __shfl_xor(ss, 16); ss += __shfl_xor(ss, 32);
                if (fq == 0) part[(size_t)row * 16 + u.pn * 4 + wc] = ss;
            }
    }
};
struct EpiResidNormFinal {
    static constexpr bool PERM = false, AFTER_DRAIN = true;
    const bf16_t* base; float* out; const float* gain; float* xbuf; unsigned* cnt; float scale;
    __device__ __forceinline__ void fused(f32x4 (&acc)[2][2][4][2], const Unit& u, int wr, int wc, int fr, int fq, PG8_LAS unsigned char* lds, int wid, int lane) const {
        PG8_LAS float* Pw = (PG8_LAS float*)lds;
        PG8_LAS float* Sr = (PG8_LAS float*)(lds + 4096);
#pragma unroll
        for (int ai = 0; ai < 2; ++ai)
#pragma unroll
            for (int m = 0; m < 4; ++m) {
                const int rl = ai * HALF + wr * 64 + m * 16 + fr; const size_t rowoff = (size_t)(u.pm * BM + rl) * 1024; float ss = 0.f;
#pragma unroll
                for (int bj = 0; bj < 2; ++bj)
#pragma unroll
                    for (int n = 0; n < 2; ++n) { const int col = u.pn * BM + bj * HALF + wc * 32 + n * 16 + 4 * fq;
                        const f32x4 v = bf4_(*(const u32x2*)(base + rowoff + col)) + acc[ai][bj][m][n] * scale; acc[ai][bj][m][n] = v;
                        ss += (v[0] * v[0] + v[1] * v[1]) + (v[2] * v[2] + v[3] * v[3]); }
                ss += __shfl_xor(ss, 16); ss += __shfl_xor(ss, 32);
                if (fq == 0) Pw[rl * 4 + wc] = ss;
                asm volatile("" : "+v"(acc[ai][0][m][0]), "+v"(acc[ai][0][m][1]), "+v"(acc[ai][1][m][0]), "+v"(acc[ai][1][m][1]));
                if (m & 1) asm volatile("" ::: "memory");
            }
        asm volatile("s_waitcnt lgkmcnt(0)" ::: "memory"); __builtin_amdgcn_s_barrier(); asm volatile("" ::: "memory");
        const int row = wid * 32 + (lane & 31);
        if (lane < 32) { const f32x4 pp = *(const PG8_LAS f32x4*)(Pw + row * 4); const float t = (pp[0] + pp[1]) + (pp[2] + pp[3]);
            __hip_atomic_store(xbuf + (size_t)(u.pm * BM + row) * 4 + u.pn, t, __ATOMIC_RELAXED, __HIP_MEMORY_SCOPE_AGENT); }
        asm volatile("s_waitcnt vmcnt(0)" ::: "memory");
        if (lane == 0) __hip_atomic_fetch_add(cnt + 64 * u.pm, 1u, __ATOMIC_RELAXED, __HIP_MEMORY_SCOPE_AGENT);
        if (wid == 0) {
            unsigned sp = 0;
            while ((unsigned)__builtin_amdgcn_readfirstlane(__hip_atomic_load(cnt + 64 * u.pm, __ATOMIC_RELAXED, __HIP_MEMORY_SCOPE_AGENT)) < 32u) { __builtin_amdgcn_s_sleep(2); if (++sp > (1u << 22)) break; }
            __builtin_amdgcn_fence(__ATOMIC_ACQUIRE, "agent");
        }
        asm volatile("s_waitcnt vmcnt(0) lgkmcnt(0)" ::: "memory"); __builtin_amdgcn_s_barrier(); asm volatile("" ::: "memory");
        if (lane < 32) { const float* sl = xbuf + (size_t)(u.pm * BM + row) * 4; float t = 0.f;
#pragma unroll
            for (int k = 0; k < 4; ++k) t += __hip_atomic_load(sl + k, __ATOMIC_RELAXED, __HIP_MEMORY_SCOPE_AGENT);
            Sr[row] = __builtin_amdgcn_rsqf(t * (1.0f / 1024.0f) + 1e-6f); }
        asm volatile("s_waitcnt vmcnt(0) lgkmcnt(0)" ::: "memory"); __builtin_amdgcn_s_barrier(); asm volatile("" ::: "memory");
#pragma unroll
        for (int ai = 0; ai < 2; ++ai)
#pragma unroll
            for (int m = 0; m < 4; ++m) {
                const int rl = ai * HALF + wr * 64 + m * 16 + fr; const size_t rowoff = (size_t)(u.pm * BM + rl) * 1024; const float rs = Sr[rl];
#pragma unroll
                for (int bj = 0; bj < 2; ++bj)
#pragma unroll
                    for (int n = 0; n < 2; ++n) { const int col = u.pn * BM + bj * HALF + wc * 32 + n * 16 + 4 * fq;
                        *(f32x4*)(out + rowoff + col) = acc[ai][bj][m][n] * rs * *(const f32x4*)(gain + col); }
            }
    }
};

template <class Epi, class Sched, bool ALIGN_EPI = false, bool SP2 = false>
__device__ __forceinline__ void gemm_phase(PG8_LAS unsigned char* lds, const Gemm g, const Sched& S, const Epi& E) {
    const int tid = threadIdx.x, wid = __builtin_amdgcn_readfirstlane(tid >> 6), lane = tid & 63, wr = wid >> 2, wc = wid & 3, fr = lane & 15, fq = lane >> 4;
    const int K = g.K, nt = K / BK, LD = g.ld ? g.ld : g.K;
    unsigned voffA[2], voffB[2];
#pragma unroll
    for (int i = 0; i < 2; ++i) { int R, C; stage_rc(tid * 16 + i * 8192, R, C); const int Rb = Epi::PERM ? ((R & ~31) + perm32(R & 31)) : R;
        voffA[i] = (unsigned)(R * LD + C) * 2u; voffB[i] = (unsigned)(Rb * LD + C) * 2u; }
    const size_t kstep = (size_t)(BK * 2);
    const size_t hstep = (size_t)HALF * LD * 2;
    const size_t tstep = 2 * hstep;
    const unsigned ldsw = (unsigned)wid * 1024u;
    const int aoff = lds_byte(wr * 64 + fr, fq * 8), boff = lds_byte(wc * 32 + fr, fq * 8);
#define PG8_SA(b, h) (((b) * 2 + (h)) * HTB)
#define PG8_SB(b, h) ((4 + (b) * 2 + (h)) * HTB)
#define PG8_STAGE(bufoff, gbase, voff) do { _Pragma("unroll") for (int _i = 0; _i < 2; ++_i) \
        __builtin_amdgcn_global_load_lds((const unsigned*)((const char*)(gbase) + (voff)[_i]), (PG8_LAS unsigned*)(lds + (bufoff) + ldsw + _i * 8192), 16, 0, 0); } while (0)
#define PG8_LDA(dst, b, h) do { _Pragma("unroll") for (int m = 0; m < 4; ++m) _Pragma("unroll") for (int k = 0; k < 2; ++k) dst[m][k] = *(const PG8_LAS bf16x8*)(lds + PG8_SA(b, h) + aoff + m * 2048 + k * 1024); } while (0)
#define PG8_LDB(dst, b, h) do { _Pragma("unroll") for (int n = 0; n < 2; ++n) _Pragma("unroll") for (int k = 0; k < 2; ++k) dst[n][k] = *(const PG8_LAS bf16x8*)(lds + PG8_SB(b, h) + boff + n * 2048 + k * 1024); } while (0)
#define PG8_MMA(ai, bj, At, Bt) do { __builtin_amdgcn_s_setprio(1); _Pragma("unroll") for (int m = 0; m < 4; ++m) _Pragma("unroll") for (int n = 0; n < 2; ++n) _Pragma("unroll") for (int k = 0; k < 2; ++k) \
        acc[ai][bj][m][n] = __builtin_amdgcn_mfma_f32_16x16x32_bf16(Bt[n][k], At[m][k], acc[ai][bj][m][n], 0, 0, 0); __builtin_amdgcn_s_setprio(0); } while (0)
#define PG8_WAIT_V(n) asm volatile("s_waitcnt vmcnt(" #n ")" ::: "memory")
#define PG8_WAIT_L(n) asm volatile("s_waitcnt lgkmcnt(" #n ")" ::: "memory")
#define PG8_BAR __builtin_amdgcn_s_barrier()
#define PG8_SCHED __builtin_amdgcn_sched_barrier(0)
    Unit cur, nxt; int ui = 0;
    if (!S.next(0, cur)) return;
    f32x4 acc[2][2][4][2];
#pragma unroll
    for (int a = 0; a < 2; ++a)
#pragma unroll
        for (int b = 0; b < 2; ++b)
#pragma unroll
            for (int m = 0; m < 4; ++m)
#pragma unroll
                for (int n = 0; n < 2; ++n) acc[a][b][m][n] = (f32x4){0.f, 0.f, 0.f, 0.f};
    bf16x8 At[4][2], B0[2][2], B1[2][2];
    const char* cA = (const char*)g.A + (size_t)cur.pm * tstep; const char* cB = (const char*)g.Bt + (size_t)cur.pn * tstep;
    S.a_ready(cur);
    if constexpr (SP2) {
        PG8_STAGE(PG8_SB(0, 0), cB, voffB); PG8_STAGE(PG8_SB(0, 1), cB + hstep, voffB); PG8_STAGE(PG8_SA(0, 0), cA, voffA); PG8_STAGE(PG8_SA(0, 1), cA + hstep, voffA);
        if (wr == 1) PG8_BAR;
        PG8_WAIT_V(2); PG8_BAR;
        PG8_STAGE(PG8_SB(1, 0), cB + kstep, voffB); PG8_STAGE(PG8_SA(1, 0), cA + kstep, voffA); PG8_STAGE(PG8_SB(1, 1), cB + hstep + kstep, voffB);
        PG8_WAIT_V(6); PG8_BAR;
    } else {
        PG8_STAGE(PG8_SB(0, 0), cB, voffB); PG8_STAGE(PG8_SA(0, 0), cA, voffA); PG8_STAGE(PG8_SB(0, 1), cB + hstep, voffB); PG8_STAGE(PG8_SA(0, 1), cA + hstep, voffA);
        if (wr == 1) PG8_BAR;
        PG8_WAIT_V(4); PG8_BAR;
        PG8_STAGE(PG8_SB(1, 0), cB + kstep, voffB); PG8_STAGE(PG8_SA(1, 0), cA + kstep, voffA); PG8_STAGE(PG8_SB(1, 1), cB + hstep + kstep, voffB);
        PG8_WAIT_V(6); PG8_BAR;
    }
    for (;;) {
        const bool has_next = S.next(ui + 1, nxt);
        const char* nA = has_next ? (const char*)g.A + (size_t)nxt.pm * tstep : cA; const char* nB = has_next ? (const char*)g.Bt + (size_t)nxt.pn * tstep : cB;
        for (int t = 0; t < nt; t += 2) {
            const bool last = (t == nt - 2);
            const char* a1 = cA + (size_t)(t + 1) * kstep;
            const char* a2 = last ? nA : cA + (size_t)(t + 2) * kstep; const char* b2 = last ? nB : cB + (size_t)(t + 2) * kstep;
            const char* a3 = a2 + kstep; const char* b3 = b2 + kstep;
            if (last && has_next) S.a_ready(nxt);
            if constexpr (SP2) {
            PG8_LDB(B0, 0, 0); PG8_LDB(B1, 0, 1); PG8_SCHED; PG8_LDA(At, 0, 0); PG8_STAGE(PG8_SA(1, 1), a1 + hstep, voffA);
            PG8_WAIT_V(8); PG8_WAIT_L(0); PG8_BAR; PG8_MMA(0, 0, At, B0); PG8_MMA(0, 1, At, B1); PG8_BAR; PG8_SCHED;
            PG8_LDA(At, 0, 1); PG8_STAGE(PG8_SB(0, 0), b2, voffB); PG8_STAGE(PG8_SB(0, 1), b2 + hstep, voffB); PG8_STAGE(PG8_SA(0, 0), a2, voffA);
            PG8_WAIT_V(8); PG8_WAIT_L(0); PG8_BAR; PG8_MMA(1, 0, At, B0); PG8_MMA(1, 1, At, B1); PG8_BAR; PG8_SCHED;
            PG8_LDB(B0, 1, 0); PG8_LDB(B1, 1, 1); PG8_SCHED; PG8_LDA(At, 1, 0); PG8_STAGE(PG8_SA(0, 1), a2 + hstep, voffA);
            PG8_WAIT_V(8); PG8_WAIT_L(0); PG8_BAR; PG8_MMA(0, 0, At, B0); PG8_MMA(0, 1, At, B1); PG8_BAR; PG8_SCHED;
            PG8_LDA(At, 1, 1); PG8_STAGE(PG8_SB(1, 0), b3, voffB); PG8_STAGE(PG8_SB(1, 1), b3 + hstep, voffB); PG8_STAGE(PG8_SA(1, 0), a3, voffA);
            PG8_WAIT_V(8); PG8_WAIT_L(0); PG8_BAR; PG8_MMA(1, 0, At, B0); PG8_MMA(1, 1, At, B1); PG8_BAR; PG8_SCHED;
            } else {
            PG8_LDB(B0, 0, 0); PG8_SCHED; PG8_LDA(At, 0, 0); PG8_STAGE(PG8_SA(1, 1), a1 + hstep, voffA);
            PG8_WAIT_L(8); PG8_BAR; PG8_WAIT_L(0); PG8_MMA(0, 0, At, B0); PG8_BAR; PG8_SCHED;
            PG8_LDB(B1, 0, 1); PG8_STAGE(PG8_SB(0, 0), b2, voffB);
            PG8_BAR; PG8_WAIT_L(0); PG8_MMA(0, 1, At, B1); PG8_BAR;
            PG8_LDA(At, 0, 1); PG8_STAGE(PG8_SA(0, 0), a2, voffA);
            PG8_BAR; PG8_WAIT_L(0); PG8_MMA(1, 0, At, B0); PG8_BAR; PG8_SCHED;
            PG8_STAGE(PG8_SB(0, 1), b2 + hstep, voffB);
            PG8_WAIT_V(6); PG8_BAR; PG8_MMA(1, 1, At, B1); PG8_BAR;
            PG8_LDB(B0, 1, 0); PG8_SCHED; PG8_LDA(At, 1, 0); PG8_STAGE(PG8_SA(0, 1), a2 + hstep, voffA);
            PG8_WAIT_L(8); PG8_BAR; PG8_WAIT_L(0); PG8_MMA(0, 0, At, B0); PG8_BAR; PG8_SCHED;
            PG8_LDB(B1, 1, 1); PG8_STAGE(PG8_SB(1, 0), b3, voffB);
            PG8_BAR; PG8_WAIT_L(0); PG8_MMA(0, 1, At, B1); PG8_BAR;
            PG8_LDA(At, 1, 1); PG8_STAGE(PG8_SA(1, 0), a3, voffA);
            PG8_BAR; PG8_WAIT_L(0); PG8_MMA(1, 0, At, B0); PG8_BAR; PG8_SCHED;
            PG8_STAGE(PG8_SB(1, 1), b3 + hstep, voffB);
            PG8_WAIT_V(6); PG8_BAR; PG8_MMA(1, 1, At, B1); PG8_BAR;
            }
        }
        if constexpr (ALIGN_EPI) { if (wr == 0) PG8_BAR; }
        if constexpr (!Epi::AFTER_DRAIN) { E(acc, cur, wr, wc, fr, fq); S.done(cur); }
        if (!has_next) break;
#pragma unroll
        for (int a = 0; a < 2; ++a)
#pragma unroll
            for (int b = 0; b < 2; ++b)
#pragma unroll
                for (int m = 0; m < 4; ++m)
#pragma unroll
                    for (int n = 0; n < 2; ++n) acc[a][b][m][n] = (f32x4){0.f, 0.f, 0.f, 0.f};
        cur = nxt; cA = nA; cB = nB; ++ui;
        if constexpr (ALIGN_EPI) { if (wr == 1) PG8_BAR; }
    }
    PG8_WAIT_V(0);
    if constexpr (!ALIGN_EPI) { if (wr == 0) PG8_BAR; }
    PG8_BAR;
    if constexpr (Epi::AFTER_DRAIN) { E.fused(acc, cur, wr, wc, fr, fq, lds, wid, lane); S.done(cur); }
#undef PG8_SA
#undef PG8_SB
#undef PG8_STAGE
#undef PG8_LDA
#undef PG8_LDB
#undef PG8_MMA
#undef PG8_WAIT_V
#undef PG8_WAIT_L
#undef PG8_BAR
#undef PG8_SCHED
}
}
#ifndef MK_N_LAUNCHES
#define MK_N_LAUNCHES 1
#endif
constexpr int NWAVES = 8, NTHREADS = 512;
constexpr int M = 16384, SEQ = 2048, D = 1024, FF = 2816, NGU = 2 * FF, NIN = 3336, NINP = 3584, PP = 3336, NLORA = 1536, KLORA = 256;
constexpr int NPHASE = 12;
constexpr size_t MiB = 1u << 20;
constexpr size_t WS_PART = 1 * MiB, WS_BONUS = 2 * MiB, WS_GC = 3 * MiB, WS_W1GU = 4 * MiB, WS_W1D = 15 * MiB, WS_WIN = 21 * MiB, WS_WOUT = 36 * MiB, WS_W2D = 38 * MiB, WS_WL = 44 * MiB;
constexpr size_t WS_CS = 4 * MiB;
constexpr size_t WS_CD = 3 * MiB + 512 * 1024;
constexpr size_t WS_XG = 48 * MiB;
constexpr size_t WS_P = 80 * MiB;
constexpr size_t WS_Y = 185 * MiB;
constexpr size_t WS_G = 217 * MiB;
constexpr size_t WS_LIN = 233 * MiB;
constexpr size_t WS_END = 249 * MiB;
constexpr int LDS_BYTES = 147456;

#define LAS __attribute__((address_space(3)))
typedef unsigned short bf16;
typedef unsigned v4u __attribute__((ext_vector_type(4)));
typedef unsigned v2u __attribute__((ext_vector_type(2)));
typedef float f32x4 __attribute__((ext_vector_type(4)));
typedef short bf16x8 __attribute__((ext_vector_type(8)));
#define LDS_WAIT() asm volatile("s_waitcnt lgkmcnt(0)" ::: "memory")
using pg8::cvt_pk_bf16;
__device__ __forceinline__ float bf_lo(unsigned u) { return __builtin_bit_cast(float, u << 16); }
__device__ __forceinline__ float bf_hi(unsigned u) { return __builtin_bit_cast(float, u & 0xffff0000u); }
__device__ __forceinline__ float bf1(bf16 s) { return __builtin_bit_cast(float, (unsigned)s << 16); }
__device__ __forceinline__ bf16 f2bf(float f) { return (bf16)(cvt_pk_bf16(f, 0.f) & 0xffffu); }
__device__ __forceinline__ f32x4 bf4(v2u u) { return (f32x4){bf_lo(u.x), bf_hi(u.x), bf_lo(u.y), bf_hi(u.y)}; }
__device__ __forceinline__ float sigm(float x) { return __builtin_amdgcn_rcpf(1.0f + __expf(-x)); }
__device__ __forceinline__ float wave_sum(float v) {
#pragma unroll
    for (int o = 1; o < 64; o <<= 1) v += __shfl_xor(v, o);
    return v;
}
template <int CTRL> __device__ __forceinline__ float dppf(float x) { return __builtin_bit_cast(float, __builtin_amdgcn_update_dpp(0, __builtin_bit_cast(int, x), CTRL, 0xf, 0xf, true)); }
__device__ __forceinline__ float allred16(float x) { x += dppf<0xB1>(x); x += dppf<0x4E>(x); x += dppf<0x124>(x); x += dppf<0x128>(x); return x; }

struct TrItem { const float* W; bf16* dst; const float* gk; int N, dpitch; };
__device__ __forceinline__ void tr_load(const TrItem& it, f32x4 (&v)[8]) {
#pragma unroll
    for (int i = 0; i < 8; ++i) { v[i] = it.N ? *(const f32x4*)(it.W + (size_t)i * it.N) : (f32x4){0.f, 0.f, 0.f, 0.f}; if (it.gk) v[i] = v[i] * it.gk[i]; }
}
__device__ __forceinline__ void tr_store(const TrItem& it, const f32x4 (&v)[8]) {
#pragma unroll
    for (int j = 0; j < 4; ++j) { v4u o; o.x = cvt_pk_bf16(v[0][j], v[1][j]); o.y = cvt_pk_bf16(v[2][j], v[3][j]); o.z = cvt_pk_bf16(v[4][j], v[5][j]); o.w = cvt_pk_bf16(v[6][j], v[7][j]);
        *(v4u*)(it.dst + (size_t)j * it.dpitch) = o; }
}
__device__ __forceinline__ TrItem tr_make(const float* W, int N, int kb, int nb, bf16* WT, int dpitch, int roff, int dk0, int mode, int up, int lane, const float* gain = nullptr) {
    const int ng = lane & 15, kg = lane >> 4, n = 64 * nb + 4 * ng, k = 32 * kb + 8 * kg;
    TrItem t; t.N = (n < N) ? N : 0; t.W = W + (size_t)k * N + n; t.dpitch = dpitch; t.gk = gain ? gain + k : nullptr;
    const int drow = mode ? (256 * (n >> 7) + 128 * up + (n & 127)) : (n + roff);
    t.dst = WT + (size_t)drow * dpitch + dk0 + k; return t;
}
constexpr int TR_I_GU = 44 * 32, TR_I_DN = 16 * 88, TR_I_IN = 56 * 32, TR_I_OUT = 16 * 32;
constexpr int TR_P0_ITEMS = 4 * TR_I_GU + TR_I_IN + TR_I_OUT + 64;
__device__ __forceinline__ TrItem p0_decode(int r, const float* const* in, unsigned char* ws, int lane) {
    bf16* W1GU = (bf16*)(ws + WS_W1GU); bf16* W1D = (bf16*)(ws + WS_W1D); bf16* WIN = (bf16*)(ws + WS_WIN); bf16* WOUT = (bf16*)(ws + WS_WOUT); bf16* W2D = (bf16*)(ws + WS_W2D); bf16* WL = (bf16*)(ws + WS_WL);
    if (r < 2 * TR_I_GU) { const int up = r >= TR_I_GU; r -= up * TR_I_GU; return tr_make(in[2 + up], FF, r / 44, r % 44, W1GU, D, 0, 0, 1, up, lane); } r -= 2 * TR_I_GU;
    if (r < TR_I_DN) return tr_make(in[4], D, r / 16, r % 16, W1D, FF, 0, 0, 0, 0, lane); r -= TR_I_DN;
    if (r < TR_I_IN) return tr_make(in[6], NIN, r / 56, r % 56, WIN, D, 0, 0, 0, 0, lane, in[5]); r -= TR_I_IN;
    if (r < TR_I_OUT) return tr_make(in[24], D, r / 16, r % 16, WOUT, D, 0, 0, 0, 0, lane); r -= TR_I_OUT;
    if (r < TR_I_DN) return tr_make(in[28], D, r / 16, r % 16, W2D, FF, 0, 0, 0, 0, lane); r -= TR_I_DN;
    if (r < 16) return tr_make(in[9], 512, r / 8, r % 8, WL, KLORA, 0, 0, 0, 0, lane); r -= 16;
    if (r < 16) return tr_make(in[11], 512, r / 8, r % 8, WL, KLORA, 512, 64, 0, 0, lane); r -= 16;
    return tr_make(in[12], 512, r / 8, r % 8, WL, KLORA, 1024, 128, 0, 0, lane);
}
__device__ __forceinline__ void p1_tail_copies(const float* const* in, unsigned char* ws, int tw, int NTW, int tthr, int NTT, int lane) {
    bf16* WL = (bf16*)(ws + WS_WL);
    for (int it = 2 * TR_I_GU + tw; it < TR_P0_ITEMS; it += 2 * NTW) {
        const TrItem a = p0_decode(it, in, ws, lane); const bool hasb = it + NTW < TR_P0_ITEMS; const TrItem b = p0_decode(hasb ? it + NTW : it, in, ws, lane);
        f32x4 va[8], vb[8]; tr_load(a, va); tr_load(b, vb); tr_store(a, va); if (hasb) tr_store(b, vb);
    }
    for (int id = tthr; id < NLORA * 32; id += NTT) { const int row = id >> 5, col = 8 * (id & 31);
        const bool nz = (row < 512) ? (col < 64) : (row < 1024 ? (col >= 64 && col < 128) : (col >= 128));
        if (!nz) *(v4u*)(WL + (size_t)row * KLORA + col) = (v4u){0u, 0u, 0u, 0u}; }
}
__device__ __forceinline__ void p0_prologue(LAS unsigned char* lds, const float* const* in, unsigned char* ws, int vcu, int G, int tid, int wave, int lane) {
    const int gw = vcu * NWAVES + wave, NGW = G * NWAVES;
    bf16* WL = (bf16*)(ws + WS_WL);
    for (int it = gw; it < 2 * TR_I_GU; it += 2 * NGW) {
        const TrItem a = p0_decode(it, in, ws, lane); const bool hasb = it + NGW < 2 * TR_I_GU; const TrItem b = p0_decode(hasb ? it + NGW : it, in, ws, lane);
        f32x4 va[8], vb[8]; tr_load(a, va); tr_load(b, vb); tr_store(a, va); if (hasb) tr_store(b, vb);
    }
    const float* x = in[0]; const float* g1 = in[1]; bf16* XG = (bf16*)(ws + WS_XG);
    f32x4 gv[4];
#pragma unroll
    for (int j = 0; j < 4; ++j) gv[j] = ((const f32x4*)g1)[64 * j + lane];
    for (int m = gw; m < M; m += 2 * NGW) {
        const int m2 = m + NGW;
        const f32x4* xa = (const f32x4*)(x + (size_t)m * D) + lane; const f32x4* xb = (const f32x4*)(x + (size_t)m2 * D) + lane; f32x4 va[4], vb[4]; float sa = 0.f, sb = 0.f;
#pragma unroll
        for (int j = 0; j < 4; ++j) { va[j] = xa[64 * j]; vb[j] = xb[64 * j]; }
#pragma unroll
        for (int j = 0; j < 4; ++j) { sa += (va[j].x * va[j].x + va[j].y * va[j].y) + (va[j].z * va[j].z + va[j].w * va[j].w); sb += (vb[j].x * vb[j].x + vb[j].y * vb[j].y) + (vb[j].z * vb[j].z + vb[j].w * vb[j].w); }
        const float ra = __builtin_amdgcn_rsqf(wave_sum(sa) * (1.f / D) + 1e-6f), rb = __builtin_amdgcn_rsqf(wave_sum(sb) * (1.f / D) + 1e-6f);
        v2u* oa = (v2u*)(XG + (size_t)m * D) + lane; v2u* ob = (v2u*)(XG + (size_t)m2 * D) + lane;
#pragma unroll
        for (int j = 0; j < 4; ++j) { const f32x4 wa = va[j] * ra * gv[j], wb = vb[j] * rb * gv[j]; v2u o; o.x = cvt_pk_bf16(wa.x, wa.y); o.y = cvt_pk_bf16(wa.z, wa.w); oa[64 * j] = o;
            v2u o2; o2.x = cvt_pk_bf16(wb.x, wb.y); o2.y = cvt_pk_bf16(wb.z, wb.w); ob[64 * j] = o2; }
    }
}
__device__ __forceinline__ void p4_lora_in(const bf16* P, const float* mu, bf16* LIN, int gtid, int NT) {
    v4u cur[4], prv[4];
#pragma unroll
    for (int k = 0; k < 4; ++k) { const int idx = gtid + k * NT; const int m = idx >> 5, cgp = idx & 31, t = m & (SEQ - 1);
        const bf16* pc = P + (size_t)m * PP + 1536 + 8 * cgp; cur[k] = *(const v4u*)pc; prv[k] = (v4u){0u, 0u, 0u, 0u}; if (t) prv[k] = *(const v4u*)(pc - PP); }
    const int cgp = gtid & 31;
    const f32x4 m0 = *(const f32x4*)(mu + 1536 + 8 * cgp), m1 = *(const f32x4*)(mu + 1540 + 8 * cgp);
#pragma unroll
    for (int k = 0; k < 4; ++k) { const int idx = gtid + k * NT; const int m = idx >> 5;
        float xv[8];
#pragma unroll
        for (int e = 0; e < 4; ++e) { const unsigned cu = cur[k][e], pu = prv[k][e]; const float c0 = bf_lo(cu), c1 = bf_hi(cu), p0 = bf_lo(pu), p1 = bf_hi(pu);
            const float mA = (e < 2) ? m0[2 * e] : m1[2 * e - 4], mB = (e < 2) ? m0[2 * e + 1] : m1[2 * e - 3];
            xv[2 * e] = c0 + (p0 - c0) * mA; xv[2 * e + 1] = c1 + (p1 - c1) * mB; }
        if (cgp < 8) {
#pragma unroll
            for (int e = 0; e < 8; ++e) xv[e] = 2.f * sigm(2.f * xv[e]) - 1.f;
        } else if (cgp >= 16) {
#pragma unroll
            for (int e = 0; e < 8; ++e) xv[e] = sigm(xv[e]);
        }
        v4u o; o.x = cvt_pk_bf16(xv[0], xv[1]); o.y = cvt_pk_bf16(xv[2], xv[3]); o.z = cvt_pk_bf16(xv[4], xv[5]); o.w = cvt_pk_bf16(xv[6], xv[7]);
        *(v4u*)(LIN + (size_t)m * KLORA + 8 * cgp) = o;
    }
}
__device__ __forceinline__ int perm_pos(int s) { return (s & 32) + (((s & 15) >> 2) << 3) + (((s >> 4) & 1) << 2) + (s & 3); }
__device__ __forceinline__ bf16x8 pack8(const f32x4 a, const f32x4 b) { v4u u; u.x = cvt_pk_bf16(a[0], a[1]); u.y = cvt_pk_bf16(a[2], a[3]); u.z = cvt_pk_bf16(b[0], b[1]); u.w = cvt_pk_bf16(b[2], b[3]); return __builtin_bit_cast(bf16x8, u); }
#define MFMA16(a, b, c) __builtin_amdgcn_mfma_f32_16x16x32_bf16((a), (b), (c), 0, 0, 0)
constexpr int RW_PITCH = 72;
struct RwIn { v4u cr, ck, cv, qr, qk, qv, ce, ca; };
__device__ __forceinline__ void rwkv_chunk_load(RwIn& I, int unit, const bf16* P, const bf16* EA, int tid) {
    const int h = unit & 7, c = (unit >> 3) & 31, b = unit >> 8; const size_t m0 = (size_t)b * SEQ + 64 * c;
    const int t = tid >> 3, jg = tid & 7, ch = 64 * h + 8 * jg;
    const bf16* pc = P + (m0 + t) * PP + ch;
    I.cr = *(const v4u*)pc; I.ck = *(const v4u*)(pc + 512); I.cv = *(const v4u*)(pc + 1024);
    I.ce = *(const v4u*)(EA + (m0 + t) * 1024 + ch); I.ca = *(const v4u*)(EA + (m0 + t) * 1024 + 512 + ch);
}
__device__ __forceinline__ void rwkv_chunk_load_prev(RwIn& I, int unit, const bf16* P, int tid) {
    const int h = unit & 7, c = (unit >> 3) & 31, b = unit >> 8; const size_t m0 = (size_t)b * SEQ + 64 * c;
    const int t = tid >> 3, jg = tid & 7, ch = 64 * h + 8 * jg;
    const bf16* pc = P + (m0 + t) * PP + ch;
    I.qr = (v4u){0u, 0u, 0u, 0u}; I.qk = I.qr; I.qv = I.qr;
    if (64 * c + t > 0) { I.qr = *(const v4u*)(pc - PP); I.qk = *(const v4u*)(pc - PP + 512); I.qv = *(const v4u*)(pc - PP + 1024); }
}
__device__ __forceinline__ void rwkv_chunk_unit(LAS unsigned char* lds, int unit, RwIn& I, int next_unit, const bf16* P, bf16* EA, bf16* Y, float* BON, float* GCg, unsigned* SLg,
                                                int tid, int wave, int lane, bool st = true, int stop = 0) {
    const int h = unit & 7, c = (unit >> 3) & 31, b = unit >> 8;
    const size_t m0 = (size_t)b * SEQ + 64 * c;
    LAS bf16* At = (LAS bf16*)(lds); LAS bf16* Rt = (LAS bf16*)(lds + 9216); LAS bf16* Bm = (LAS bf16*)(lds + 18432); LAS bf16* Km = (LAS bf16*)(lds + 27648);
    LAS bf16* BmT = (LAS bf16*)(lds + 36864); LAS bf16* KmT = (LAS bf16*)(lds + 46080); LAS bf16* VT = (LAS bf16*)(lds + 55296);
    LAS bf16* AabT = (LAS bf16*)(lds + 64512); LAS bf16* AkbT = (LAS bf16*)(lds + 73728); LAS bf16* AbrT = (LAS bf16*)(lds + 82944); LAS bf16* AkrT = (LAS bf16*)(lds + 92160);
    LAS float* AD = (LAS float*)(lds + 101376); LAS bf16* TdA = (LAS bf16*)(lds + 105472); LAS float* GC = (LAS float*)(lds + 109568); LAS float* WT = (LAS float*)(lds + 109824);
    const LAS float* PRM = (const LAS float*)(lds + 143872);
    const int r = lane & 15, q = lane >> 4;
    {
        const int t = tid >> 3, jg = tid & 7;
        rwkv_chunk_load_prev(I, unit, P, tid);
        const v4u cr = I.cr, ck = I.ck, cv = I.cv, qr = I.qr, qk = I.qk, qv = I.qv, ce = I.ce, ca = I.ca;
        float rr[8], kx[8], vv[8], ee[8], aa[8], kk[8], km[8], bv[8], E[8];
        float ss = 0.f, bon = 0.f;
#pragma unroll
        for (int x = 0; x < 8; ++x) {
            const unsigned ur = cr[x >> 1], uk = ck[x >> 1], uv = cv[x >> 1], pr = qr[x >> 1], pk = qk[x >> 1], pv = qv[x >> 1], ue = ce[x >> 1], ua = ca[x >> 1];
            const float r0 = (x & 1) ? bf_hi(ur) : bf_lo(ur), k0 = (x & 1) ? bf_hi(uk) : bf_lo(uk), v0 = (x & 1) ? bf_hi(uv) : bf_lo(uv);
            const float r1 = (x & 1) ? bf_hi(pr) : bf_lo(pr), k1 = (x & 1) ? bf_hi(pk) : bf_lo(pk), v1 = (x & 1) ? bf_hi(pv) : bf_lo(pv);
            const LAS float* pj = PRM + 8 * jg + x;
            const float ep = ((x & 1) ? bf_hi(ue) : bf_lo(ue)) + pj[384], ap = ((x & 1) ? bf_hi(ua) : bf_lo(ua)) + pj[448];
            rr[x] = r0 + (r1 - r0) * pj[0]; kx[x] = k0 + (k1 - k0) * pj[64]; vv[x] = v0 + (v1 - v0) * pj[128];
            ee[x] = 0.60653066f * sigm(ep); aa[x] = sigm(ap);
            kk[x] = kx[x] * pj[192]; ss += kk[x] * kk[x];
            km[x] = kx[x] * (1.0f + (aa[x] - 1.0f) * pj[256]);
            bon += rr[x] * km[x] * pj[320];
            E[x] = ee[x];
        }
        ss += __shfl_xor(ss, 1); ss += __shfl_xor(ss, 2); ss += __shfl_xor(ss, 4);
        bon += __shfl_xor(bon, 1); bon += __shfl_xor(bon, 2); bon += __shfl_xor(bon, 4);
        if (jg == 0 && st) BON[(m0 + t) * 8 + h] = bon;
        const float inv = 1.0f / fmaxf(sqrtf(ss), 1e-12f);
#pragma unroll
        for (int x = 0; x < 8; ++x) { kk[x] *= inv; bv[x] = kk[x] * aa[x]; }
#pragma unroll
        for (int off = 8; off < 64; off <<= 1)
#pragma unroll
            for (int x = 0; x < 8; ++x) { const float tv = __shfl_up(E[x], off); if (lane >= off) E[x] += tv; }
        if ((lane >> 3) == 7) {
#pragma unroll
            for (int x = 0; x < 8; ++x) WT[wave * 64 + 8 * jg + x] = E[x];
        }
        __syncthreads();
        for (int w2 = 0; w2 < wave; ++w2)
#pragma unroll
            for (int x = 0; x < 8; ++x) E[x] += WT[w2 * 64 + 8 * jg + x];
        float av[8], rv[8], bt[8], kt[8];
#pragma unroll
        for (int x = 0; x < 8; ++x) { const float gi = __expf(-E[x]), ge = __expf(-(E[x] - ee[x])), gp = __expf(E[x]);
            av[x] = -kk[x] * ge; rv[x] = rr[x] * gi; bt[x] = bv[x] * gp; kt[x] = km[x] * gp;
            if (t == 63) { GC[8 * jg + x] = gi; if (st) GCg[(size_t)unit * 64 + 8 * jg + x] = gi; } }
#define PK8(a_) (v4u){cvt_pk_bf16(a_[0], a_[1]), cvt_pk_bf16(a_[2], a_[3]), cvt_pk_bf16(a_[4], a_[5]), cvt_pk_bf16(a_[6], a_[7])}
        *(LAS v4u*)(At + t * RW_PITCH + 8 * jg) = PK8(av); *(LAS v4u*)(Rt + t * RW_PITCH + 8 * jg) = PK8(rv);
        *(LAS v4u*)(Bm + t * RW_PITCH + 8 * jg) = PK8(bt); *(LAS v4u*)(Km + t * RW_PITCH + 8 * jg) = PK8(kt);
#undef PK8
#pragma unroll
        for (int x = 0; x < 8; ++x) { BmT[(8 * jg + x) * RW_PITCH + perm_pos(t)] = f2bf(bt[x]); KmT[(8 * jg + x) * RW_PITCH + t] = f2bf(kt[x]); VT[(8 * jg + x) * RW_PITCH + t] = f2bf(vv[x]); }
    }
    if (next_unit >= 0) rwkv_chunk_load(I, next_unit, P, EA, tid);
    __syncthreads();
    if (stop == 1) return;
    {
        const int mat = wave >> 1; const LAS bf16* Atile = mat < 2 ? At : Rt; const LAS bf16* Btile = (mat & 1) ? Km : Bm;
        LAS bf16* dst = mat == 0 ? AabT : (mat == 1 ? AkbT : (mat == 2 ? AbrT : AkrT));
        const bool strict = mat < 2, perm = (mat & 1) == 0;
#pragma unroll
        for (int tbi = 0; tbi < 2; ++tbi) { const int tb = 2 * (wave & 1) + tbi;
            const bf16x8 a0 = *(const LAS bf16x8*)(Atile + (16 * tb + r) * RW_PITCH + 8 * q), a1 = *(const LAS bf16x8*)(Atile + (16 * tb + r) * RW_PITCH + 32 + 8 * q);
#pragma unroll
            for (int sb = 0; sb < 4; ++sb) {
                f32x4 acc = (f32x4){0.f, 0.f, 0.f, 0.f};
                if (sb <= tb) { acc = MFMA16(a0, *(const LAS bf16x8*)(Btile + (16 * sb + r) * RW_PITCH + 8 * q), acc); acc = MFMA16(a1, *(const LAS bf16x8*)(Btile + (16 * sb + r) * RW_PITCH + 32 + 8 * q), acc); }
                const int sx = 16 * sb + r, pos = perm ? perm_pos(sx) : sx;
#pragma unroll
                for (int jj = 0; jj < 4; ++jj) { const int tx = 16 * tb + 4 * q + jj; const bool keep = (sb <= tb) && (strict ? sx < tx : sx <= tx); const float v = keep ? acc[jj] : 0.f;
                    dst[tx * RW_PITCH + pos] = f2bf(v);
                    if (mat == 0 && sb == tb) AD[tb * 256 + (4 * q + jj) * 16 + r] = v; }
            }
        }
    }
    __syncthreads();
    if (stop == 2) return;
    if (wave < 4) {
        const LAS float* ad = AD + wave * 256; float X[16];
#pragma unroll
        for (int sx = 15; sx >= 0; --sx) { float x = (sx == r) ? 1.f : 0.f;
#pragma unroll
            for (int k = sx + 1; k < 16; ++k) x += ad[k * 16 + sx] * X[k];
            X[sx] = x; }
        LAS bf16* td = TdA + wave * 512 + r * 32;
        if (q == 0) {
#pragma unroll
            for (int kg = 0; kg < 4; ++kg) { v4u o; o.x = cvt_pk_bf16(X[4 * kg], X[4 * kg + 1]); o.y = cvt_pk_bf16(X[4 * kg + 2], X[4 * kg + 3]); o.z = 0u; o.w = 0u; *(LAS v4u*)(td + 8 * kg) = o; }
        }
    }
    f32x4 z[4], qy[4], gs[4];
    const bool vpart = wave >= 4; const int cb = wave & 3;
    if (vpart) {
        const bf16x8 v0 = *(const LAS bf16x8*)(VT + (16 * cb + r) * RW_PITCH + 8 * q), v1 = *(const LAS bf16x8*)(VT + (16 * cb + r) * RW_PITCH + 32 + 8 * q);
#pragma unroll
        for (int tb = 0; tb < 4; ++tb) { const int ro = (16 * tb + r) * RW_PITCH + 8 * q;
            f32x4 acc = (f32x4){0.f, 0.f, 0.f, 0.f}; acc = MFMA16(*(const LAS bf16x8*)(AkbT + ro), v0, acc); acc = MFMA16(*(const LAS bf16x8*)(AkbT + ro + 32), v1, acc); z[tb] = acc;
            acc = (f32x4){0.f, 0.f, 0.f, 0.f}; acc = MFMA16(*(const LAS bf16x8*)(AkrT + ro), v0, acc); acc = MFMA16(*(const LAS bf16x8*)(AkrT + ro + 32), v1, acc); qy[tb] = acc;
            acc = (f32x4){0.f, 0.f, 0.f, 0.f}; acc = MFMA16(*(const LAS bf16x8*)(KmT + ro), v0, acc); acc = MFMA16(*(const LAS bf16x8*)(KmT + ro + 32), v1, acc); gs[tb] = acc; }
    } else {
#pragma unroll
        for (int tb = 0; tb < 4; ++tb)
#pragma unroll
            for (int jj = 0; jj < 4; ++jj) { const int tx = 16 * tb + 4 * q + jj; z[tb][jj] = bf1(At[tx * RW_PITCH + 16 * cb + r]); qy[tb][jj] = bf1(Rt[tx * RW_PITCH + 16 * cb + r]); gs[tb][jj] = 0.f; }
    }
    __syncthreads();
    if (stop == 3) return;
    const f32x4 zero4 = (f32x4){0.f, 0.f, 0.f, 0.f};
#pragma unroll
    for (int tb = 0; tb < 4; ++tb) {
        f32x4 rhs = z[tb];
        if (tb >= 1) rhs = MFMA16(*(const LAS bf16x8*)(AabT + (16 * tb + r) * RW_PITCH + 8 * q), pack8(z[0], tb >= 2 ? z[1] : zero4), rhs);
        if (tb >= 3) rhs = MFMA16(*(const LAS bf16x8*)(AabT + (16 * tb + r) * RW_PITCH + 32 + 8 * q), pack8(z[2], zero4), rhs);
        z[tb] = MFMA16(*(const LAS bf16x8*)(TdA + tb * 512 + r * 32 + 8 * q), pack8(rhs, zero4), zero4);
    }
    const bf16x8 zb0 = pack8(z[0], z[1]), zb1 = pack8(z[2], z[3]);
#pragma unroll
    for (int tb = 0; tb < 4; ++tb) { const int ro = (16 * tb + r) * RW_PITCH + 8 * q;
        qy[tb] = MFMA16(*(const LAS bf16x8*)(AbrT + ro), zb0, qy[tb]); qy[tb] = MFMA16(*(const LAS bf16x8*)(AbrT + ro + 32), zb1, qy[tb]);
        gs[tb] = MFMA16(*(const LAS bf16x8*)(BmT + ro), zb0, gs[tb]); gs[tb] = MFMA16(*(const LAS bf16x8*)(BmT + ro + 32), zb1, gs[tb]);
#pragma unroll
        for (int jj = 0; jj < 4; ++jj) gs[tb][jj] *= GC[16 * tb + 4 * q + jj]; }
    LAS bf16* QTs = At; LAS bf16* GTs = Rt; LAS bf16* YLs = Bm;
    if (vpart) {
#pragma unroll
        for (int tb = 0; tb < 4; ++tb) {
#pragma unroll
            for (int jj = 0; jj < 4; ++jj) YLs[(16 * tb + 4 * q + jj) * RW_PITCH + 16 * cb + r] = f2bf(qy[tb][jj]);
            v2u o; o.x = cvt_pk_bf16(gs[tb][0], gs[tb][1]); o.y = cvt_pk_bf16(gs[tb][2], gs[tb][3]);
            if (st) *(v2u*)(SLg + ((((size_t)unit * 4 + cb) * 4 + tb) * 64 + lane) * 2) = o; }
    } else {
        const int pj = perm_pos(16 * cb + r);
#pragma unroll
        for (int tb = 0; tb < 4; ++tb)
#pragma unroll
            for (int jj = 0; jj < 4; ++jj) { const int rw = (16 * tb + 4 * q + jj) * RW_PITCH + pj; QTs[rw] = f2bf(qy[tb][jj]); GTs[rw] = f2bf(gs[tb][jj]); }
    }
    __syncthreads();
    if (st) { const int row = tid >> 3, sg = 8 * (tid & 7); const size_t ro = (m0 + row) * 1024 + 64 * h + sg;
        *(v4u*)(EA + ro + 512) = *(const LAS v4u*)(QTs + row * RW_PITCH + sg); *(v4u*)(EA + ro) = *(const LAS v4u*)(GTs + row * RW_PITCH + sg); *(v4u*)(Y + ro) = *(const LAS v4u*)(YLs + row * RW_PITCH + sg); }
    __syncthreads();
}
struct SeqS { bf16x8 ga[2][2]; v2u sl[2]; f32x4 gc[2]; };
struct SeqY { bf16x8 qa[2][2]; bf16 yl[2][4]; };
#define SEQS_LOAD(S_, c_, HF_) do { const int cc_ = (c_) < 32 ? (c_) : 31; const int unit_ = (b * 32 + cc_) * 8 + h; const size_t mm_ = (size_t)b * SEQ + 64 * cc_; \
    _Pragma("unroll") for (int t2 = 0; t2 < 2; ++t2) { const int tb = 2 * (HF_) + t2; \
        const bf16* grow_ = EA + (mm_ + 16 * tb + r) * 1024 + 64 * h + 8 * q; S_.ga[t2][0] = *(const bf16x8*)grow_; S_.ga[t2][1] = *(const bf16x8*)(grow_ + 32); \
        S_.sl[t2] = *(const v2u*)(SLg + ((((size_t)unit_ * 4 + ib) * 4 + tb) * 64 + lane) * 2); \
        S_.gc[t2] = *(const f32x4*)(GCg + (size_t)unit_ * 64 + 16 * tb + 4 * q); } } while (0)
#define SEQS_COMP(S_, HF_) do { \
    _Pragma("unroll") for (int t2 = 0; t2 < 2; ++t2) { const int tb = 2 * (HF_) + t2; \
        f32x4 sv = bf4(S_.sl[t2]) + S_.gc[t2] * sT[tb]; \
        sv = MFMA16(S_.ga[t2][0], bh0, sv); sv = MFMA16(S_.ga[t2][1], bh1, sv); sv = MFMA16(S_.ga[t2][0], bl0, sv); sv = MFMA16(S_.ga[t2][1], bl1, sv); \
        sT[tb] = sv; } } while (0)
#define SEQS_SPLIT(c_) do { f32x4 hi[4], lo[4]; \
    _Pragma("unroll") for (int jb = 0; jb < 4; ++jb) _Pragma("unroll") for (int jj = 0; jj < 4; ++jj) { const float hv = bf1(f2bf(sT[jb][jj])); hi[jb][jj] = hv; lo[jb][jj] = sT[jb][jj] - hv; } \
    bh0 = pack8(hi[0], hi[1]); bh1 = pack8(hi[2], hi[3]); bl0 = pack8(lo[0], lo[1]); bl1 = pack8(lo[2], lo[3]); \
    LAS bf16x8* slot_ = (LAS bf16x8*)(lds + (c_) * 4096) + lane; slot_[0] = bh0; slot_[64] = bh1; slot_[128] = bl0; slot_[192] = bl1; \
    asm volatile("s_waitcnt lgkmcnt(0)" ::: "memory"); *prog = (unsigned)(c_) + 1u; } while (0)
#define SEQY_LOAD(S_, c_, HF_) do { const int cc_ = (c_) < 32 ? (c_) : 31; const size_t mm_ = (size_t)b * SEQ + 64 * cc_; \
    _Pragma("unroll") for (int t2 = 0; t2 < 2; ++t2) { const int tb = 2 * (HF_) + t2; \
        const bf16* qrow_ = EA + (mm_ + 16 * tb + r) * 1024 + 512 + 64 * h + 8 * q; S_.qa[t2][0] = *(const bf16x8*)qrow_; S_.qa[t2][1] = *(const bf16x8*)(qrow_ + 32); \
        _Pragma("unroll") for (int jj = 0; jj < 4; ++jj) S_.yl[t2][jj] = Y[(mm_ + 16 * tb + 4 * q + jj) * 1024 + 64 * h + 16 * ib + r]; } } while (0)
#define SEQY_WAIT(c_) do { unsigned sp_ = 0; while (*prog < (unsigned)(c_) + 1u) { __builtin_amdgcn_s_sleep(1); if (++sp_ > (1u << 24)) break; } \
    asm volatile("" ::: "memory"); \
    const LAS bf16x8* slot_ = (const LAS bf16x8*)(lds + (c_) * 4096) + lane; bh0 = slot_[0]; bh1 = slot_[64]; bl0 = slot_[128]; bl1 = slot_[192]; } while (0)
#define SEQY_COMP(S_, c_, HF_) do { const size_t m0 = (size_t)b * SEQ + 64 * (c_); \
    _Pragma("unroll") for (int t2 = 0; t2 < 2; ++t2) { const int tb = 2 * (HF_) + t2; \
        f32x4 y; _Pragma("unroll") for (int jj = 0; jj < 4; ++jj) y[jj] = bf1(S_.yl[t2][jj]); \
        y = MFMA16(S_.qa[t2][0], bh0, y); y = MFMA16(S_.qa[t2][1], bh1, y); y = MFMA16(S_.qa[t2][0], bl0, y); y = MFMA16(S_.qa[t2][1], bl1, y); \
        if (st) { _Pragma("unroll") for (int jj = 0; jj < 4; ++jj) Y[(m0 + 16 * tb + 4 * q + jj) * 1024 + 64 * h + 16 * ib + r] = f2bf(y[jj]); } } } while (0)
__device__ __forceinline__ void rwkv_seq_state(LAS unsigned char* lds, volatile LAS unsigned* prog, int job, const bf16* EA, const float* GCg, const unsigned* SLg, int lane) {
    const int ib = job & 3, h = (job >> 2) & 7, b = job >> 5; const int r = lane & 15, q = lane >> 4;
    f32x4 sT[4];
#pragma unroll
    for (int jb = 0; jb < 4; ++jb) sT[jb] = (f32x4){0.f, 0.f, 0.f, 0.f};
    bf16x8 bh0, bh1, bl0, bl1;
    SeqS B0, B1, B2, B3;
    SEQS_LOAD(B0, 0, 0); SEQS_LOAD(B1, 0, 1); SEQS_LOAD(B2, 1, 0);
    for (int c = 0; c < 32; c += 2) {
        SEQS_LOAD(B3, c + 1, 1); SEQS_SPLIT(c); SEQS_COMP(B0, 0);
        SEQS_LOAD(B0, c + 2, 0); SEQS_COMP(B1, 1);
        SEQS_LOAD(B1, c + 2, 1); SEQS_SPLIT(c + 1); SEQS_COMP(B2, 0);
        SEQS_LOAD(B2, c + 3, 0); SEQS_COMP(B3, 1);
    }
}
__device__ __forceinline__ void rwkv_seq_out(LAS unsigned char* lds, volatile LAS unsigned* prog, int job, const bf16* EA, bf16* Y, int lane, bool st, int hf) {
    const int ib = job & 3, h = (job >> 2) & 7, b = job >> 5; const int r = lane & 15, q = lane >> 4;
    bf16x8 bh0, bh1, bl0, bl1;
    SeqY B0, B1, B2, B3;
    SEQY_LOAD(B0, 0, hf); SEQY_LOAD(B1, 1, hf); SEQY_LOAD(B2, 2, hf);
    for (int c = 0; c < 32; c += 4) {
        SEQY_LOAD(B3, c + 3, hf); SEQY_WAIT(c);     SEQY_COMP(B0, c, hf);
        SEQY_LOAD(B0, c + 4, hf); SEQY_WAIT(c + 1); SEQY_COMP(B1, c + 1, hf);
        SEQY_LOAD(B1, c + 5, hf); SEQY_WAIT(c + 2); SEQY_COMP(B2, c + 2, hf);
        SEQY_LOAD(B2, c + 6, hf); SEQY_WAIT(c + 3); SEQY_COMP(B3, c + 3, hf);
    }
}
#undef SEQS_LOAD
#undef SEQS_COMP
#undef SEQS_SPLIT
#undef SEQY_LOAD
#undef SEQY_WAIT
#undef SEQY_COMP
__device__ __forceinline__ void ssd_chunk_group(LAS unsigned char* lds, int unit, const bf16* P, bf16* Y, bf16* CS, float* CD, const float* dt_bias, const float* a_log, const float* d_skip, int tid, int wave, int lane) {
    const int g = unit & 1, c = (unit >> 1) & 31, b = unit >> 6;
    LAS bf16* Cn = (LAS bf16*)(lds); LAS bf16* Bn = (LAS bf16*)(lds + 17408); LAS bf16* BT = (LAS bf16*)(lds + 34816); LAS bf16* RAWX = (LAS bf16*)(lds + 53248);
    LAS unsigned char* U = lds + 88640;
    LAS bf16* RAWBC = (LAS bf16*)U; LAS bf16* XT = (LAS bf16*)U; LAS bf16* XdT = (LAS bf16*)(U + 9216); LAS bf16* Xr = (LAS bf16*)(U + 18432); LAS bf16* Ms = (LAS bf16*)(U + 26624);
    LAS float* ACS4 = (LAS float*)(lds + 124480); const LAS float* CW = (const LAS float*)(lds + 133632);
    const int r = lane & 15, q = lane >> 4;
    const size_t m0 = (size_t)b * SEQ + 64 * c;
    {
        const int chb = lane < 16 ? 2816 + 128 * g + 8 * lane : (lane < 32 ? 3072 + 128 * g + 8 * (lane - 16) : 2304 + 256 * g + 8 * (lane - 32));
        const bf16* pbase = P + m0 * PP + chb;
        v4u rv[9];
#pragma unroll
        for (int i = 0; i < 9; ++i) { const int rr = wave + 8 * i; rv[i] = (v4u){0u, 0u, 0u, 0u}; if (rr < 67 && 64 * c + rr - 3 >= 0) rv[i] = *(const v4u*)(pbase + (ptrdiff_t)(rr - 3) * PP); }
        LAS bf16* dstb = lane < 32 ? RAWBC + 8 * lane : RAWX + 8 * (lane - 32);
#pragma unroll
        for (int i = 0; i < 9; ++i) { const int rr = wave + 8 * i; if (rr < 67) *(LAS v4u*)(dstb + rr * 264) = rv[i]; }
    }
    float dt[4], dd[4], aend[4];
#pragma unroll
    for (int hh = 0; hh < 4; ++hh) { const int h = 4 * g + hh;
        const float xdt = bf1(P[(m0 + lane) * PP + 3328 + h]) + dt_bias[h]; dt[hh] = xdt > 20.f ? xdt : log1pf(__expf(xdt));
        float acs = dt[hh] * (-__expf(a_log[h]));
#pragma unroll
        for (int o = 1; o < 64; o <<= 1) { const float t = __shfl_up(acs, o); if (lane >= o) acs += t; }
        aend[hh] = __shfl(acs, 63);
        if (wave == 0) ACS4[hh * 64 + lane] = acs;
        dd[hh] = dt[hh] * __expf(aend[hh] - acs); }
    __syncthreads();
#pragma unroll
    for (int i = 0; i < 4; ++i) { const int cgp = wave + 8 * i;
        const LAS float* cwl = CW + cgp * 40;
        float o8[8];
        { const f32x4 b0 = *(const LAS f32x4*)(cwl + 32), b1 = *(const LAS f32x4*)(cwl + 36);
#pragma unroll
          for (int e = 0; e < 4; ++e) { o8[e] = b0[e]; o8[4 + e] = b1[e]; } }
#pragma unroll
        for (int k = 0; k < 4; ++k) { const v4u iv = *(const LAS v4u*)(RAWBC + (lane + k) * 264 + 8 * cgp);
            const f32x4 w0v = *(const LAS f32x4*)(cwl + 8 * k), w1v = *(const LAS f32x4*)(cwl + 8 * k + 4);
            o8[0] += w0v[0] * bf_lo(iv[0]); o8[1] += w0v[1] * bf_hi(iv[0]); o8[2] += w0v[2] * bf_lo(iv[1]); o8[3] += w0v[3] * bf_hi(iv[1]);
            o8[4] += w1v[0] * bf_lo(iv[2]); o8[5] += w1v[1] * bf_hi(iv[2]); o8[6] += w1v[2] * bf_lo(iv[3]); o8[7] += w1v[3] * bf_hi(iv[3]); }
#pragma unroll
        for (int e = 0; e < 8; ++e) o8[e] = o8[e] * sigm(o8[e]);
        v4u o; o.x = cvt_pk_bf16(o8[0], o8[1]); o.y = cvt_pk_bf16(o8[2], o8[3]); o.z = cvt_pk_bf16(o8[4], o8[5]); o.w = cvt_pk_bf16(o8[6], o8[7]);
        if (cgp < 16) { const int n = 8 * cgp; *(LAS v4u*)(Bn + lane * 136 + n) = o;
#pragma unroll
            for (int e = 0; e < 8; ++e) BT[(n + e) * 72 + lane] = f2bf(o8[e]);
        } else { const int n = 8 * (cgp - 16); *(LAS v4u*)(Cn + lane * 136 + n) = o; }
    }
    __syncthreads();
    f32x4 sc[2];
    {
        const int lb = wave >> 1;
#pragma unroll
        for (int sbi = 0; sbi < 2; ++sbi) { const int sb = 2 * (wave & 1) + sbi; sc[sbi] = (f32x4){0.f, 0.f, 0.f, 0.f};
            if (sb <= lb) {
#pragma unroll
                for (int kk = 0; kk < 4; ++kk) sc[sbi] = MFMA16(*(const LAS bf16x8*)(Cn + (16 * lb + r) * 136 + 32 * kk + 8 * q), *(const LAS bf16x8*)(Bn + (16 * sb + r) * 136 + 32 * kk + 8 * q), sc[sbi]);
            } }
    }
#pragma unroll
    for (int hh = 0; hh < 4; ++hh) { const int h = 4 * g + hh; const int unit_h = (b * 32 + c) * 8 + h;
        {
            const int cgx = 8 * hh + wave; const LAS float* cwl = CW + (32 + cgx) * 40;
            float o8[8];
            { const f32x4 b0 = *(const LAS f32x4*)(cwl + 32), b1 = *(const LAS f32x4*)(cwl + 36);
#pragma unroll
              for (int e = 0; e < 4; ++e) { o8[e] = b0[e]; o8[4 + e] = b1[e]; } }
#pragma unroll
            for (int k = 0; k < 4; ++k) { const v4u iv = *(const LAS v4u*)(RAWX + (lane + k) * 264 + 8 * cgx);
                const f32x4 w0v = *(const LAS f32x4*)(cwl + 8 * k), w1v = *(const LAS f32x4*)(cwl + 8 * k + 4);
                o8[0] += w0v[0] * bf_lo(iv[0]); o8[1] += w0v[1] * bf_hi(iv[0]); o8[2] += w0v[2] * bf_lo(iv[1]); o8[3] += w0v[3] * bf_hi(iv[1]);
                o8[4] += w1v[0] * bf_lo(iv[2]); o8[5] += w1v[1] * bf_hi(iv[2]); o8[6] += w1v[2] * bf_lo(iv[3]); o8[7] += w1v[3] * bf_hi(iv[3]); }
#pragma unroll
            for (int e = 0; e < 8; ++e) o8[e] = o8[e] * sigm(o8[e]);
            v4u o; o.x = cvt_pk_bf16(o8[0], o8[1]); o.y = cvt_pk_bf16(o8[2], o8[3]); o.z = cvt_pk_bf16(o8[4], o8[5]); o.w = cvt_pk_bf16(o8[6], o8[7]);
#pragma unroll
            for (int e = 0; e < 8; ++e) { XT[(8 * wave + e) * 72 + lane] = f2bf(o8[e] * dt[hh]); XdT[(8 * wave + e) * 72 + lane] = f2bf(o8[e] * dd[hh]); }
            *(LAS v4u*)(Xr + lane * 64 + 8 * wave) = o;
        }
        {
            const int lb = wave >> 1; const LAS float* acsh = ACS4 + hh * 64;
#pragma unroll
            for (int sbi = 0; sbi < 2; ++sbi) { const int sb = 2 * (wave & 1) + sbi; const int sx = 16 * sb + r; const float as = acsh[sx];
#pragma unroll
                for (int j = 0; j < 4; ++j) { const int l = 16 * lb + 4 * q + j; const float v = (l >= sx && sb <= lb) ? sc[sbi][j] * __expf(acsh[l] - as) : 0.f; Ms[l * 72 + sx] = f2bf(v); } }
        }
        __syncthreads();
        {
            const int lb = wave >> 1, l = 16 * lb + r; const float dsk = d_skip[h];
            const bf16x8 m0v = *(const LAS bf16x8*)(Ms + l * 72 + 8 * q), m1v = *(const LAS bf16x8*)(Ms + l * 72 + 32 + 8 * q);
#pragma unroll
            for (int pbi = 0; pbi < 2; ++pbi) { const int pb = 2 * (wave & 1) + pbi;
                f32x4 acc = (f32x4){0.f, 0.f, 0.f, 0.f};
                acc = MFMA16(*(const LAS bf16x8*)(XT + (16 * pb + r) * 72 + 8 * q), m0v, acc); acc = MFMA16(*(const LAS bf16x8*)(XT + (16 * pb + r) * 72 + 32 + 8 * q), m1v, acc);
                const int p0 = 16 * pb + 4 * q; const f32x4 xv = bf4(*(const LAS v2u*)(Xr + l * 64 + p0));
                v2u o; o.x = cvt_pk_bf16(acc[0] + dsk * xv[0], acc[1] + dsk * xv[1]); o.y = cvt_pk_bf16(acc[2] + dsk * xv[2], acc[3] + dsk * xv[3]);
                *(v2u*)(Y + (m0 + l) * 1024 + 512 + 64 * h + p0) = o;
            }
            const int pb = wave & 3;
            const bf16x8 x0 = *(const LAS bf16x8*)(XdT + (16 * pb + r) * 72 + 8 * q), x1 = *(const LAS bf16x8*)(XdT + (16 * pb + r) * 72 + 32 + 8 * q);
            bf16* cs = CS + (size_t)unit_h * 8192 + (16 * pb + r) * 128;
#pragma unroll
            for (int i = 0; i < 4; ++i) { const int nb = 4 * (wave >> 2) + i;
                f32x4 acc = (f32x4){0.f, 0.f, 0.f, 0.f};
                acc = MFMA16(*(const LAS bf16x8*)(BT + (16 * nb + r) * 72 + 8 * q), x0, acc); acc = MFMA16(*(const LAS bf16x8*)(BT + (16 * nb + r) * 72 + 32 + 8 * q), x1, acc);
                v2u o; o.x = cvt_pk_bf16(acc[0], acc[1]); o.y = cvt_pk_bf16(acc[2], acc[3]);
                *(v2u*)(cs + 16 * nb + 4 * q) = o;
            }
            if (tid == 0) CD[unit_h] = __expf(aend[hh]);
        }
        __syncthreads();
    }
}
__device__ __forceinline__ void ssd_scan_item(int item, bf16* CS, const float* CD, bool dost) {
    const int bh = item >> 10, e8 = (item & 1023) * 8, b = bh >> 3, h = bh & 7;
    float st[8];
#pragma unroll
    for (int e = 0; e < 8; ++e) st[e] = 0.f;
    for (int cb = 0; cb < 2; ++cb) {
        v4u v[16]; float d[16];
#pragma unroll
        for (int k = 0; k < 16; ++k) { const int unit = (b * 32 + 16 * cb + k) * 8 + h; v[k] = *(const v4u*)(CS + (size_t)unit * 8192 + e8); d[k] = CD[unit]; }
#pragma unroll
        for (int k = 0; k < 16; ++k) { const int unit = (b * 32 + 16 * cb + k) * 8 + h;
            v4u o; o.x = cvt_pk_bf16(st[0], st[1]); o.y = cvt_pk_bf16(st[2], st[3]); o.z = cvt_pk_bf16(st[4], st[5]); o.w = cvt_pk_bf16(st[6], st[7]);
            if (dost) *(v4u*)(CS + (size_t)unit * 8192 + e8) = o;
#pragma unroll
            for (int e = 0; e < 4; ++e) { st[2 * e] = st[2 * e] * d[k] + bf_lo(v[k][e]); st[2 * e + 1] = st[2 * e + 1] * d[k] + bf_hi(v[k][e]); } }
    }
}
__device__ __forceinline__ void mix_out_unit(LAS unsigned char* lds, int unit, const bf16* P, const bf16* G, const float* BON, bf16* Y, const bf16* CS, const float* mu, const float* gn_g, const float* gn_b,
                                             const float* ssm_norm, const float* conv_w, const float* conv_b, const float* dt_bias, const float* a_log, int tid, int wave, int lane, bool st = true) {
    const int c = unit & 31, b = unit >> 5, h = wave, g = h >> 2;
    LAS bf16* Cn2 = (LAS bf16*)(lds); LAS float* ACS8 = (LAS float*)(lds + 34816); LAS float* SS8 = (LAS float*)(lds + 36864);
    const int r = lane & 15, q = lane >> 4;
    const size_t m0 = (size_t)b * SEQ + 64 * c; const bf16* prow = P + (m0 + lane) * PP;
    {
        const float xdt = bf1(prow[3328 + h]) + dt_bias[h]; const float dt = xdt > 20.f ? xdt : log1pf(__expf(xdt));
        float acs = dt * (-__expf(a_log[h]));
#pragma unroll
        for (int o = 1; o < 64; o <<= 1) { const float t = __shfl_up(acs, o); if (lane >= o) acs += t; }
        ACS8[h * 64 + lane] = acs;
    }
    {
        const int cl = lane & 31, chb = 3072 + 8 * cl, cw = chb - 2304;
        const bf16* pbase = P + (m0 + 8 * wave) * PP + chb;
        v4u win[11];
#pragma unroll
        for (int k = 0; k < 11; ++k) { win[k] = (v4u){0u, 0u, 0u, 0u}; if (64 * c + 8 * wave + k - 3 >= 0) win[k] = *(const v4u*)(pbase + (ptrdiff_t)(k - 3) * PP); }
        float cwv[4][8], cbv[8];
#pragma unroll
        for (int e = 0; e < 8; ++e) { cbv[e] = conv_b[cw + e];
#pragma unroll
            for (int k = 0; k < 4; ++k) cwv[k][e] = conv_w[k * 1024 + cw + e]; }
#pragma unroll
        for (int tl = 0; tl < 8; ++tl) { const int t = 8 * wave + tl;
            float o8[8];
#pragma unroll
            for (int e = 0; e < 8; ++e) o8[e] = cbv[e];
#pragma unroll
            for (int k = 0; k < 4; ++k) { const v4u iv = win[tl + k];
#pragma unroll
                for (int e = 0; e < 4; ++e) { o8[2 * e] += cwv[k][2 * e] * bf_lo(iv[e]); o8[2 * e + 1] += cwv[k][2 * e + 1] * bf_hi(iv[e]); } }
#pragma unroll
            for (int e = 0; e < 8; ++e) o8[e] = o8[e] * sigm(o8[e]);
            v4u o; o.x = cvt_pk_bf16(o8[0], o8[1]); o.y = cvt_pk_bf16(o8[2], o8[3]); o.z = cvt_pk_bf16(o8[4], o8[5]); o.w = cvt_pk_bf16(o8[6], o8[7]);
            if (lane < 32) *(LAS v4u*)(Cn2 + (cl >> 4) * 8704 + t * 136 + 8 * (cl & 15)) = o;
        }
    }
    __syncthreads();
    float ssl[4];
    {
        const bf16* cs = CS + (size_t)((b * 32 + c) * 8 + h) * 8192; const LAS bf16* Cg = Cn2 + g * 8704;
#pragma unroll
        for (int lb = 0; lb < 4; ++lb) ssl[lb] = 0.f;
#pragma unroll
        for (int pb = 0; pb < 4; ++pb) {
            bf16x8 bo[4];
#pragma unroll
            for (int kk = 0; kk < 4; ++kk) bo[kk] = *(const bf16x8*)(cs + (16 * pb + r) * 128 + 32 * kk + 8 * q);
            const int p0 = 16 * pb + 4 * q;
#pragma unroll
            for (int lb = 0; lb < 4; ++lb) { const int l = 16 * lb + r;
                bf16* yp = Y + (m0 + l) * 1024 + 512 + 64 * h + p0;
                const v2u yv = *(const v2u*)yp, zv = *(const v2u*)(P + (m0 + l) * PP + 1792 + 64 * h + p0);
                f32x4 acc = (f32x4){0.f, 0.f, 0.f, 0.f};
#pragma unroll
                for (int kk = 0; kk < 4; ++kk) acc = MFMA16(bo[kk], *(const LAS bf16x8*)(Cg + l * 136 + 32 * kk + 8 * q), acc);
                const float ea = __expf(ACS8[h * 64 + l]); const f32x4 y4 = bf4(yv) + ea * acc, z4 = bf4(zv);
                f32x4 u4;
#pragma unroll
                for (int j = 0; j < 4; ++j) { u4[j] = y4[j] * z4[j] * sigm(z4[j]); ssl[lb] += u4[j] * u4[j]; }
                v2u o; o.x = cvt_pk_bf16(u4[0], u4[1]); o.y = cvt_pk_bf16(u4[2], u4[3]);
                if (st) *(v2u*)yp = o;
            }
            asm volatile("" ::: "memory");
        }
#pragma unroll
        for (int lb = 0; lb < 4; ++lb) { float t = ssl[lb]; t += __shfl_xor(t, 16); t += __shfl_xor(t, 32); if (q == 0) SS8[h * 64 + 16 * lb + r] = t; }
    }
    __syncthreads();
    {
#pragma unroll
        for (int lb = 0; lb < 4; ++lb) { const int l = 16 * lb + r; float t = 0.f;
#pragma unroll
            for (int hh = 0; hh < 8; ++hh) t += SS8[hh * 64 + l];
            const float rs = __builtin_amdgcn_rsqf(t * (1.f / 512.f) + 1e-5f);
#pragma unroll
            for (int pb = 0; pb < 4; ++pb) { const int p0 = 16 * pb + 4 * q; bf16* yp = Y + (m0 + l) * 1024 + 512 + 64 * h + p0;
                const f32x4 u4 = bf4(*(const v2u*)yp) * rs * *(const f32x4*)(ssm_norm + 64 * h + p0);
                v2u o; o.x = cvt_pk_bf16(u4[0], u4[1]); o.y = cvt_pk_bf16(u4[2], u4[3]); if (st) *(v2u*)yp = o; }
        }
    }
    {
        const int c8 = 8 * lane, hh = lane >> 3;
        float gg[8], gb[8], muv[8];
#pragma unroll
        for (int e = 0; e < 8; ++e) { gg[e] = gn_g[c8 + e]; gb[e] = gn_b[c8 + e]; muv[e] = mu[1024 + c8 + e]; }
#pragma unroll
        for (int bt = 0; bt < 2; ++bt) {
            v4u yv[4], gv[4], vc[4], vp[4]; float bon[4];
#pragma unroll
            for (int k = 0; k < 4; ++k) { const size_t m = m0 + 8 * wave + 4 * bt + k; const int t = (int)(m & (SEQ - 1)); const bf16* pr = P + m * PP;
                yv[k] = *(const v4u*)(Y + m * 1024 + c8); gv[k] = *(const v4u*)(G + m * 512 + c8); vc[k] = *(const v4u*)(pr + 1024 + c8);
                vp[k] = (v4u){0u, 0u, 0u, 0u}; if (t) vp[k] = *(const v4u*)(pr - PP + 1024 + c8); bon[k] = BON[m * 8 + hh]; }
#pragma unroll
            for (int k = 0; k < 4; ++k) { const size_t m = m0 + 8 * wave + 4 * bt + k;
                float y[8], sm = 0.f;
#pragma unroll
                for (int e = 0; e < 4; ++e) { y[2 * e] = bf_lo(yv[k][e]); y[2 * e + 1] = bf_hi(yv[k][e]); sm += y[2 * e] + y[2 * e + 1]; }
                sm += __shfl_xor(sm, 1); sm += __shfl_xor(sm, 2); sm += __shfl_xor(sm, 4);
                const float mean = sm * (1.f / 64.f); float qv_ = 0.f;
#pragma unroll
                for (int e = 0; e < 8; ++e) { y[e] -= mean; qv_ += y[e] * y[e]; }
                qv_ += __shfl_xor(qv_, 1); qv_ += __shfl_xor(qv_, 2); qv_ += __shfl_xor(qv_, 4);
                const float rstd = __builtin_amdgcn_rsqf(qv_ * (1.f / 64.f) + 64e-5f);
                float o[8];
#pragma unroll
                for (int e = 0; e < 4; ++e) {
                    const float v0 = bf_lo(vc[k][e]), v1 = bf_hi(vc[k][e]), p0 = bf_lo(vp[k][e]), p1 = bf_hi(vp[k][e]);
                    const float va = v0 + (p0 - v0) * muv[2 * e], vb = v1 + (p1 - v1) * muv[2 * e + 1];
                    o[2 * e] = (y[2 * e] * rstd * gg[2 * e] + gb[2 * e] + bon[k] * va) * bf_lo(gv[k][e]);
                    o[2 * e + 1] = (y[2 * e + 1] * rstd * gg[2 * e + 1] + gb[2 * e + 1] + bon[k] * vb) * bf_hi(gv[k][e]);
                }
                v4u w; w.x = cvt_pk_bf16(o[0], o[1]); w.y = cvt_pk_bf16(o[2], o[3]); w.z = cvt_pk_bf16(o[4], o[5]); w.w = cvt_pk_bf16(o[6], o[7]);
                if (st) *(v4u*)(Y + m * 1024 + c8) = w;
            }
        }
    }
    __syncthreads();
}
#define XB_TMO      128
#define XB_XCNT(j)  (256  + 64 * (j))
#define XB_XSUB(j)  (1280 + 64 * (j))
#define XB_XGEN(j)  (2304 + 64 * (j))
#define XB_TOP      3328
#define XB_TOPGEN   3392
#define XCD_BAR_WORDS 3456
#define XB_SPIN_CAP (1u << 18)

__device__ __forceinline__ unsigned xb_ld(unsigned* p)              { return __hip_atomic_load(p, __ATOMIC_RELAXED, __HIP_MEMORY_SCOPE_AGENT); }
__device__ __forceinline__ unsigned xb_add(unsigned* p, unsigned v) { return __hip_atomic_fetch_add(p, v, __ATOMIC_RELAXED, __HIP_MEMORY_SCOPE_AGENT); }
__device__ __forceinline__ unsigned xb_xcc_id() { return (unsigned)__builtin_amdgcn_s_getreg((3 << 11) | 20) & 0xFu; }
#define XB_SPIN(cond, bar) do { unsigned _sp = 0; while (cond) { __builtin_amdgcn_s_sleep(1); \
    if ((++_sp & 255u) == 0u) { if (xb_ld(&(bar)[XB_TMO])) break; if (_sp > XB_SPIN_CAP) { atomicAdd(&(bar)[XB_TMO], 1u); break; } } } } while (0)

struct XcdBarrier {
    unsigned* bar; unsigned x;
    volatile LAS unsigned* st;
};

__device__ __forceinline__ XcdBarrier xcd_barrier_post(unsigned* bar, volatile LAS unsigned* st) {
    XcdBarrier b; b.bar = bar; b.x = xb_xcc_id(); b.st = st;
    if (threadIdx.x == 0) (void)xb_add(&bar[XB_XCNT(b.x)], 1u);
    return b;
}
__device__ __forceinline__ void xcd_barrier_complete(unsigned* bar, unsigned x, unsigned& nloc, unsigned& nx) {
    const unsigned G = gridDim.x * gridDim.y * gridDim.z;
    unsigned sum, cnt, mine, sp = 0u;
    for (;;) {
        sum = 0u; cnt = 0u; mine = 0u;
#pragma unroll
        for (unsigned j = 0; j < 16; ++j) { const unsigned c = xb_ld(&bar[XB_XCNT(j)]); sum += c; cnt += (c > 0u) ? 1u : 0u; mine = (j == x) ? c : mine; }
        if (sum == G) break;
        __builtin_amdgcn_s_sleep(1);
        if ((++sp & 255u) == 0u) { if (xb_ld(&bar[XB_TMO])) break; if (sp > XB_SPIN_CAP) { atomicAdd(&bar[XB_TMO], 1u); break; } }
    }
    nloc = mine > 0u ? mine : 1u; nx = cnt > 0u ? cnt : 1u;
}

__device__ __forceinline__ void xcd_barrier(const XcdBarrier& b) {
    asm volatile("s_waitcnt vmcnt(0)" ::: "memory");
    __syncthreads();
    if (threadIdx.x == 0) {
        unsigned* bar = b.bar;
        __builtin_amdgcn_s_waitcnt(0);
        unsigned nloc = b.st[0], nx = b.st[1];
        if (nloc == 0u) { xcd_barrier_complete(bar, b.x, nloc, nx); b.st[0] = nloc; b.st[1] = nx; }
        const unsigned old = xb_add(&bar[XB_XSUB(b.x)], 1u);
        const unsigned gen = old / nloc;
        if (old + 1u == (gen + 1u) * nloc) {
            __builtin_amdgcn_fence(__ATOMIC_RELEASE, "agent");
            asm volatile("s_waitcnt vmcnt(0)" ::: "memory");
            const unsigned og = xb_add(&bar[XB_TOP], 1u);
            const unsigned tg = og / nx;
            if (og + 1u == (tg + 1u) * nx) xb_add(&bar[XB_TOPGEN], 1u);
            else XB_SPIN(xb_ld(&bar[XB_TOPGEN]) == tg, bar);
            __builtin_amdgcn_fence(__ATOMIC_ACQUIRE, "agent");
            xb_add(&bar[XB_XGEN(b.x)], 1u);
            asm volatile("s_waitcnt vmcnt(0)" ::: "memory");
        } else {
            XB_SPIN(xb_ld(&bar[XB_XGEN(b.x)]) == gen, bar);
            __builtin_amdgcn_fence(__ATOMIC_ACQUIRE, "agent");
            asm volatile("s_waitcnt vmcnt(0)" ::: "memory");
        }
    }
    __syncthreads();
}

struct Args { const float* in[30]; float* out; unsigned char* ws; int ph_lo, ph_hi, dry, pad; };
__global__ void __launch_bounds__(NTHREADS, 2) fwd_kernel(Args args) {
    extern __shared__ __attribute__((aligned(16))) unsigned char lds_raw[];
    LAS unsigned char* lds = (LAS unsigned char*)lds_raw;
    const int tid = threadIdx.x, lane = tid & 63, wave = __builtin_amdgcn_readfirstlane(tid >> 6);
    const int G = gridDim.x, bx = blockIdx.x; const int vcu = (G % 8 == 0) ? (bx % 8) * (G / 8) + bx / 8 : bx;
    const int gw = vcu * NWAVES + wave, NGW = G * NWAVES;
    unsigned char* ws = args.ws;
    const float* const* in = args.in;
    bf16* W1GU = (bf16*)(ws + WS_W1GU); bf16* W1D = (bf16*)(ws + WS_W1D); bf16* WIN = (bf16*)(ws + WS_WIN); bf16* WOUT = (bf16*)(ws + WS_WOUT);
    bf16* W2GU = (bf16*)((unsigned char*)args.out + 32 * MiB);     bf16* W2D = (bf16*)(ws + WS_W2D); bf16* WL = (bf16*)(ws + WS_WL);
    bf16* XG = (bf16*)(ws + WS_XG); bf16* PB = (bf16*)(ws + WS_P); bf16* YB = (bf16*)(ws + WS_Y); bf16* GB = (bf16*)(ws + WS_G); bf16* LIN = (bf16*)(ws + WS_LIN);
    bf16* EAB = (bf16*)args.out;
    float* PART = (float*)(ws + WS_PART); float* BON = (float*)(ws + WS_BONUS); float* GCG = (float*)(ws + WS_GC); unsigned* SLG = (unsigned*)(ws + WS_LIN); bf16* CSB = (bf16*)(ws + WS_CS); float* CDB = (float*)(ws + WS_CD);
    const int lo = args.ph_lo, hi = args.ph_hi;
    cg::grid_group grid = cg::this_grid();
    volatile LAS unsigned* xbst = (volatile LAS unsigned*)(lds + 147440);
    if (tid < 2) xbst[tid] = 0u;
    __syncthreads();
    XcdBarrier xbar; xbar.bar = (unsigned*)ws; xbar.x = 0; xbar.st = nullptr;
    if (hi - lo > 1) xbar = xcd_barrier_post((unsigned*)ws, xbst);
#ifndef PH_MASK
#define PH_MASK 0xfff
#endif
#ifndef REPG
#define REPG 1
#endif
#ifndef REP0
#define REP0 1
#endif
#define IN(k) (((PH_MASK >> (k)) & 1) && lo <= (k) && (k) < hi)
#define SEAM(k) do { if (IN(k) && IN((k) + 1)) { if (args.pad != 0) grid.sync(); else xcd_barrier(xbar); } } while (0)
#define STAGE_P6_TABLES() do {   \
        const int h6 = vcu & 7, g6 = vcu & 1; LAS float* CWs = (LAS float*)(lds + 133632); LAS float* PRMw = (LAS float*)(lds + 143872); \
        for (int idx = tid; idx < 2560; idx += NTHREADS) { const int cgp = idx / 40, rem = idx % 40, k = rem >> 3, e = rem & 7; \
            const int chb = cgp < 16 ? 2816 + 128 * g6 + 8 * cgp : (cgp < 32 ? 3072 + 128 * g6 + 8 * (cgp - 16) : 2304 + 256 * g6 + 8 * (cgp - 32)); \
            CWs[idx] = k < 4 ? in[18][k * 1024 + chb - 2304 + e] : in[19][chb - 2304 + e]; } \
        { const int a = tid >> 6, j = tid & 63; const float* src = a < 3 ? in[7] + 512 * a : (a == 3 ? in[13] : (a == 4 ? in[14] : (a == 5 ? in[15] : (a == 6 ? in[8] : in[10])))); \
          PRMw[tid] = src[64 * h6 + j]; } } while (0)
    if (IN(0)) { p0_prologue(lds, in, ws, vcu, G, tid, wave, lane); SEAM(0); }
    if (IN(1)) {
        pg8::Gemm g{XG, W1GU, M, NGU, D}; pg8::StaticOrder S; S.init(M, NGU, G, bx);
        pg8::EpiSwiGLU E{PB, FF, nullptr};
        pg8::gemm_phase<pg8::EpiSwiGLU, pg8::StaticOrder, true, true>(lds, g, S, E);
        if (G == 256 ? bx >= 128 : true) { const int tb_ = G == 256 ? bx - 128 : bx, ntb = G == 256 ? 128 : G; p1_tail_copies(in, ws, tb_ * NWAVES + wave, ntb * NWAVES, tb_ * NTHREADS + tid, ntb * NTHREADS, lane); }
        SEAM(1);
    }
    if (IN(2)) {
        pg8::Gemm g{PB, W1D, M, D, FF}; pg8::StaticOrder S; S.init(M, D, G, bx);
        pg8::EpiResidB<false> E{in[0], XG, nullptr, PART, 0.5f, nullptr, nullptr};
        pg8::gemm_phase<pg8::EpiResidB<false>, pg8::StaticOrder, true, true>(lds, g, S, E);
        SEAM(2);
    }
    if (IN(3)) {
        pg8::Gemm g{XG, WIN, M, NINP, D}; pg8::StaticOrder S; S.init(M, NINP, G, bx);
        pg8::EpiScaleBf16 E{PB, PP, NIN, PART};
        pg8::gemm_phase<pg8::EpiScaleBf16, pg8::StaticOrder, true, true>(lds, g, S, E);
        if (G == 256 ? bx >= 128 : true) {
            const int tb_ = G == 256 ? bx - 128 : bx, ntw = (G == 256 ? 128 : G) * NWAVES;
            for (int it = tb_ * NWAVES + wave; it < 2 * TR_I_GU; it += 2 * ntw) {
                int ra = it; const int upa = ra >= TR_I_GU; ra -= upa * TR_I_GU; const TrItem a = tr_make(in[26 + upa], FF, ra / 44, ra % 44, W2GU, D, 0, 0, 1, upa, lane, in[25]);
                const bool hasb = it + ntw < 2 * TR_I_GU; int rb = hasb ? it + ntw : it; const int upb = rb >= TR_I_GU; rb -= upb * TR_I_GU; const TrItem b = tr_make(in[26 + upb], FF, rb / 44, rb % 44, W2GU, D, 0, 0, 1, upb, lane, in[25]);
                f32x4 va[8], vb[8]; tr_load(a, va); tr_load(b, vb); tr_store(a, va); if (hasb) tr_store(b, vb);
            }
        }
        SEAM(3);
    }
    if (IN(4)) { p4_lora_in(PB, in[7], LIN, vcu * NTHREADS + tid, G * NTHREADS); SEAM(4); }
    if (IN(5)) {
        int kl = 128; asm volatile("" : "+s"(kl));
        { pg8::Gemm g{LIN, WL, M, 1024, kl, KLORA}; pg8::StaticOrder S; S.init(M, 1024, G, bx);
          pg8::EpiLora E{EAB, GB};
          pg8::gemm_phase<pg8::EpiLora, pg8::StaticOrder, true, true>(lds, g, S, E); }
        { pg8::Gemm g{LIN + 128, WL + (size_t)1024 * KLORA + 128, M, 512, kl, KLORA}; pg8::StaticOrder S; S.init(M, 512, G, (bx + 128) % G);
          pg8::EpiLoraG E2{GB};
          pg8::gemm_phase<pg8::EpiLoraG, pg8::StaticOrder, true, true>(lds, g, S, E2); }
        if (IN(6)) STAGE_P6_TABLES();
        SEAM(5);
    }
    const int dry = args.dry;
    if (IN(6)) {
        if (!IN(5)) { STAGE_P6_TABLES(); __syncthreads(); }
        if (dry == 0 || (dry & 1)) { RwIn rin; rwkv_chunk_load(rin, vcu, PB, EAB, tid);
            for (int u = vcu; u < 2048; u += G) { rwkv_chunk_unit(lds, u, rin, u + G < 2048 ? u + G : -1, PB, EAB, YB, BON, GCG, SLG, tid, wave, lane, dry == 0, dry >> 4); } }
        if (dry == 0 || (dry & 2)) {
            for (int u = vcu; u < 512; u += G) ssd_chunk_group(lds, u, PB, YB, CSB, CDB, in[20], in[21], in[22], tid, wave, lane);
        }
        SEAM(6);
    }
    if (IN(7)) {
        volatile LAS unsigned* prog = (volatile LAS unsigned*)(lds + 131072);
        if (tid == 0) *prog = 0u;
        __syncthreads();
        if (wave == 0) { if ((dry == 0 || (dry & 1)) && vcu < 256) rwkv_seq_state(lds, prog, vcu, EAB, GCG, SLG, lane); }
        else if (wave <= 2) { if ((dry == 0 || (dry & 1)) && vcu < 256) rwkv_seq_out(lds, prog, vcu, EAB, YB, lane, dry == 0, wave - 1); }
        else if (dry == 0 || (dry & 2)) { for (int it = (vcu * 5 + wave - 3) * 64 + lane; it < 65536; it += G * 5 * 64) ssd_scan_item(it, CSB, CDB, dry == 0); }
        SEAM(7);
    }
    if (IN(8)) {
        if (dry == 0 || (dry & 1)) for (int u = vcu; u < 256; u += G) mix_out_unit(lds, u, PB, GB, BON, YB, CSB, in[7], in[16], in[17], in[23], in[18], in[19], in[20], in[21], tid, wave, lane, dry == 0);
        SEAM(8);
    }
    if (IN(9)) {
        pg8::Gemm g{YB, WOUT, M, D, D}; pg8::StaticOrder S; S.init(M, D, G, bx);
        pg8::EpiResidB<true> E{XG, XG, nullptr, PART, 1.0f, nullptr, nullptr};
        pg8::gemm_phase<pg8::EpiResidB<true>, pg8::StaticOrder, true, true>(lds, g, S, E);
        SEAM(9);
    }
    if (IN(10)) {
        pg8::Gemm g{XG, W2GU, M, NGU, D}; pg8::StaticOrder S; S.init(M, NGU, G, bx);
        pg8::EpiSwiGLU E{PB, FF, PART};
        pg8::gemm_phase<pg8::EpiSwiGLU, pg8::StaticOrder, true, true>(lds, g, S, E);
        SEAM(10);
    }
    if (IN(11)) {
        pg8::Gemm g{PB, W2D, M, D, FF}; pg8::StaticOrder S; S.init(M, D, G, bx);
        pg8::EpiResidNormFinal E{XG, args.out, in[29], (float*)(ws + 65536), (unsigned*)(ws + 16384), 0.5f};
        pg8::gemm_phase<pg8::EpiResidNormFinal, pg8::StaticOrder, false, true>(lds, g, S, E);
    }
#undef IN
#undef SEAM
}

extern "C" void kernel_launch(void* const* d_in, const int* in_sizes, int n_in, void* d_out, int out_size, void* d_ws, size_t ws_size, hipStream_t stream) {
    static int grid = 0;
    if (grid == 0) {
        if (n_in != 30 || out_size != M * D || ws_size < WS_END) { fprintf(stderr, "kernel_launch: unexpected shapes (n_in %d out %d ws %zu)\n", n_in, out_size, ws_size); grid = -1; return; }
        int dev = 0, cus = 0, per_cu = 0;
        hipGetDevice(&dev); hipDeviceGetAttribute(&cus, hipDeviceAttributeMultiprocessorCount, dev);
        if (hipFuncSetAttribute((const void*)fwd_kernel, hipFuncAttributeMaxDynamicSharedMemorySize, LDS_BYTES) != hipSuccess) { fprintf(stderr, "kernel_launch: hipFuncSetAttribute failed\n"); grid = -1; return; }
        hipOccupancyMaxActiveBlocksPerMultiprocessor(&per_cu, (const void*)fwd_kernel, NTHREADS, LDS_BYTES);
        (void)hipGetLastError();
        if (per_cu < 1) per_cu = 1;
        grid = cus * 1;
        if (grid != 256) fprintf(stderr, "kernel_launch: note: grid %d\n", grid);
    }
    if (grid < 0) return;
    Args a{};
    for (int i = 0; i < 30; ++i) a.in[i] = (const float*)d_in[i];
    a.out = (float*)d_out; a.ws = (unsigned char*)d_ws;
    if (hipMemsetAsync(d_ws, 0, 32768, stream) != hipSuccess) { fprintf(stderr, "kernel_launch: memset of the control words failed\n"); return; }
#if MK_N_LAUNCHES == 1
    a.ph_lo = 0; a.ph_hi = NPHASE;
    void* kargs[] = {&a};
    hipError_t e = hipLaunchCooperativeKernel((const void*)fwd_kernel, dim3(grid), dim3(NTHREADS), kargs, LDS_BYTES, stream);
    if (e != hipSuccess) fprintf(stderr, "cooperative launch failed: %s (grid %d)\n", hipGetErrorString(e), grid);
#else
    #ifndef REP_PHASE_MASK
#define REP_PHASE_MASK 0
#endif
#ifndef PROBE_PHASE
#define PROBE_PHASE -1
#define PROBE_SEL 0
#endif
    for (int p = 0; p < NPHASE; ++p) { a.ph_lo = p; a.ph_hi = p + 1; const int nrep = ((REP_PHASE_MASK >> p) & 1) ? 2 : 1;
        if (p == PROBE_PHASE) { a.dry = PROBE_SEL; hipLaunchKernelGGL(fwd_kernel, dim3(grid), dim3(NTHREADS), LDS_BYTES, stream, a); a.dry = 0; }
        for (int rr = 0; rr < nrep; ++rr) hipLaunchKernelGGL(fwd_kernel, dim3(grid), dim3(NTHREADS), LDS_BYTES, stream, a); }
#endif
}
```
